# Optimizing an MI355X kernel written in HIP

```python
import math
import jax
import jax.numpy as jnp
from jax import lax
import numpy as np

D_MODEL = 1024
BATCH = 8
SEQ = 4096
DEPTH = 2

N_MIXERS = 2
N_MEM = 256
HEAD_DIM = 64
MIX_HEADS = 12
MEM_HEADS = 4
MIX_WIDTH = MIX_HEADS * HEAD_DIM
MEM_WIDTH = MEM_HEADS * HEAD_DIM
GATE_WIDTH = MIX_WIDTH + MEM_WIDTH
CONV_WIDTH = 4
DELTA_CHUNK = 64
MOBA_BLOCK = 256
MOBA_TOPK = 3
MOBA_QCHUNK = 32
ROPE_THETA = 10000.0
NORM_EPS = 1e-6
MASK_VALUE = -1e30
DELTA_IN = 3 * MIX_WIDTH + GATE_WIDTH + MEM_WIDTH + 2 * MIX_HEADS
MOBA_IN = 3 * MIX_WIDTH + GATE_WIDTH + MEM_WIDTH

kernel_name = 'hybrid_deltanet_moba_memory'


def rmsnorm(x, g):
    xf = x.astype(jnp.float32)
    y = xf * lax.rsqrt(jnp.mean(xf * xf, axis=-1, keepdims=True) + NORM_EPS)
    return (y * g.astype(jnp.float32)).astype(x.dtype)


def l2norm(x):
    xf = x.astype(jnp.float32)
    return xf * lax.rsqrt(jnp.sum(xf * xf, axis=-1, keepdims=True) + NORM_EPS)


def apply_rope(x, positions):
    d = x.shape[-1]
    half = d // 2
    inv_freq = ROPE_THETA ** (-jnp.arange(half, dtype=jnp.float32) * (2.0 / d))
    ang = positions.astype(jnp.float32)[..., None] * inv_freq
    cos = jnp.cos(ang)[:, :, None, :]
    sin = jnp.sin(ang)[:, :, None, :]
    xf = x.astype(jnp.float32)
    x1, x2 = xf[..., :half], xf[..., half:]
    return jnp.concatenate([x1 * cos - x2 * sin, x2 * cos + x1 * sin], axis=-1).astype(x.dtype)


def causal_short_conv(x, w):
    c = x.shape[-1]
    return lax.conv_general_dilated(
        x, w.astype(x.dtype)[:, None, :], window_strides=(1,),
        padding=[(CONV_WIDTH - 1, 0)], dimension_numbers=('NWC', 'WIO', 'NWC'),
        feature_group_count=c)


def gated_delta_rule(q, k, v, log_decay, beta):
    B_, S_, H_, dk = q.shape
    dv = v.shape[-1]
    C = DELTA_CHUNK
    N = S_ // C

    def to_chunks(t):
        t = t.reshape((B_, N, C, H_) + t.shape[3:])
        return jnp.moveaxis(t, (1, 3), (0, 2))

    qc = to_chunks(q * (dk ** -0.5))
    kc = to_chunks(k)
    vc = to_chunks(v)
    gcum = jnp.cumsum(to_chunks(log_decay), axis=-1)
    bc = to_chunks(beta)
    tri_incl = jnp.tril(jnp.ones((C, C), dtype=bool))
    tri_strict = jnp.tril(jnp.ones((C, C), dtype=bool), -1)
    decay = jnp.exp(jnp.where(tri_incl, gcum[..., :, None] - gcum[..., None, :], -jnp.inf))
    kb = kc * bc[..., None]
    lower = jnp.where(tri_strict, jnp.einsum('nbhid,nbhjd->nbhij', kb, kc) * decay, 0.0)
    eye = jnp.eye(C, dtype=jnp.float32)
    rhs = jnp.concatenate([vc * bc[..., None], kb * jnp.exp(gcum)[..., None]], axis=-1)
    sol = lax.linalg.triangular_solve(eye + lower, rhs, left_side=True, lower=True,
                                      unit_diagonal=True)
    u, w = sol[..., :dv], sol[..., dv:]
    attn_intra = jnp.where(tri_incl, jnp.einsum('nbhid,nbhjd->nbhij', qc, kc) * decay, 0.0)

    def step(state, xs):
        q_i, k_i, u_i, w_i, g_i, a_i = xs
        v_new = u_i - jnp.einsum('bhcd,bhde->bhce', w_i, state)
        o = (jnp.einsum('bhcd,bhde->bhce', q_i * jnp.exp(g_i)[..., None], state)
             + jnp.einsum('bhij,bhje->bhie', a_i, v_new))
        g_last = g_i[..., -1:]
        state = (state * jnp.exp(g_last)[..., None]
                 + jnp.einsum('bhcd,bhce->bhde', k_i * jnp.exp(g_last - g_i)[..., None], v_new))
        return state, o

    s0 = jnp.zeros((B_, H_, dk, dv), jnp.float32)
    _, o = lax.scan(step, s0, (qc, kc, u, w, gcum, attn_intra))
    return jnp.moveaxis(o, (0, 2), (1, 3)).reshape(B_, S_, H_, dv)


def moba_attention(q, k, v):
    B_, S_, H_, d = q.shape
    nb = max(-(-S_ // MOBA_BLOCK), MOBA_TOPK)
    sp = nb * MOBA_BLOCK
    pad = ((0, 0), (0, sp - S_), (0, 0), (0, 0))
    kblk = jnp.moveaxis(jnp.pad(k, pad), 2, 1).reshape(B_, H_, nb, MOBA_BLOCK, d)
    vblk = jnp.moveaxis(jnp.pad(v, pad), 2, 1).reshape(B_, H_, nb, MOBA_BLOCK, d)
    kmean = jnp.mean(kblk.astype(jnp.float32), axis=3)
    nq = S_ // MOBA_QCHUNK
    qch = jnp.moveaxis(q, 2, 1).reshape(B_, H_, nq, MOBA_QCHUNK, d).transpose(2, 0, 1, 3, 4)
    scale = d ** -0.5
    bidx = jnp.arange(B_)[:, None, None]
    hidx = jnp.arange(H_)[None, :, None]
    blocks = jnp.arange(nb)

    def one_chunk(args):
        c, qc = args
        qpos = c * MOBA_QCHUNK + jnp.arange(MOBA_QCHUNK)
        own = (c * MOBA_QCHUNK) // MOBA_BLOCK
        gate = jnp.einsum('bhqd,bhnd->bhqn', qc.astype(jnp.float32), kmean)
        gate = jnp.where(blocks < own, gate, -jnp.inf)
        top_val, top_idx = lax.top_k(gate, MOBA_TOPK)
        sel_valid = jnp.isfinite(top_val)
        kown = lax.dynamic_index_in_dim(kblk, own, axis=2, keepdims=False)
        vown = lax.dynamic_index_in_dim(vblk, own, axis=2, keepdims=False)
        kpos = own * MOBA_BLOCK + jnp.arange(MOBA_BLOCK)
        causal = kpos[None, :] <= qpos[:, None]
        logit_own = jnp.einsum('bhqd,bhkd->bhqk', qc, kown).astype(jnp.float32) * scale
        logits = [jnp.where(causal, logit_own, MASK_VALUE)]
        for s in range(MOBA_TOPK):
            ks = kblk[bidx, hidx, top_idx[..., s]]
            ls = jnp.einsum('bhqd,bhqkd->bhqk', qc, ks).astype(jnp.float32) * scale
            logits.append(jnp.where(sel_valid[..., s, None], ls, MASK_VALUE))
        p = jax.nn.softmax(jnp.concatenate(logits, axis=-1), axis=-1).astype(v.dtype)
        out = jnp.einsum('bhqk,bhkd->bhqd', p[..., :MOBA_BLOCK], vown)
        for s in range(MOBA_TOPK):
            vs = vblk[bidx, hidx, top_idx[..., s]]
            ps = p[..., (s + 1) * MOBA_BLOCK:(s + 2) * MOBA_BLOCK]
            out = out + jnp.einsum('bhqk,bhqkd->bhqd', ps, vs)
        return out

    out = lax.map(one_chunk, (jnp.arange(nq), qch))
    return out.transpose(1, 0, 3, 2, 4).reshape(B_, S_, H_, d)


def memory_attention(mq, mem, mem_norm_g, w_mem_kv):
    B_, S_, _ = mq.shape
    kv = rmsnorm(mem, mem_norm_g) @ w_mem_kv
    mk, mv = jnp.split(kv, 2, axis=-1)
    mk = mk.reshape(B_, -1, MEM_HEADS, HEAD_DIM)
    mv = mv.reshape(B_, -1, MEM_HEADS, HEAD_DIM)
    q = mq.reshape(B_, S_, MEM_HEADS, HEAD_DIM)
    logits = jnp.einsum('bshd,bmhd->bhsm', q, mk).astype(jnp.float32) * (HEAD_DIM ** -0.5)
    p = jax.nn.softmax(logits, axis=-1).astype(mv.dtype)
    return jnp.einsum('bhsm,bmhd->bshd', p, mv).reshape(B_, S_, MEM_WIDTH)


def gated_output(mix, memo, z, w_out):
    y = jnp.concatenate([mix, memo.astype(mix.dtype)], axis=-1) * jax.nn.silu(z)
    return y @ w_out


def delta_layer(h, mem, norm_g, w_in, conv_w, a_log, dt_bias, o_norm, mem_norm_g, w_mem_kv, w_out):
    B_, S_, _ = h.shape
    proj = rmsnorm(h, norm_g) @ w_in
    i1 = 3 * MIX_WIDTH
    i2 = i1 + GATE_WIDTH
    i3 = i2 + MEM_WIDTH
    qkv, z, mq, ba = jnp.split(proj, [i1, i2, i3], axis=-1)
    qkv = jax.nn.silu(causal_short_conv(qkv, conv_w))
    q, k, v = [t.reshape(B_, S_, MIX_HEADS, HEAD_DIM) for t in jnp.split(qkv, 3, axis=-1)]
    b_raw, a_raw = jnp.split(ba.astype(jnp.float32), 2, axis=-1)
    beta = jax.nn.sigmoid(b_raw)
    log_decay = -jnp.exp(a_log.astype(jnp.float32)) * jax.nn.softplus(a_raw + dt_bias.astype(jnp.float32))
    o = gated_delta_rule(l2norm(q), l2norm(k), v.astype(jnp.float32), log_decay, beta)
    o = rmsnorm(o, o_norm).reshape(B_, S_, MIX_WIDTH).astype(h.dtype)
    m = memory_attention(mq, mem, mem_norm_g, w_mem_kv)
    return gated_output(o, m, z, w_out)


def moba_layer(h, mem, positions, norm_g, w_in, mem_norm_g, w_mem_kv, w_out):
    B_, S_, _ = h.shape
    proj = rmsnorm(h, norm_g) @ w_in
    q, k, v, z, mq = jnp.split(proj, [MIX_WIDTH, 2 * MIX_WIDTH, 3 * MIX_WIDTH,
                                      3 * MIX_WIDTH + GATE_WIDTH], axis=-1)
    q = apply_rope(q.reshape(B_, S_, MIX_HEADS, HEAD_DIM), positions)
    k = apply_rope(k.reshape(B_, S_, MIX_HEADS, HEAD_DIM), positions)
    v = v.reshape(B_, S_, MIX_HEADS, HEAD_DIM)
    o = moba_attention(q, k, v).reshape(B_, S_, MIX_WIDTH)
    m = memory_attention(mq, mem, mem_norm_g, w_mem_kv)
    return gated_output(o, m, z, w_out)


def setup_inputs(seed: int = 0) -> dict:
    key = jax.random.key(seed)
    ks = jax.random.split(key, 24)
    f32 = jnp.float32

    def dense(k, fan_in, fan_out):
        return jax.random.normal(k, (fan_in, fan_out), f32) * fan_in ** -0.5

    def gain(k, n):
        return 1.0 + 0.05 * jax.random.normal(k, (n,), f32)

    x = jax.random.normal(ks[0], (BATCH, SEQ, D_MODEL), f32)
    mem = jax.random.normal(ks[1], (BATCH, N_MEM, D_MODEL), f32)
    start = jax.random.randint(ks[2], (BATCH, 1), 0, 1024, dtype=jnp.int32)
    positions = start + jnp.arange(SEQ, dtype=jnp.int32)[None, :]
    dt = jnp.exp(jax.random.uniform(ks[7], (MIX_HEADS,), f32,
                                    minval=math.log(1e-3), maxval=math.log(1e-1)))
    return {
        'x': x,
        'mem': mem,
        'positions': positions,
        'norm_0': gain(ks[3], D_MODEL),
        'w_in_0': dense(ks[4], D_MODEL, DELTA_IN),
        'conv_w_0': jax.random.normal(ks[5], (CONV_WIDTH, 3 * MIX_WIDTH), f32) * CONV_WIDTH ** -0.5,
        'a_log_0': jnp.log(jax.random.uniform(ks[6], (MIX_HEADS,), f32, minval=1.0, maxval=16.0)),
        'dt_bias_0': dt + jnp.log(-jnp.expm1(-dt)),
        'o_norm_0': gain(ks[8], HEAD_DIM),
        'mem_norm_0': gain(ks[9], D_MODEL),
        'w_mem_kv_0': dense(ks[10], D_MODEL, 2 * MEM_WIDTH),
        'w_out_0': dense(ks[11], GATE_WIDTH, D_MODEL),
        'norm_1': gain(ks[12], D_MODEL),
        'w_in_1': dense(ks[13], D_MODEL, MOBA_IN),
        'mem_norm_1': gain(ks[14], D_MODEL),
        'w_mem_kv_1': dense(ks[15], D_MODEL, 2 * MEM_WIDTH),
        'w_out_1': dense(ks[16], GATE_WIDTH, D_MODEL),
        'final_norm': gain(ks[17], D_MODEL),
    }


def reference(x, mem, positions, norm_0, w_in_0, conv_w_0, a_log_0, dt_bias_0, o_norm_0,
              mem_norm_0, w_mem_kv_0, w_out_0, norm_1, w_in_1, mem_norm_1, w_mem_kv_1,
              w_out_1, final_norm):
    layers = [
        ('delta', (norm_0, w_in_0, conv_w_0, a_log_0, dt_bias_0, o_norm_0,
                   mem_norm_0, w_mem_kv_0, w_out_0)),
        ('moba', (norm_1, w_in_1, mem_norm_1, w_mem_kv_1, w_out_1)),
    ]
    h = x
    for i in range(DEPTH):
        kind, params = layers[i]
        if i % N_MIXERS == 0:
            h = h + delta_layer(h, mem, *params)
        else:
            h = h + moba_layer(h, mem, positions, *params)
    return rmsnorm(h, final_norm)
```

```cpp
#include <hip/hip_runtime.h>
#include <hip/hip_cooperative_groups.h>
#include <hip/hip_bf16.h>
#include <cstdio>
#include <cstdint>
#include <cmath>
namespace pg8 {
#define PG8_LAS __attribute__((address_space(3)))
typedef unsigned short bf16_t;
typedef short bf16x8 __attribute__((ext_vector_type(8)));
typedef float f32x4 __attribute__((ext_vector_type(4)));
typedef unsigned u32x4 __attribute__((ext_vector_type(4)));
constexpr int BM = 256, BK = 64, HALF = 128, HTB = HALF * BK * 2  , STAGE_BYTES = 8 * HTB, NXCD = 8, WGM = 8;

__host__ __device__ __forceinline__ int lds_byte(int r, int c) { const int st = (r >> 4) * 2 + (c >> 5), rr = r & 15, cc = c & 31, ob = rr * 64 + cc * 2; return st * 1024 + (ob ^ (((ob >> 9) & 1) << 5)); }
__host__ __device__ __forceinline__ void stage_rc(int b, int& R, int& C) { const int st = b / 1024, sb = b % 1024, swz = sb ^ (((sb >> 9) & 1) << 5); R = (st >> 1) * 16 + swz / 64; C = (st & 1) * 32 + (swz % 64) / 2; }
__host__ __device__ __forceinline__ int perm32(int rho) { const int n = rho >> 4, i = rho & 15; return 8 * (i >> 2) + 4 * n + (i & 3); }

struct Unit { int pm, pn; };
struct Gemm { const bf16_t* A; const bf16_t* Bt; int M, N, K; };
__device__ __forceinline__ unsigned cvt_pk_bf16(float lo, float hi) { unsigned r; asm volatile("v_cvt_pk_bf16_f32 %0, %1, %2" : "=v"(r) : "v"(lo), "v"(hi)); return r; }
typedef float f32x2 __attribute__((ext_vector_type(2)));
template <class Epi, class Sched, bool ALIGN_EPI = false, bool SP2 = false>
__device__ __forceinline__ void gemm_phase(PG8_LAS unsigned char* lds, const Gemm g, const Sched& S, const Epi& E, const int wave_s) {
    int lane_ = __builtin_amdgcn_mbcnt_hi(~0u, __builtin_amdgcn_mbcnt_lo(~0u, 0u)); asm volatile("" : "+v"(lane_)); const int tid = wave_s * 64 + lane_; const int wid = wave_s, lane = tid & 63, wr = wid >> 2, wc = wid & 3, fr = lane & 15, fq = lane >> 4;
    const int K = g.K, nt = K / BK;
    unsigned voffA[2], voffB[2];
#pragma unroll
    for (int i = 0; i < 2; ++i) { int R, C; stage_rc(tid * 16 + i * 8192, R, C); const int Rb = Epi::PERM ? ((R & ~31) + perm32(R & 31)) : R;
        voffA[i] = (unsigned)(R * K + C) * 2u; voffB[i] = (unsigned)(Rb * K + C) * 2u; }
    const size_t kstep = (size_t)(BK * 2);
    const size_t hstep = (size_t)HALF * K * 2;
    const size_t tstep = 2 * hstep;
    const unsigned ldsw = (unsigned)wid * 1024u;
    const int aoff = lds_byte(wr * 64 + fr, fq * 8), boff = lds_byte(wc * 32 + fr, fq * 8);
#define PG8_SA(b, h) (((b) * 2 + (h)) * HTB)
#define PG8_SB(b, h) ((4 + (b) * 2 + (h)) * HTB)
#define PG8_STAGE(bufoff, gbase, voff) do { _Pragma("unroll") for (int _i = 0; _i < 2; ++_i) \
        __builtin_amdgcn_global_load_lds((const unsigned*)((const char*)(gbase) + (voff)[_i]), (PG8_LAS unsigned*)(lds + (bufoff) + ldsw + _i * 8192), 16, 0, 0); } while (0)
#define PG8_LDA(dst, b, h) do { _Pragma("unroll") for (int m = 0; m < 4; ++m) _Pragma("unroll") for (int k = 0; k < 2; ++k) dst[m][k] = *(const PG8_LAS bf16x8*)(lds + PG8_SA(b, h) + aoff + m * 2048 + k * 1024); } while (0)
#define PG8_LDB(dst, b, h) do { _Pragma("unroll") for (int n = 0; n < 2; ++n) _Pragma("unroll") for (int k = 0; k < 2; ++k) dst[n][k] = *(const PG8_LAS bf16x8*)(lds + PG8_SB(b, h) + boff + n * 2048 + k * 1024); } while (0)
#define PG8_MMA(ai, bj, At, Bt) do { __builtin_amdgcn_s_setprio(1); _Pragma("unroll") for (int m = 0; m < 4; ++m) _Pragma("unroll") for (int n = 0; n < 2; ++n) _Pragma("unroll") for (int k = 0; k < 2; ++k) \
        acc[ai][bj][m][n] = __builtin_amdgcn_mfma_f32_16x16x32_bf16(Bt[n][k], At[m][k], acc[ai][bj][m][n], 0, 0, 0); __builtin_amdgcn_s_setprio(0); } while (0)
#define PG8_WAIT_V(n) asm volatile("s_waitcnt vmcnt(" #n ")" ::: "memory")
#define PG8_WAIT_L(n) asm volatile("s_waitcnt lgkmcnt(" #n ")" ::: "memory")
#define PG8_BAR __builtin_amdgcn_s_barrier()
#define PG8_SCHED __builtin_amdgcn_sched_barrier(0)
    Unit cur, nxt; int ui = 0;
    if (!S.next(0, cur)) return;
    f32x4 acc[2][2][4][2];
#pragma unroll
    for (int a = 0; a < 2; ++a)
#pragma unroll
        for (int b = 0; b < 2; ++b)
#pragma unroll
            for (int m = 0; m < 4; ++m)
#pragma unroll
                for (int n = 0; n < 2; ++n) acc[a][b][m][n] = (f32x4){0.f, 0.f, 0.f, 0.f};
    bf16x8 At[4][2], B0[2][2], B1[2][2];
    const char* cA = (const char*)g.A + (size_t)cur.pm * tstep; const char* cB = (const char*)g.Bt + (size_t)cur.pn * tstep;
    S.a_ready(cur);
    if constexpr (SP2) {
        PG8_STAGE(PG8_SB(0, 0), cB, voffB); PG8_STAGE(PG8_SB(0, 1), cB + hstep, voffB); PG8_STAGE(PG8_SA(0, 0), cA, voffA); PG8_STAGE(PG8_SA(0, 1), cA + hstep, voffA);
        if (wr == 1) PG8_BAR;
        PG8_WAIT_V(2); PG8_BAR;
        PG8_STAGE(PG8_SB(1, 0), cB + kstep, voffB); PG8_STAGE(PG8_SA(1, 0), cA + kstep, voffA); PG8_STAGE(PG8_SB(1, 1), cB + hstep + kstep, voffB);
        PG8_WAIT_V(6); PG8_BAR;
    } else {
        PG8_STAGE(PG8_SB(0, 0), cB, voffB); PG8_STAGE(PG8_SA(0, 0), cA, voffA); PG8_STAGE(PG8_SB(0, 1), cB + hstep, voffB); PG8_STAGE(PG8_SA(0, 1), cA + hstep, voffA);
        if (wr == 1) PG8_BAR;
        PG8_WAIT_V(4); PG8_BAR;
        PG8_STAGE(PG8_SB(1, 0), cB + kstep, voffB); PG8_STAGE(PG8_SA(1, 0), cA + kstep, voffA); PG8_STAGE(PG8_SB(1, 1), cB + hstep + kstep, voffB);
        PG8_WAIT_V(6); PG8_BAR;
    }
    for (;;) {
        const bool has_next = S.next(ui + 1, nxt);
        const char* nA = has_next ? (const char*)g.A + (size_t)nxt.pm * tstep : cA; const char* nB = has_next ? (const char*)g.Bt + (size_t)nxt.pn * tstep : cB;
        for (int t = 0; t < nt; t += 2) {
            const bool last = (t == nt - 2);
            const char* a1 = cA + (size_t)(t + 1) * kstep;
            const char* a2 = last ? nA : cA + (size_t)(t + 2) * kstep; const char* b2 = last ? nB : cB + (size_t)(t + 2) * kstep;
            const char* a3 = a2 + kstep; const char* b3 = b2 + kstep;
            if (last && has_next) S.a_ready(nxt);
            if constexpr (SP2) {
            PG8_LDB(B0, 0, 0); PG8_LDB(B1, 0, 1); PG8_SCHED; PG8_LDA(At, 0, 0); PG8_STAGE(PG8_SA(1, 1), a1 + hstep, voffA);
            PG8_WAIT_V(8); PG8_WAIT_L(0); PG8_BAR; PG8_MMA(0, 0, At, B0); PG8_MMA(0, 1, At, B1); PG8_BAR; PG8_SCHED;
            PG8_LDA(At, 0, 1); PG8_STAGE(PG8_SB(0, 0), b2, voffB); PG8_STAGE(PG8_SB(0, 1), b2 + hstep, voffB); PG8_STAGE(PG8_SA(0, 0), a2, voffA);
            PG8_WAIT_V(8); PG8_WAIT_L(0); PG8_BAR; PG8_MMA(1, 0, At, B0); PG8_MMA(1, 1, At, B1); PG8_BAR; PG8_SCHED;
            PG8_LDB(B0, 1, 0); PG8_LDB(B1, 1, 1); PG8_SCHED; PG8_LDA(At, 1, 0); PG8_STAGE(PG8_SA(0, 1), a2 + hstep, voffA);
            PG8_WAIT_V(8); PG8_WAIT_L(0); PG8_BAR; PG8_MMA(0, 0, At, B0); PG8_MMA(0, 1, At, B1); PG8_BAR; PG8_SCHED;
            PG8_LDA(At, 1, 1); PG8_STAGE(PG8_SB(1, 0), b3, voffB); PG8_STAGE(PG8_SB(1, 1), b3 + hstep, voffB); PG8_STAGE(PG8_SA(1, 0), a3, voffA);
            PG8_WAIT_V(8); PG8_WAIT_L(0); PG8_BAR; PG8_MMA(1, 0, At, B0); PG8_MMA(1, 1, At, B1); PG8_BAR; PG8_SCHED;
            } else {
            PG8_LDB(B0, 0, 0); PG8_SCHED; PG8_LDA(At, 0, 0); PG8_STAGE(PG8_SA(1, 1), a1 + hstep, voffA);
            PG8_WAIT_L(8); PG8_BAR; PG8_WAIT_L(0); PG8_MMA(0, 0, At, B0); PG8_BAR; PG8_SCHED;
            PG8_LDB(B1, 0, 1); PG8_STAGE(PG8_SB(0, 0), b2, voffB);
            PG8_BAR; PG8_WAIT_L(0); PG8_MMA(0, 1, At, B1); PG8_BAR;
            PG8_LDA(At, 0, 1); PG8_STAGE(PG8_SA(0, 0), a2, voffA);
            PG8_BAR; PG8_WAIT_L(0); PG8_MMA(1, 0, At, B0); PG8_BAR; PG8_SCHED;
            PG8_STAGE(PG8_SB(0, 1), b2 + hstep, voffB);
            PG8_WAIT_V(6); PG8_BAR; PG8_MMA(1, 1, At, B1); PG8_BAR;
            PG8_LDB(B0, 1, 0); PG8_SCHED; PG8_LDA(At, 1, 0); PG8_STAGE(PG8_SA(0, 1), a2 + hstep, voffA);
            PG8_WAIT_L(8); PG8_BAR; PG8_WAIT_L(0); PG8_MMA(0, 0, At, B0); PG8_BAR; PG8_SCHED;
            PG8_LDB(B1, 1, 1); PG8_STAGE(PG8_SB(1, 0), b3, voffB);
            PG8_BAR; PG8_WAIT_L(0); PG8_MMA(0, 1, At, B1); PG8_BAR;
            PG8_LDA(At, 1, 1); PG8_STAGE(PG8_SA(1, 0), a3, voffA);
            PG8_BAR; PG8_WAIT_L(0); PG8_MMA(1, 0, At, B0); PG8_BAR; PG8_SCHED;
            PG8_STAGE(PG8_SB(1, 1), b3 + hstep, voffB);
            PG8_WAIT_V(6); PG8_BAR; PG8_MMA(1, 1, At, B1); PG8_BAR;
            }
        }
        if constexpr (ALIGN_EPI) { if (wr == 0) PG8_BAR; }
        if constexpr (!Epi::AFTER_DRAIN) { E(acc, cur, wr, wc, fr, fq); S.done(cur); }
        if (!has_next) break;
#pragma unroll
        for (int a = 0; a < 2; ++a)
#pragma unroll
            for (int b = 0; b < 2; ++b)
#pragma unroll
                for (int m = 0; m < 4; ++m)
#pragma unroll
                    for (int n = 0; n < 2; ++n) acc[a][b][m][n] = (f32x4){0.f, 0.f, 0.f, 0.f};
        cur = nxt; cA = nA; cB = nB; ++ui;
        if constexpr (ALIGN_EPI) { if (wr == 1) PG8_BAR; }
    }
    PG8_WAIT_V(0);
    if constexpr (!ALIGN_EPI) { if (wr == 0) PG8_BAR; }
    PG8_BAR;
    if constexpr (Epi::AFTER_DRAIN) { E.fused(acc, cur, wr, wc, fr, fq, lds, wid, lane); S.done(cur); }
#undef PG8_SA
#undef PG8_SB
#undef PG8_STAGE
#undef PG8_LDA
#undef PG8_LDB
#undef PG8_MMA
#undef PG8_WAIT_V
#undef PG8_WAIT_L
#undef PG8_BAR
#undef PG8_SCHED
}
}
namespace attn_body {
using bf16=__hip_bfloat16;
using bf16x8=__attribute__((ext_vector_type(8)))short;
using s16x4=__attribute__((ext_vector_type(4)))short;
using f32x16=__attribute__((ext_vector_type(16)))float;
using u32x4=__attribute__((ext_vector_type(4)))unsigned;
using f32x4_t=__attribute__((ext_vector_type(4)))float;
__device__ __forceinline__ float bf2f(short v){return __uint_as_float(((unsigned)(unsigned short)v)<<16);}
constexpr int D=64;
constexpr int NW=8,QBLK=32,QB=QBLK*NW,KVBLK=64;
__device__ __forceinline__ int crow(int r,int hi){return (r&3)+8*(r>>2)+4*hi;}
#define SBAR() __builtin_amdgcn_sched_barrier(0)
__device__ __forceinline__ void cmask(f32x16&p0,f32x16&p1,int jb,int qrel,int hi){
  const float NEG=-INFINITY; int kb=64*jb+4*hi;
  #pragma unroll
  for(int r=0;r<16;++r){int kv=kb+(r&3)+8*(r>>2); if(kv>qrel)p0[r]=NEG; if(kv+32>qrel)p1[r]=NEG;}
}

constexpr int NSLOT=3, SLOTB=8192;
constexpr int LDS_K=0, LDS_V=NSLOT*SLOTB, LDS_WS=2*NSLOT*SLOTB, LDS_OST=LDS_WS+NW*64*4, LDS_BYTES=LDS_OST+NW*4096;
constexpr float C2=0.125f*1.4426950408889634f;
__device__ __forceinline__ void glds16(const void*gsrc,unsigned lds_dst){unsigned keep;
  asm volatile("s_mov_b32 %0, m0\n\ts_mov_b32 m0, %2\n\ts_nop 0\n\tglobal_load_lds_dwordx4 %1, off\n\ts_mov_b32 m0, %0":"=&s"(keep):"v"(gsrc),"s"(lds_dst):"memory");}
__device__ __forceinline__ float max3f(float a,float b,float c){float r;asm("v_max3_f32 %0, %1, %2, %3":"=v"(r):"v"(a),"v"(b),"v"(c));return r;}
__device__ __forceinline__ float max2f(float a,float b){float r;asm("v_max_f32_e32 %0, %1, %2":"=v"(r):"v"(a),"v"(b));return r;}
__device__ __forceinline__ float fadd_s(float a,float b){float r;asm("v_add_f32_e32 %0, %1, %2":"=v"(r):"v"(a),"v"(b));return r;}
__device__ __forceinline__ float fsub_s(float a,float b){float r;asm("v_sub_f32_e32 %0, %1, %2":"=v"(r):"v"(a),"v"(b));return r;}
typedef float f32x2_t __attribute__((ext_vector_type(2))); typedef __bf16 bf16x2_t __attribute__((ext_vector_type(2)));
__device__ __forceinline__ unsigned cvtpk_s(float lo,float hi){f32x2_t v={lo,hi};bf16x2_t b=__builtin_convertvector(v,bf16x2_t);return __builtin_bit_cast(unsigned,b);}
#define WAIT_BAR(N) asm volatile("s_waitcnt vmcnt(" #N ") lgkmcnt(0)\n\ts_barrier":::"memory")

__device__ __forceinline__ float wave_max_f(float v){
  #define DPPMX(ctrl) v=__builtin_fmaxf(v,__builtin_bit_cast(float,__builtin_amdgcn_update_dpp(__builtin_bit_cast(int,v),__builtin_bit_cast(int,v),(ctrl),0xf,0xf,false)))
  DPPMX(0xB1); DPPMX(0x4E); DPPMX(0x141); DPPMX(0x140);
  #undef DPPMX
  const int vi=__builtin_bit_cast(int,v);
  return __builtin_fmaxf(__builtin_fmaxf(__builtin_bit_cast(float,__builtin_amdgcn_readlane(vi,0)),__builtin_bit_cast(float,__builtin_amdgcn_readlane(vi,16))),__builtin_fmaxf(__builtin_bit_cast(float,__builtin_amdgcn_readlane(vi,32)),__builtin_bit_cast(float,__builtin_amdgcn_readlane(vi,48))));
}
__device__ __forceinline__ void qkt(f32x16&p0,f32x16&p1,const char*Kslot,const bf16x8*qr,const f32x16&negm,int r32,int hi){
  const char*kb=Kslot+hi*1024+r32*16;
  #pragma unroll
  for(int d0=0;d0<4;++d0){
    const bf16x8 b0=*reinterpret_cast<const bf16x8*>(kb+d0*2048);
    const bf16x8 b1=*reinterpret_cast<const bf16x8*>(kb+d0*2048+512);
    if(d0==0){p0=__builtin_amdgcn_mfma_f32_32x32x16_bf16(b0,qr[0],negm,0,0,0);p1=__builtin_amdgcn_mfma_f32_32x32x16_bf16(b1,qr[0],negm,0,0,0);}
    else{p0=__builtin_amdgcn_mfma_f32_32x32x16_bf16(b0,qr[d0],p0,0,0,0);p1=__builtin_amdgcn_mfma_f32_32x32x16_bf16(b1,qr[d0],p1,0,0,0);}}
}
typedef __attribute__((address_space(3))) const char* lds_cptr;
typedef short v4i16_t __attribute__((ext_vector_type(4)));
__device__ __forceinline__ void kload8(bf16x8*kf,lds_cptr kp){
  kf[0]=*(const __attribute__((address_space(3))) bf16x8*)(kp);      kf[1]=*(const __attribute__((address_space(3))) bf16x8*)(kp+512);
  kf[2]=*(const __attribute__((address_space(3))) bf16x8*)(kp+2048); kf[3]=*(const __attribute__((address_space(3))) bf16x8*)(kp+2560);
  kf[4]=*(const __attribute__((address_space(3))) bf16x8*)(kp+4096); kf[5]=*(const __attribute__((address_space(3))) bf16x8*)(kp+4608);
  kf[6]=*(const __attribute__((address_space(3))) bf16x8*)(kp+6144); kf[7]=*(const __attribute__((address_space(3))) bf16x8*)(kp+6656);
}
__device__ __forceinline__ void kload2(bf16x8*kf,lds_cptr kp,int j){ kf[2*j]=*(const __attribute__((address_space(3))) bf16x8*)(kp+j*2048); kf[2*j+1]=*(const __attribute__((address_space(3))) bf16x8*)(kp+j*2048+512); }
__device__ __forceinline__ s16x4 vtr(lds_cptr p){ return __builtin_bit_cast(s16x4,__builtin_amdgcn_ds_read_tr16_b64_v4i16((__attribute__((address_space(3))) v4i16_t*)p)); }
__device__ __forceinline__ float rowmax(const f32x16&p0,const f32x16&p1){
  float a=max3f(p0[0],p0[1],p1[0]),b=max3f(p0[2],p0[3],p1[1]);a=max3f(a,p1[2],p1[3]);
  #pragma unroll
  for(int r=4;r<16;r+=4){a=max3f(a,p0[r],p0[r+1]);b=max3f(b,p0[r+2],p0[r+3]);a=max3f(a,p1[r],p1[r+1]);b=max3f(b,p1[r+2],p1[r+3]);}
  const float m=max2f(a,b);
  auto rr=__builtin_amdgcn_permlane32_swap(__float_as_uint(m),__float_as_uint(m),false,false);
  return max2f(__uint_as_float(rr[0]),__uint_as_float(rr[1]));
}
__device__ __forceinline__ void pv(f32x16*o,int vb,bf16x8 pa0,bf16x8 pa1,bf16x8 pa2,bf16x8 pa3){
  #pragma unroll
  for(int d0=0;d0<2;++d0){s16x4 lo[4],hi[4];
    #pragma unroll
    for(int ks=0;ks<4;++ks){
      asm volatile("ds_read_b64_tr_b16 %0,%1 offset:%c2":"=&v"(lo[ks]):"v"(vb),"i"(d0*4096+ks*1024):"memory");
      asm volatile("ds_read_b64_tr_b16 %0,%1 offset:%c2":"=&v"(hi[ks]):"v"(vb),"i"(d0*4096+ks*1024+512):"memory");}
    asm volatile("s_waitcnt lgkmcnt(0)":::"memory");SBAR();
    #define PK(k) (bf16x8){lo[k][0],lo[k][1],lo[k][2],lo[k][3],hi[k][0],hi[k][1],hi[k][2],hi[k][3]}
    o[d0]=__builtin_amdgcn_mfma_f32_32x32x16_bf16(pa0,PK(0),o[d0],0,0,0);
    o[d0]=__builtin_amdgcn_mfma_f32_32x32x16_bf16(pa1,PK(1),o[d0],0,0,0);
    o[d0]=__builtin_amdgcn_mfma_f32_32x32x16_bf16(pa2,PK(2),o[d0],0,0,0);
    o[d0]=__builtin_amdgcn_mfma_f32_32x32x16_bf16(pa3,PK(3),o[d0],0,0,0);
    #undef PK
  }
}

#ifndef ATTN_STORE16
#define ATTN_STORE16(p,v) (*(u32x4*)(p)=(v))
#endif
template<int THRL,int MODE,int qp,int kvp,int zp> __device__ __forceinline__ void attn_unit(int NT,const bf16*Qu,const bf16*__restrict__ Kh,const bf16*__restrict__ Vh,bf16*Zu,const float*ksum,int nsel,char*shm,const int wave_s,const bool dry=false,const float*rtq=nullptr){
  int lane=__builtin_amdgcn_mbcnt_hi(~0u,__builtin_amdgcn_mbcnt_lo(~0u,0u)); asm volatile("":"+v"(lane));   const int tid=wave_s*64+lane; (void)tid; const int r32=lane&31,hi=lane>>5; float zf=0.f; asm volatile("":"+v"(zf)); const int wid=wave_s;
  const bf16*Qw=Qu+(long)(wid*QBLK)*qp;
  const unsigned lds0=(unsigned)(uintptr_t)shm;
  float*wsf=(float*)(shm+LDS_WS)+wid*64;
  const bf16*ksrc=Kh+(long)lane*kvp+wid*8;
  const bf16*vsrc=Vh+(long)(16*(wid&3)+(lane>>2))*kvp+(wid>>2)*32+(lane&3)*8;
  const unsigned kdst=lds0+LDS_K+wid*1024, vdst=lds0+LDS_V+wid*1024;
  #define DMA_K(t,slot) glds16(ksrc+(long)(t)*KVBLK*kvp,(unsigned)__builtin_amdgcn_readfirstlane(kdst+(slot)))
  #define DMA_V(t,slot) glds16(vsrc+(long)(t)*KVBLK*kvp,(unsigned)__builtin_amdgcn_readfirstlane(vdst+(slot)))
  const int vb0=(int)(lds0+LDS_V)+((lane>>4)&1)*32+(lane&3)*8+(4*hi+((lane&15)>>2))*64;
  const char*Kbase=shm+LDS_K; bf16x8 kf[8];
  const lds_cptr shm3=(lds_cptr)shm; const lds_cptr kp0=shm3+LDS_K+hi*1024+r32*16; const lds_cptr vp0=shm3+LDS_V+((lane>>4)&1)*32+(lane&3)*8+(4*hi+((lane&15)>>2))*64;
  DMA_K(0,0);DMA_V(0,0);DMA_K(1,SLOTB);
  bf16x8 qr[4];
  #pragma unroll
  for(int d0=0;d0<4;++d0)qr[d0]=*reinterpret_cast<const bf16x8*>(&Qw[(long)r32*qp+d0*16+hi*8]);
  if(MODE==1){ const float*rp_=rtq+(long)(wid*QBLK+r32)*64+8*hi;
    _Pragma("unroll") for(int d0=0;d0<4;++d0){ const f32x4_t t0=*(const f32x4_t*)(rp_+16*d0), t1=*(const f32x4_t*)(rp_+16*d0+4);
      const float a0=bf2f(qr[d0][0]),b0=bf2f(qr[d0][1]),a1=bf2f(qr[d0][2]),b1=bf2f(qr[d0][3]),a2=bf2f(qr[d0][4]),b2=bf2f(qr[d0][5]),a3=bf2f(qr[d0][6]),b3=bf2f(qr[d0][7]);
      u32x4 w_; w_[0]=cvtpk_s((a0*t0[0]-b0*t0[1])*C2,(b0*t0[0]+a0*t0[1])*C2); w_[1]=cvtpk_s((a1*t0[2]-b1*t0[3])*C2,(b1*t0[2]+a1*t0[3])*C2);
      w_[2]=cvtpk_s((a2*t1[0]-b2*t1[1])*C2,(b2*t1[0]+a2*t1[1])*C2); w_[3]=cvtpk_s((a3*t1[2]-b3*t1[3])*C2,(b3*t1[2]+a3*t1[3])*C2); qr[d0]=__builtin_bit_cast(bf16x8,w_); } }
  unsigned selmask=0xffffffffu;
  if(MODE==1){ if(nsel>3){ float v0=-INFINITY,v1=-INFINITY,v2=-INFINITY; int i0=0,i1=0,i2=0;
      for(int j=0;j<nsel;++j){ const float*kp=ksum+(long)j*768+hi*8; float g=0.f;
        _Pragma("unroll") for(int d0=0;d0<4;++d0){ const f32x4_t ka=*(const f32x4_t*)(kp+d0*16), kb=*(const f32x4_t*)(kp+d0*16+4);
          g+=bf2f(qr[d0][0])*ka[0]+bf2f(qr[d0][1])*ka[1]+bf2f(qr[d0][2])*ka[2]+bf2f(qr[d0][3])*ka[3]+bf2f(qr[d0][4])*kb[0]+bf2f(qr[d0][5])*kb[1]+bf2f(qr[d0][6])*kb[2]+bf2f(qr[d0][7])*kb[3]; }
        { auto rr_=__builtin_amdgcn_permlane32_swap(__float_as_uint(g),__float_as_uint(g),false,false); g=__uint_as_float(rr_[0])+__uint_as_float(rr_[1]); }
        if(g>v0){v2=v1;i2=i1;v1=v0;i1=i0;v0=g;i0=j;} else if(g>v1){v2=v1;i2=i1;v1=g;i1=j;} else if(g>v2){v2=g;i2=j;} }
      selmask=(1u<<i0)|(1u<<i1)|(1u<<i2); } }
  float mhat=0.f,l_reg=0.f;f32x16 o[2];_Pragma("unroll") for(int r=0;r<16;++r){o[0][r]=zf;o[1][r]=zf;} const f32x16 negm=f32x16{};
  const int qrel=wid*QBLK+r32;
  #define CMASK(P0,P1,t) do{ if(MODE==1){int jb_=(t)-(NT-4); if(jb_>=0)cmask(P0,P1,jb_,qrel,hi);} }while(0)
  bool resc=false;
  #define START(P0,P1) do{ const float rm=rowmax(P0,P1); resc=false; \
    { const float wm_=wave_max_f(rm); const float dl=(rm==-INFINITY)?((wm_==-INFINITY)?0.f:wm_):rm; mhat=fadd_s(mhat,dl);     \
      _Pragma("unroll") for(int r=0;r<16;++r){P0[r]=fsub_s(P0[r],dl);P1[r]=fsub_s(P1[r],dl);} \
      } \
    _Pragma("unroll") for(int r=0;r<16;++r)P0[r]=__builtin_amdgcn_exp2f(P0[r]); }while(0)
  #define RESC() do{ if(resc){ asm volatile("s_waitcnt lgkmcnt(0)":::"memory"); \
      _Pragma("unroll") for(int d_=0;d_<2;++d_) _Pragma("unroll") for(int r=0;r<16;++r)o[d_][r]*=wsf[crow(r,hi)]; } }while(0)
  f32x16 pA0,pA1,pB0,pB1;
  int sl_prev=0,sl_cur=0,sl_next=SLOTB;
  #define ROT() do{sl_prev=sl_cur;sl_cur=sl_next;sl_next=(sl_next==(NSLOT-1)*SLOTB)?0:sl_next+SLOTB;}while(0)
  DMA_K(2,2*SLOTB);
  WAIT_BAR(3);
  qkt(pA0,pA1,Kbase,qr,negm,r32,hi);asm volatile("s_nop 15\n\ts_nop 7":"+v"(pA0),"+v"(pA1));CMASK(pA0,pA1,0);
  if(MODE==1){ const float ms0=(NT>4&&!(selmask&1u))?INFINITY:0.f; _Pragma("unroll") for(int r=0;r<16;++r){pA0[r]-=ms0;pA1[r]-=ms0;} }
  START(pA0,pA1);
  _Pragma("unroll") for(int r=0;r<16;++r)pA1[r]=__builtin_amdgcn_exp2f(pA1[r]);
  WAIT_BAR(0);
  DMA_K(3,0);DMA_V(1,SLOTB);
  ROT();
  kload8(kf,kp0+sl_cur);
  WAIT_BAR(2);
  s16x4 vlo[8],vhi[8]; u32x4 pw0,pw1,pw2,pw3; f32x16 cin;
  #define PKW(P,B) cvtpk_s(P[B],P[B+1])
  #define PAF(k) __builtin_bit_cast(bf16x8,pw##k)
  #define VFR(i) (bf16x8){vlo[i][0],vlo[i][1],vlo[i][2],vlo[i][3],vhi[i][0],vhi[i][1],vhi[i][2],vhi[i][3]}
  #define PIN(x) asm volatile("":"+v"(x))
  #define MX3(a,b,c) __builtin_fmaxf(__builtin_fmaxf((a),(b)),(c))
  #define GAPA(MF,A0,A1,A2,A3,W0,W1,PW) do{ MF; sacc+=A0; sacc+=A1; sacc+=A2; sacc+=A3; PIN(sacc); W0; W1; PIN(PW); SBAR(); }while(0)
  #define EX(v) __builtin_amdgcn_exp2f(v)
  #define GAPB(MF,X,B) do{ MF; X[B]=EX(X[B]); X[B+1]=EX(X[B+1]); X[B+2]=EX(X[B+2]); X[B+3]=EX(X[B+3]); PIN(X); SBAR(); }while(0)
  #define VRD(i) do{ vlo[i]=vtr(vp_+(((i)>>2)*4096+((i)&3)*1024)); vhi[i]=vtr(vp_+(((i)>>2)*4096+((i)&3)*1024+512)); }while(0)
  #define KRD(G,j) do{ if(G){ kload2(kf,kp0+sl_next,j); SBAR(); } }while(0)
  #define STEP(C0,C1,P0,P1,t,GK,GV,GL) do{ { const float cv_=(MODE==1&&(t)<NT-4&&!((selmask>>((t)>>2))&1u))?-INFINITY:-mhat; _Pragma("unroll") for(int r=0;r<16;++r)cin[r]=cv_; asm volatile("":"+v"(cin)); } SBAR(); \
    const lds_cptr vp_=vp0+sl_prev; \
    VRD(0); SBAR(); float sacc=(P0[0]+P0[1]); \
    GAPA(C0=__builtin_amdgcn_mfma_f32_32x32x16_bf16(kf[0],qr[0],cin,0,0,0), P0[2],P0[3],P0[4],P0[5],     pw0[0]=PKW(P0,0), pw0[1]=PKW(P0,2), pw0); \
    VRD(4); SBAR(); GAPA(C1=__builtin_amdgcn_mfma_f32_32x32x16_bf16(kf[1],qr[0],cin,0,0,0), P0[6],P0[7],P0[8],P0[9],     pw0[2]=PKW(P0,4), pw0[3]=PKW(P0,6), pw0); \
    VRD(1); SBAR(); GAPA(C0=__builtin_amdgcn_mfma_f32_32x32x16_bf16(kf[2],qr[1],C0,0,0,0),   P0[10],P0[11],P0[12],P0[13], pw1[0]=PKW(P0,8), pw1[1]=PKW(P0,10), pw1); \
    VRD(5); SBAR(); GAPA(C1=__builtin_amdgcn_mfma_f32_32x32x16_bf16(kf[3],qr[1],C1,0,0,0),   P0[14],P0[15],P1[0],P1[1],   pw1[2]=PKW(P0,12),pw1[3]=PKW(P0,14), pw1); \
    VRD(2); SBAR(); GAPA(C0=__builtin_amdgcn_mfma_f32_32x32x16_bf16(kf[4],qr[2],C0,0,0,0),   P1[2],P1[3],P1[4],P1[5],     pw2[0]=PKW(P1,0), pw2[1]=PKW(P1,2), pw2); \
    VRD(6); SBAR(); GAPA(C1=__builtin_amdgcn_mfma_f32_32x32x16_bf16(kf[5],qr[2],C1,0,0,0),   P1[6],P1[7],P1[8],P1[9],     pw2[2]=PKW(P1,4), pw2[3]=PKW(P1,6), pw2); \
    VRD(3); SBAR(); GAPA(C0=__builtin_amdgcn_mfma_f32_32x32x16_bf16(kf[6],qr[3],C0,0,0,0),   P1[10],P1[11],P1[12],P1[13], pw3[0]=PKW(P1,8), pw3[1]=PKW(P1,10), pw3); \
    VRD(7); SBAR(); GAPA(C1=__builtin_amdgcn_mfma_f32_32x32x16_bf16(kf[7],qr[3],C1,0,0,0),   P1[14],P1[15],0.f,0.f,       pw3[2]=PKW(P1,12),pw3[3]=PKW(P1,14), pw3); \
    l_reg+=sacc; \
    if(GK){DMA_K((t)+3,sl_cur);} if(GV){DMA_V((t)+1,sl_next);} \
    CMASK(C0,C1,t); \
    { float a=MX3(C0[0],C0[1],C1[0]),b=MX3(C0[2],C0[3],C1[1]); a=MX3(a,C1[2],C1[3]); \
      _Pragma("unroll") for(int r=4;r<16;r+=4){a=MX3(a,C0[r],C0[r+1]);b=MX3(b,C0[r+2],C0[r+3]);a=MX3(a,C1[r],C1[r+1]);b=MX3(b,C1[r+2],C1[r+3]);} \
      float rm=__builtin_fmaxf(a,b); { auto rr=__builtin_amdgcn_permlane32_swap(__float_as_uint(rm),__float_as_uint(rm),false,false); rm=__builtin_fmaxf(__uint_as_float(rr[0]),__uint_as_float(rr[1])); } \
      resc=false; \
      if(__builtin_expect(__any(rm>(float)THRL),0)){ const float dl=__builtin_fmaxf(rm,0.f); mhat+=dl; \
        _Pragma("unroll") for(int r=0;r<16;++r){C0[r]-=dl;C1[r]-=dl;} \
        const float f=__builtin_amdgcn_exp2f(-dl); l_reg*=f; if(hi==0)wsf[r32]=f; resc=true; } } \
    SBAR(); \
    GAPB(o[0]=__builtin_amdgcn_mfma_f32_32x32x16_bf16(PAF(0),VFR(0),o[0],0,0,0), C0,0); \
    GAPB(o[1]=__builtin_amdgcn_mfma_f32_32x32x16_bf16(PAF(0),VFR(4),o[1],0,0,0), C0,4); \
    KRD(GL,0); GAPB(o[0]=__builtin_amdgcn_mfma_f32_32x32x16_bf16(PAF(1),VFR(1),o[0],0,0,0), C0,8); \
    KRD(GL,1); GAPB(o[1]=__builtin_amdgcn_mfma_f32_32x32x16_bf16(PAF(1),VFR(5),o[1],0,0,0), C0,12); \
    KRD(GL,2); GAPB(o[0]=__builtin_amdgcn_mfma_f32_32x32x16_bf16(PAF(2),VFR(2),o[0],0,0,0), C1,0); \
    KRD(GL,3); GAPB(o[1]=__builtin_amdgcn_mfma_f32_32x32x16_bf16(PAF(2),VFR(6),o[1],0,0,0), C1,4); \
    GAPB(o[0]=__builtin_amdgcn_mfma_f32_32x32x16_bf16(PAF(3),VFR(3),o[0],0,0,0), C1,8); \
    GAPB(o[1]=__builtin_amdgcn_mfma_f32_32x32x16_bf16(PAF(3),VFR(7),o[1],0,0,0), C1,12); \
    }while(0)
  int t=1;
  #undef CMASK
  #define CMASK(P0,P1,t) do{ if(MODE==1){int jb_=(t)-(NT-4); if(jb_>=0)cmask(P0,P1,jb_,qrel,hi);} }while(0)
  for(;t+5<NT;t+=2){
    STEP(pB0,pB1,pA0,pA1,t,true,true,true);     WAIT_BAR(2); RESC(); ROT();
    STEP(pA0,pA1,pB0,pB1,t+1,true,true,true);   WAIT_BAR(2); RESC(); ROT();
  }
  #undef CMASK
  #define CMASK(P0,P1,t) do{ if(MODE==1){int jb_=(t)-(NT-4); if(jb_>=0)cmask(P0,P1,jb_,qrel,hi);} }while(0)
  #define ENDW(tt) do{ if((tt)+3<NT){WAIT_BAR(2);} else if((tt)+2<NT){WAIT_BAR(1);} else {WAIT_BAR(0);} }while(0)
  for(;t+1<NT;t+=2){
    STEP(pB0,pB1,pA0,pA1,t,(t+3<NT),(t+1<NT),(t+1<NT));       ENDW(t);   RESC(); ROT();
    STEP(pA0,pA1,pB0,pB1,t+1,(t+4<NT),(t+2<NT),(t+2<NT));     ENDW(t+1); RESC(); ROT();
  }
  STEP(pB0,pB1,pA0,pA1,NT-1,false,false,false); RESC();
  { float sacc=pB0[0]+pB0[1]; _Pragma("unroll") for(int r=2;r<16;++r)sacc+=pB0[r]; _Pragma("unroll") for(int r=0;r<16;++r)sacc+=pB1[r]; l_reg+=sacc;
    pw0=(u32x4){PKW(pB0,0),PKW(pB0,2),PKW(pB0,4),PKW(pB0,6)};pw1=(u32x4){PKW(pB0,8),PKW(pB0,10),PKW(pB0,12),PKW(pB0,14)};pw2=(u32x4){PKW(pB1,0),PKW(pB1,2),PKW(pB1,4),PKW(pB1,6)};pw3=(u32x4){PKW(pB1,8),PKW(pB1,10),PKW(pB1,12),PKW(pB1,14)};
    SBAR(); pv(o,vb0+sl_cur,PAF(0),PAF(1),PAF(2),PAF(3)); }
  #undef PKW
  #undef PAF
  #undef VFR
  #undef PIN
  #undef MX3
  #undef GAPA
  #undef GAPB
  #undef EX
  #undef VRD
  #undef KRD
  #undef STEP
  #undef ENDW
  bf16*Zw=Zu+(long)(wid*QBLK)*zp;
  u32x4 zq[4];
  #pragma unroll
  for(int i=0;i<4;++i)zq[i]=*(const u32x4*)(Zw+(long)(i*8+(lane>>3))*zp+(lane&7)*8);
  {auto rr=__builtin_amdgcn_permlane32_swap(__float_as_uint(l_reg),__float_as_uint(l_reg),false,false);l_reg=__uint_as_float(rr[0])+__uint_as_float(rr[1]);}
  if(hi==0)wsf[32+r32]=l_reg;asm volatile("s_waitcnt lgkmcnt(0)":::"memory");
  float rli[16];
  #pragma unroll
  for(int r=0;r<16;++r)rli[r]=__builtin_amdgcn_rcpf(wsf[32+crow(r,hi)]);
  { bf16*stg=(bf16*)(shm+LDS_OST)+wid*2048;
    #pragma unroll
    for(int r=0;r<16;++r){const int orow=crow(r,hi);
      #pragma unroll
      for(int d0=0;d0<2;++d0)stg[orow*64+d0*32+r32]=__float2bfloat16(o[d0][r]*rli[r]);}
    asm volatile("s_waitcnt lgkmcnt(0)":::"memory");
    #pragma unroll
    for(int i=0;i<4;++i){const int row=i*8+(lane>>3),ch=lane&7; const u32x4 v=*(const u32x4*)(stg+row*64+ch*8); u32x4*zpz=(u32x4*)(Zw+(long)row*zp+ch*8); const u32x4 zz=zq[i]; u32x4 yy;
      _Pragma("unroll") for(int e=0;e<4;++e){ const float o0=__uint_as_float(v[e]<<16),o1=__uint_as_float(v[e]&0xffff0000u),z0=__uint_as_float(zz[e]<<16),z1=__uint_as_float(zz[e]&0xffff0000u);
        yy[e]=cvtpk_s(o0*z0*__builtin_amdgcn_rcpf(1.f+__expf(-z0)),o1*z1*__builtin_amdgcn_rcpf(1.f+__expf(-z1))); }
      if(!dry)*zpz=yy;} }
  asm volatile("s_waitcnt lgkmcnt(0)\n\ts_barrier":::"memory");
  #undef DMA_K
  #undef DMA_V
  #undef CMASK
  #undef START
  #undef RESC
  #undef ROT
}
constexpr int ATTN_LDS_BYTES=LDS_BYTES;
#undef SBAR
#undef WAIT_BAR
}
namespace cg = cooperative_groups;
constexpr int BATCH = 8, SEQ = 4096, DM = 1024, M = BATCH * SEQ;
constexpr int NMEM = 256, MROWS = BATCH * NMEM;
constexpr int N_IN0 = 3608, N_IN0P = 3840, N_IN1 = 3584;
constexpr int NUNIT_D = BATCH * 12 * 64;
constexpr float C2 = 0.125f * 1.4426950408889634f;
constexpr float EPS = 1e-6f;
constexpr int NTHREADS = 512;
constexpr int LDS_BYTES = 161792 + 512;
constexpr size_t MiB = 1u << 20;
constexpr size_t WS_KSUM = 0;
constexpr size_t WS_GL = 512 * 1024;
constexpr size_t WS_WCAT0 = 2 * MiB;
constexpr size_t WS_WOUT0 = 12 * MiB, WS_WIN1 = 14 * MiB, WS_WOUT1 = 21 * MiB;
constexpr size_t WS_ROPE = 24 * MiB;
constexpr size_t WS_ACAT = 32 * MiB;
constexpr size_t WS_MKV = 104 * MiB;
constexpr size_t WS_QKV = 108 * MiB;
constexpr size_t WS_Z = 252 * MiB;
constexpr size_t WS_MQ = 316 * MiB;
constexpr size_t WS_BA = 332 * MiB;
constexpr size_t WS_DW = WS_ACAT;
constexpr size_t WS_DU = 336 * MiB, WS_DA = 384 * MiB;
constexpr size_t WS_PS = 432 * MiB;
constexpr size_t WS_END = 434 * MiB;

#define LAS __attribute__((address_space(3)))
typedef unsigned short bf16;
typedef unsigned v4u __attribute__((ext_vector_type(4)));
typedef unsigned v2u __attribute__((ext_vector_type(2)));
typedef float f32x4 __attribute__((ext_vector_type(4)));
typedef float f32x2v __attribute__((ext_vector_type(2)));
typedef __bf16 bf16x2v __attribute__((ext_vector_type(2)));
typedef short bf16x8 __attribute__((ext_vector_type(8)));
#define LDS_WAIT() asm volatile("s_waitcnt lgkmcnt(0)" ::: "memory")
__device__ __forceinline__ unsigned pk2(float lo, float hi) { f32x2v v = {lo, hi}; bf16x2v b = __builtin_convertvector(v, bf16x2v); return __builtin_bit_cast(unsigned, b); }
__device__ __forceinline__ float bflo(unsigned u) { return __uint_as_float(u << 16); }
__device__ __forceinline__ float bfhi(unsigned u) { return __uint_as_float(u & 0xffff0000u); }
__device__ __forceinline__ float bf1(bf16 u) { return __uint_as_float(((unsigned)u) << 16); }
__device__ __forceinline__ float dppf(float v, const int ctrl_dummy);
#define DPP_ADD(v, ctrl) ((v) + __builtin_bit_cast(float, __builtin_amdgcn_update_dpp(0, __builtin_bit_cast(int, (v)), (ctrl), 0xf, 0xf, true)))
__device__ __forceinline__ float row8_sum(float v) { v = DPP_ADD(v, 0xB1); v = DPP_ADD(v, 0x4E); v = DPP_ADD(v, 0x141); return v; }
__device__ __forceinline__ float row16_sum(float v) { v = row8_sum(v); v = DPP_ADD(v, 0x140); return v; }
__device__ __forceinline__ float wave_sum(float v) {
    v = row16_sum(v); const int vi = __builtin_bit_cast(int, v);
    return (__builtin_bit_cast(float, __builtin_amdgcn_readlane(vi, 0)) + __builtin_bit_cast(float, __builtin_amdgcn_readlane(vi, 16))) + (__builtin_bit_cast(float, __builtin_amdgcn_readlane(vi, 32)) + __builtin_bit_cast(float, __builtin_amdgcn_readlane(vi, 48)));
}
__device__ __forceinline__ float silu_f(float x) { return x * __builtin_amdgcn_rcpf(1.f + __expf(-x)); }
__device__ const float ROPE_INVF[32] = {1.000000000e+00f, 7.498942614e-01f, 5.623413324e-01f, 4.216965139e-01f, 3.162277639e-01f, 2.371373773e-01f, 1.778279394e-01f, 1.333521307e-01f, 1.000000015e-01f, 7.498941571e-02f, 5.623413250e-02f, 4.216965288e-02f, 3.162277490e-02f, 2.371373773e-02f, 1.778279431e-02f, 1.333521493e-02f, 9.999999776e-03f, 7.498941850e-03f, 5.623413250e-03f, 4.216964822e-03f, 3.162277630e-03f, 2.371373586e-03f, 1.778279431e-03f, 1.333521446e-03f, 1.000000047e-03f, 7.498942432e-04f, 5.623413017e-04f, 4.216965172e-04f, 3.162277571e-04f, 2.371373703e-04f, 1.778279402e-04f, 1.333521504e-04f};

struct OrderX {
    int nM, nN, nwg, G, c, nextra;
    __device__ void init(int nM_, int nN_, int G_, int c_, int nextra_) { nM = nM_; nN = nN_; nwg = nM * nN; G = G_; c = c_; nextra = nextra_; }
    __device__ bool next(int i, pg8::Unit& u) const {
        const long L = (long)i * G + c; if (L >= nwg + nextra) return false;
        if (L >= nwg) { const int e = (int)L - nwg, layer = e >> 4; u.pm = 128 + 8 * layer + ((e & 15) >> 1); u.pn = 15 + 2 * layer + (e & 1); return true; }
        int wgid = (int)L; { const int q = nwg / pg8::NXCD, r = nwg % pg8::NXCD, xcd = wgid % pg8::NXCD, off = wgid / pg8::NXCD; wgid = (xcd < r ? xcd * (q + 1) : r * (q + 1) + (xcd - r) * q) + off; }
        const int nig = pg8::WGM * nN, gid = wgid / nig, fm = gid * pg8::WGM, gsz = (nM - fm) < pg8::WGM ? (nM - fm) : pg8::WGM;
        u.pm = fm + ((wgid % nig) % gsz); u.pn = (wgid % nig) / gsz; return true;
    }
    __device__ __forceinline__ void a_ready(const pg8::Unit&) const {}
    __device__ __forceinline__ void done(const pg8::Unit&) const {}
};
struct EpiIn0 {
    static constexpr bool PERM = true, AFTER_DRAIN = false;
    bf16 *QKV, *Z, *MQ, *MKV; float* BA;
    __device__ __forceinline__ void operator()(const f32x4 (&acc)[2][2][4][2], const pg8::Unit& u, int wr, int wc, int fr_in, int fq_in) const {
        int fr = fr_in, fq = fq_in; asm volatile("" : "+v"(fr), "+v"(fq));
        const int pm = u.pm, pn = u.pn; bf16* base = QKV; int ld = 2304, colt = pn * 256, rowt = pm * 256; float sc = 1.f; bool isba = false;
        if (pm < 128) {
            if (pn < 9) {}
            else if (pn < 13) { base = Z; ld = 1024; colt = (pn - 9) * 256; }
            else if (pn == 13) { base = MQ; ld = 256; colt = 0; sc = C2; }
            else isba = true;
        } else { const int layer = (pm - 128) >> 3; base = MKV + (size_t)layer * (MROWS * 512); ld = 512; colt = (pn - 15 - 2 * layer) * 256; rowt = (pm - 128 - 8 * layer) * 256; }
        const int row0 = rowt + wr * 64 + fr, col0 = colt + wc * 32 + 8 * fq;
        if (!isba) {
#pragma unroll
            for (int ai = 0; ai < 2; ++ai)
#pragma unroll
                for (int m = 0; m < 4; ++m) { bf16* rowp = base + (unsigned)((row0 + ai * 128 + m * 16) * ld + col0);
#pragma unroll
                    for (int bj = 0; bj < 2; ++bj) { const f32x4 v0 = acc[ai][bj][m][0] * sc, v1 = acc[ai][bj][m][1] * sc; v4u w; w.x = pk2(v0[0], v0[1]); w.y = pk2(v0[2], v0[3]); w.z = pk2(v1[0], v1[1]); w.w = pk2(v1[2], v1[3]);
                        *(v4u*)(rowp + bj * 128) = w; } }
        } else if (wc == 0) {
#pragma unroll
            for (int ai = 0; ai < 2; ++ai)
#pragma unroll
                for (int m = 0; m < 4; ++m) { float* p = BA + (unsigned)((row0 + ai * 128 + m * 16) * 32 + 8 * fq); *(f32x4*)p = acc[ai][0][m][0]; *(f32x4*)(p + 4) = acc[ai][0][m][1]; }
        }
    }
};
struct EpiIn1 {
    static constexpr bool PERM = true, AFTER_DRAIN = false;
    bf16 *QKV, *Z, *MQ;
    __device__ __forceinline__ void operator()(const f32x4 (&acc)[2][2][4][2], const pg8::Unit& u, int wr, int wc, int fr, int fq) const {
        const int pm = u.pm, pn = u.pn; bf16* base; int ld = 768, colt; float sc = 1.f;
        if (pn < 9) { const int t = pn / 3; base = QKV + (size_t)t * M * 768; colt = (pn - 3 * t) * 256; }
        else if (pn < 13) { base = Z; ld = 1024; colt = (pn - 9) * 256; }
        else { base = MQ; ld = 256; colt = 0; sc = C2; }
        const int row0 = pm * 256 + wr * 64 + fr, col0 = colt + wc * 32 + 8 * fq;
#pragma unroll
        for (int ai = 0; ai < 2; ++ai)
#pragma unroll
            for (int m = 0; m < 4; ++m) { bf16* rowp = base + (unsigned)((row0 + ai * 128 + m * 16) * ld + col0);
#pragma unroll
                for (int bj = 0; bj < 2; ++bj) { const f32x4 v0 = acc[ai][bj][m][0] * sc, v1 = acc[ai][bj][m][1] * sc; v4u w; w.x = pk2(v0[0], v0[1]); w.y = pk2(v0[2], v0[3]); w.z = pk2(v1[0], v1[1]); w.w = pk2(v1[2], v1[3]);
                    *(v4u*)(rowp + bj * 128) = w; } }
    }
};
__device__ __forceinline__ void p6b_rope(LAS unsigned char* lds, int G, bf16* K, const float* __restrict__ RT, float* KSUM, const int wave_s) {
    int lane_ = __builtin_amdgcn_mbcnt_hi(~0u, __builtin_amdgcn_mbcnt_lo(~0u, 0u)); asm volatile("" : "+v"(lane_)); const int tid = wave_s * 64 + lane_;
    LAS float* red = (LAS float*)lds;
    for (int u = blockIdx.x; u < 256; u += G) {
        const int pm = u >> 1, ch = u & 1;
        float cs[8];
#pragma unroll
        for (int e = 0; e < 8; ++e) cs[e] = 0.f;
        const int cc = tid % 48, rg = tid / 48, col = 384 * ch + 8 * cc, i0 = ((col & 63) >> 1);
        if (tid < 384) {
#pragma unroll 4
            for (int rr = 0; rr < 32; ++rr) { const int row = pm * 256 + rg * 32 + rr; v4u* p = (v4u*)(K + (unsigned)(row * 768 + col)); const v4u w = *p;
                const f32x4 t0 = *(const f32x4*)(RT + (unsigned)(row * 64 + 2 * i0)), t1 = *(const f32x4*)(RT + (unsigned)(row * 64 + 2 * i0 + 4)); float o[8];
                { const float a = bflo(w.x), b = bfhi(w.x); o[0] = a * t0[0] - b * t0[1]; o[1] = b * t0[0] + a * t0[1]; }
                { const float a = bflo(w.y), b = bfhi(w.y); o[2] = a * t0[2] - b * t0[3]; o[3] = b * t0[2] + a * t0[3]; }
                { const float a = bflo(w.z), b = bfhi(w.z); o[4] = a * t1[0] - b * t1[1]; o[5] = b * t1[0] + a * t1[1]; }
                { const float a = bflo(w.w), b = bfhi(w.w); o[6] = a * t1[2] - b * t1[3]; o[7] = b * t1[2] + a * t1[3]; }
#pragma unroll
                for (int e = 0; e < 8; ++e) cs[e] += o[e];
                v4u y; y.x = pk2(o[0], o[1]); y.y = pk2(o[2], o[3]); y.z = pk2(o[4], o[5]); y.w = pk2(o[6], o[7]); *p = y; }
#pragma unroll
            for (int e = 0; e < 8; ++e) red[rg * 384 + cc * 8 + e] = cs[e];
        }
        __syncthreads();
        if (tid < 384) { float s = 0.f;
#pragma unroll
            for (int g8 = 0; g8 < 8; ++g8) s += red[g8 * 384 + tid];
            KSUM[(unsigned)(pm * 768 + 384 * ch + tid)] = s; }
        __syncthreads();
    }
}
struct EpiOut {
    static constexpr bool PERM = true, AFTER_DRAIN = false;
    const float* resid; float* out;
    __device__ __forceinline__ void operator()(const f32x4 (&acc)[2][2][4][2], const pg8::Unit& u, int wr, int wc, int fr_in, int fq_in) const {
        int fr = fr_in, fq = fq_in; asm volatile("" : "+v"(fr), "+v"(fq));
        const int row0 = u.pm * 256 + wr * 64 + fr, col0 = u.pn * 256 + wc * 32 + 8 * fq;
#pragma unroll
        for (int ai = 0; ai < 2; ++ai)
#pragma unroll
            for (int m = 0; m < 4; ++m) { const unsigned off = (unsigned)((row0 + ai * 128 + m * 16) * DM + col0);
#pragma unroll
                for (int bj = 0; bj < 2; ++bj) { const f32x4 r0 = *(const f32x4*)(resid + off + bj * 128), r1 = *(const f32x4*)(resid + off + bj * 128 + 4);
                    *(f32x4*)(out + off + bj * 128) = r0 + acc[ai][bj][m][0]; *(f32x4*)(out + off + bj * 128 + 4) = r1 + acc[ai][bj][m][1]; } }
    }
};
struct EpiOutN {
    static constexpr bool PERM = true, AFTER_DRAIN = false;
    const float* resid; float* out; const float* gain; bf16* XN; float* PS;
    __device__ __forceinline__ void operator()(const f32x4 (&acc)[2][2][4][2], const pg8::Unit& u, int wr, int wc, int fr_in, int fq_in) const {
        int fr = fr_in, fq = fq_in; asm volatile("" : "+v"(fr), "+v"(fq));
        const int row0 = u.pm * 256 + wr * 64 + fr, col0 = u.pn * 256 + wc * 32 + 8 * fq;
        f32x4 gv[2][2];
#pragma unroll
        for (int bj = 0; bj < 2; ++bj) { gv[bj][0] = *(const f32x4*)(gain + col0 + bj * 128); gv[bj][1] = *(const f32x4*)(gain + col0 + bj * 128 + 4); }
#pragma unroll
        for (int ai = 0; ai < 2; ++ai)
#pragma unroll
            for (int m = 0; m < 4; ++m) { const int row = row0 + ai * 128 + m * 16; const unsigned off = (unsigned)(row * DM + col0); float ss = 0.f;
#pragma unroll
                for (int bj = 0; bj < 2; ++bj) { const f32x4 r0 = *(const f32x4*)(resid + off + bj * 128), r1 = *(const f32x4*)(resid + off + bj * 128 + 4);
                    const f32x4 h0 = r0 + acc[ai][bj][m][0], h1 = r1 + acc[ai][bj][m][1];
                    *(f32x4*)(out + off + bj * 128) = h0; *(f32x4*)(out + off + bj * 128 + 4) = h1;
                    ss += (h0[0] * h0[0] + h0[1] * h0[1]) + (h0[2] * h0[2] + h0[3] * h0[3]) + (h1[0] * h1[0] + h1[1] * h1[1]) + (h1[2] * h1[2] + h1[3] * h1[3]);
                    const f32x4 y0 = h0 * gv[bj][0], y1 = h1 * gv[bj][1]; v4u w; w.x = pk2(y0[0], y0[1]); w.y = pk2(y0[2], y0[3]); w.z = pk2(y1[0], y1[1]); w.w = pk2(y1[2], y1[3]);
                    *(v4u*)(XN + off + bj * 128) = w; }
                ss += __shfl_xor(ss, 16); ss += __shfl_xor(ss, 32);
                if (fq == 0) PS[(unsigned)(row * 16 + u.pn * 4 + wc)] = ss;
                if (m & 1) asm volatile("" ::: "memory"); }
    }
};

__device__ __forceinline__ int rope_row(int n) { const int d = n & 63; return (n - d) + ((d < 32) ? 2 * d : 2 * (d - 32) + 1); }
__device__ __forceinline__ void p0_transpose_item(const float* W, int K, int N, int nblk, bf16* WT, int row_off, bool ropeperm, LAS float* scr, int item, int lane) {
    const int kb = item / nblk, nb = item % nblk, k0 = 64 * kb, n0 = 32 * nb;
    const int nn = n0 + (lane & 31);
#pragma unroll 8
    for (int i = 0; i < 32; ++i) { const int kk = 2 * i + (lane >> 5); scr[kk * 33 + (lane & 31)] = (nn < N) ? W[(size_t)(k0 + kk) * N + nn] : 0.f; }
    LDS_WAIT(); asm volatile("" ::: "memory");
    const int c = lane & 7;
#pragma unroll
    for (int j = 0; j < 4; ++j) { const int nl = (lane >> 3) + 8 * j; const LAS float* s = scr + (8 * c) * 33 + nl; int n = n0 + nl; if (ropeperm && n < 1536) n = rope_row(n);
        v4u o; o.x = pk2(s[0 * 33], s[1 * 33]); o.y = pk2(s[2 * 33], s[3 * 33]); o.z = pk2(s[4 * 33], s[5 * 33]); o.w = pk2(s[6 * 33], s[7 * 33]);
        *(v4u*)(WT + (size_t)(row_off + n) * K + k0 + 8 * c) = o; }
    LDS_WAIT(); asm volatile("" ::: "memory");
}
__device__ __forceinline__ void rms_row_to_bf16(const float* xrow, const float* g0, bf16* o0, const float* g1, bf16* o1, int lane) {
    const f32x4* xr = (const f32x4*)xrow + lane; f32x4 v[4]; float s = 0.f;
#pragma unroll
    for (int j = 0; j < 4; ++j) { v[j] = xr[64 * j]; s += (v[j].x * v[j].x + v[j].y * v[j].y) + (v[j].z * v[j].z + v[j].w * v[j].w); }
    const float rstd = rsqrtf(wave_sum(s) * (1.f / DM) + EPS);
#pragma unroll
    for (int j = 0; j < 4; ++j) { const f32x4 g = ((const f32x4*)g0)[lane + 64 * j]; const f32x4 y = v[j] * rstd * g; v2u w; w.x = pk2(y.x, y.y); w.y = pk2(y.z, y.w); ((v2u*)o0)[lane + 64 * j] = w; }
    if (g1) {
#pragma unroll
        for (int j = 0; j < 4; ++j) { const f32x4 g = ((const f32x4*)g1)[lane + 64 * j]; const f32x4 y = v[j] * rstd * g; v2u w; w.x = pk2(y.x, y.y); w.y = pk2(y.z, y.w); ((v2u*)o1)[lane + 64 * j] = w; }
    }
}

__device__ __forceinline__ void rms_row2_to_bf16(const float* xa, const float* xb, const float* g0, bf16* oa, bf16* ob, int lane) {
    const f32x4* ra = (const f32x4*)xa + lane; const f32x4* rb = (const f32x4*)xb + lane; f32x4 va[4], vb[4]; float sa = 0.f, sb = 0.f;
#pragma unroll
    for (int j = 0; j < 4; ++j) { va[j] = ra[64 * j]; vb[j] = rb[64 * j]; }
#pragma unroll
    for (int j = 0; j < 4; ++j) { sa += (va[j].x * va[j].x + va[j].y * va[j].y) + (va[j].z * va[j].z + va[j].w * va[j].w); sb += (vb[j].x * vb[j].x + vb[j].y * vb[j].y) + (vb[j].z * vb[j].z + vb[j].w * vb[j].w); }
    const float rsa = rsqrtf(wave_sum(sa) * (1.f / DM) + EPS), rsb = rsqrtf(wave_sum(sb) * (1.f / DM) + EPS);
#pragma unroll
    for (int j = 0; j < 4; ++j) { const f32x4 g = ((const f32x4*)g0)[lane + 64 * j]; const f32x4 ya = va[j] * rsa * g, yb = vb[j] * rsb * g; v2u wa, wb; wa.x = pk2(ya.x, ya.y); wa.y = pk2(ya.z, ya.w); wb.x = pk2(yb.x, yb.y); wb.y = pk2(yb.z, yb.w);
        ((v2u*)oa)[lane + 64 * j] = wa; ((v2u*)ob)[lane + 64 * j] = wb; }
}
__device__ __forceinline__ int dstperm(int k) { return (k & ~31) + 8 * ((k >> 2) & 3) + 4 * ((k >> 4) & 1) + (k & 3); }
constexpr int P2_TEAM_BYTES = 80896;
typedef short bf16x4 __attribute__((ext_vector_type(4)));
__device__ __forceinline__ bf16x4 cvt4(f32x4 v) { v2u w; w.x = pk2(v[0], v[1]); w.y = pk2(v[2], v[3]); return __builtin_bit_cast(bf16x4, w); }
#define LBAR() do { asm volatile("s_waitcnt lgkmcnt(0)" ::: "memory"); __builtin_amdgcn_s_barrier(); asm volatile("" ::: "memory"); } while (0)
__device__ __forceinline__ void p2_delta_prep(LAS unsigned char* lds, int G, const bf16* __restrict__ QKV, const float* __restrict__ BA, const float* __restrict__ conv_w, const float* __restrict__ a_log,
                                              const float* __restrict__ dt_bias, bf16* __restrict__ DQG, bf16* __restrict__ DKDT, bf16* __restrict__ DW, bf16* __restrict__ DU, bf16* __restrict__ DA, float* __restrict__ GL, const int wave_s, const int lim = 4) {
    const int team = wave_s >> 2, wt = wave_s & 3;
    LAS unsigned char* tb = lds + team * P2_TEAM_BYTES;
    LAS bf16* Qs = (LAS bf16*)tb; LAS bf16* Ks = (LAS bf16*)(tb + 9216); LAS bf16* As = (LAS bf16*)(tb + 18432);
    LAS float* RHS = (LAS float*)(tb + 27648); LAS float* Lm = (LAS float*)(tb + 60416); LAS float* gc = (LAS float*)(tb + 76800); LAS float* bt = (LAS float*)(tb + 77056); LAS float* eq = (LAS float*)(tb + 77312); LAS float* ek = (LAS float*)(tb + 77568); LAS float* CW = (LAS float*)(tb + 77824);
    const int nteams = G * 2, per = (NUNIT_D + nteams - 1) / nteams, ubase = ((int)blockIdx.x * 2 + team) * per;
    v4u raw[3][5]; float ba_b = 0.f, ba_a = 0.f;
#define P2_FETCH(uid_) do { const int bh_ = (uid_) >> 6, c_ = (uid_) & 63, b_ = bh_ / 12, h_ = bh_ - 12 * b_; const size_t r0_ = (size_t)b_ * SEQ + (size_t)c_ * 64; \
        _Pragma("unroll") for (int mtx = 0; mtx < 3; ++mtx) _Pragma("unroll") for (int r = 0; r < 5; ++r) { const int s = c_ * 64 + t0 - 3 + r; \
            raw[mtx][r] = *(const v4u*)(QKV + (r0_ + (s >= 0 ? t0 - 3 + r : 0)) * 2304 + mtx * 768 + h_ * 64 + 8 * dg); }     \
        ba_b = BA[(r0_ + lane) * 32 + h_]; ba_a = BA[(r0_ + lane) * 32 + 12 + h_]; } while (0)
    int h_prev = -1; float h_nal = 0.f, h_dtb = 0.f;
    { int lane = __builtin_amdgcn_mbcnt_hi(~0u, __builtin_amdgcn_mbcnt_lo(~0u, 0u)); asm volatile("" : "+v"(lane)); const int tt = wt * 64 + lane, dg = tt & 7, t0 = (tt >> 3) * 2; if (ubase < NUNIT_D) P2_FETCH(ubase); }
    for (int it = 0; it < per; ++it) {
        int lane = __builtin_amdgcn_mbcnt_hi(~0u, __builtin_amdgcn_mbcnt_lo(~0u, 0u)); asm volatile("" : "+v"(lane));
        const int tt = wt * 64 + lane, dg = tt & 7, t0 = (tt >> 3) * 2;
        const int rt_ = tt ^ (team << 7);
        const int uid = ubase + it; const bool act = uid < NUNIT_D;
        const int bh = uid >> 6, b = bh / 12, h = bh - 12 * b;
        if (act && h != h_prev) {
            h_nal = -__expf(a_log[h]); h_dtb = dt_bias[h];
            for (int i = tt; i < 768; i += 256) { const int mtx = i >> 8, tap = (i >> 6) & 3, dd = i & 63; CW[i] = conv_w[tap * 2304 + mtx * 768 + h * 64 + dd]; }
        }
        h_prev = h;
        LBAR();
        if (act) {
            { const float beta = __builtin_amdgcn_rcpf(1.f + __expf(-ba_b)); const float xx = ba_a + h_dtb; const float sp = xx > 20.f ? xx : log1pf(__expf(xx));
              const float g0 = h_nal * sp;
#define DPPF(src, ctrl, rm, bm) __builtin_bit_cast(float, __builtin_amdgcn_update_dpp(0, __builtin_bit_cast(int, (src)), (ctrl), (rm), (bm), false))
              float g = g0 + DPPF(g0, 0x111, 0xf, 0xf); g += DPPF(g0, 0x112, 0xf, 0xf); g += DPPF(g0, 0x113, 0xf, 0xf);
              g += DPPF(g, 0x114, 0xf, 0xe); g += DPPF(g, 0x118, 0xf, 0xc); g += DPPF(g, 0x142, 0xa, 0xf); g += DPPF(g, 0x143, 0xc, 0xf);
#undef DPPF
              const float gl_ = __builtin_bit_cast(float, __builtin_amdgcn_readlane(__builtin_bit_cast(int, g), 63));
              gc[lane] = g; bt[lane] = beta; eq[lane] = __expf(g); ek[lane] = __expf(gl_ - g); }
            { const int c_now = uid & 63;
#pragma unroll
              for (int r = 0; r < 5; ++r) if (c_now * 64 + t0 - 3 + r < 0) {
#pragma unroll
                  for (int mtx = 0; mtx < 3; ++mtx) raw[mtx][r] = (v4u){0u, 0u, 0u, 0u}; } }
            float q[2][8], k[2][8], v[2][8];
#pragma unroll
            for (int mtx = 0; mtx < 3; ++mtx) {
                f32x4 cw[4][2];
#pragma unroll
                for (int tap = 0; tap < 4; ++tap) { cw[tap][0] = *(const LAS f32x4*)(CW + mtx * 256 + tap * 64 + 8 * dg); cw[tap][1] = *(const LAS f32x4*)(CW + mtx * 256 + tap * 64 + 8 * dg + 4); }
#pragma unroll
                for (int tk = 0; tk < 2; ++tk) { float o[8];
#pragma unroll
                    for (int e = 0; e < 8; ++e) o[e] = 0.f;
#pragma unroll
                    for (int tap = 0; tap < 4; ++tap) { const v4u rw = raw[mtx][tk + tap];
                        o[0] += cw[tap][0][0] * bflo(rw.x); o[1] += cw[tap][0][1] * bfhi(rw.x); o[2] += cw[tap][0][2] * bflo(rw.y); o[3] += cw[tap][0][3] * bfhi(rw.y);
                        o[4] += cw[tap][1][0] * bflo(rw.z); o[5] += cw[tap][1][1] * bfhi(rw.z); o[6] += cw[tap][1][2] * bflo(rw.w); o[7] += cw[tap][1][3] * bfhi(rw.w); }
#pragma unroll
                    for (int e = 0; e < 8; ++e) { const float y = silu_f(o[e]); if (mtx == 0) q[tk][e] = y; else if (mtx == 1) k[tk][e] = y; else v[tk][e] = y; } }
            }
#pragma unroll
            for (int tk = 0; tk < 2; ++tk) { float sq = 0.f, sk = 0.f;
#pragma unroll
                for (int e = 0; e < 8; ++e) { sq += q[tk][e] * q[tk][e]; sk += k[tk][e] * k[tk][e]; }
                sq = row8_sum(sq); sk = row8_sum(sk); const float rq = rsqrtf(sq + EPS) * 0.125f, rk = rsqrtf(sk + EPS);
#pragma unroll
                for (int e = 0; e < 8; ++e) { q[tk][e] *= rq; k[tk][e] *= rk; } }
            LDS_WAIT();
#pragma unroll
            for (int tk = 0; tk < 2; ++tk) { const int t = t0 + tk; const float beta = bt[t], eg = eq[t] * beta;
                v4u w; w.x = pk2(q[tk][0], q[tk][1]); w.y = pk2(q[tk][2], q[tk][3]); w.z = pk2(q[tk][4], q[tk][5]); w.w = pk2(q[tk][6], q[tk][7]); *(LAS v4u*)(Qs + t * 72 + 8 * dg) = w;
                w.x = pk2(k[tk][0], k[tk][1]); w.y = pk2(k[tk][2], k[tk][3]); w.z = pk2(k[tk][4], k[tk][5]); w.w = pk2(k[tk][6], k[tk][7]); *(LAS v4u*)(Ks + t * 72 + 8 * dg) = w;
                *(LAS f32x4*)(RHS + t * 128 + 8 * dg) = (f32x4){v[tk][0] * beta, v[tk][1] * beta, v[tk][2] * beta, v[tk][3] * beta};
                *(LAS f32x4*)(RHS + t * 128 + 8 * dg + 4) = (f32x4){v[tk][4] * beta, v[tk][5] * beta, v[tk][6] * beta, v[tk][7] * beta};
                *(LAS f32x4*)(RHS + t * 128 + 64 + 8 * dg) = (f32x4){k[tk][0] * eg, k[tk][1] * eg, k[tk][2] * eg, k[tk][3] * eg};
                *(LAS f32x4*)(RHS + t * 128 + 64 + 8 * dg + 4) = (f32x4){k[tk][4] * eg, k[tk][5] * eg, k[tk][6] * eg, k[tk][7] * eg}; }
        }
        LBAR();
        if (it + 1 < per && uid + 1 < NUNIT_D) P2_FETCH(uid + 1);
        const int l15 = lane & 15, lq = lane >> 4;
        if (act && lim >= 2) {
            bf16x8 ka[2], qa[2];
#pragma unroll
            for (int ks = 0; ks < 2; ++ks) { ka[ks] = *(const LAS bf16x8*)(Ks + (16 * wt + l15) * 72 + 32 * ks + 8 * lq); qa[ks] = *(const LAS bf16x8*)(Qs + (16 * wt + l15) * 72 + 32 * ks + 8 * lq); }
            float gi[4], bi[4];
#pragma unroll
            for (int r = 0; r < 4; ++r) { gi[r] = gc[16 * wt + 4 * lq + r]; bi[r] = bt[16 * wt + 4 * lq + r]; }
#pragma unroll
            for (int ct = 0; ct < 4; ++ct) {
                const bf16x8 kb0 = *(const LAS bf16x8*)(Ks + (16 * ct + l15) * 72 + 8 * lq), kb1 = *(const LAS bf16x8*)(Ks + (16 * ct + l15) * 72 + 32 + 8 * lq);
                f32x4 kk = {0.f, 0.f, 0.f, 0.f}, qk = {0.f, 0.f, 0.f, 0.f};
                kk = __builtin_amdgcn_mfma_f32_16x16x32_bf16(ka[0], kb0, kk, 0, 0, 0); kk = __builtin_amdgcn_mfma_f32_16x16x32_bf16(ka[1], kb1, kk, 0, 0, 0);
                qk = __builtin_amdgcn_mfma_f32_16x16x32_bf16(qa[0], kb0, qk, 0, 0, 0); qk = __builtin_amdgcn_mfma_f32_16x16x32_bf16(qa[1], kb1, qk, 0, 0, 0);
                const int j = 16 * ct + l15; const float gj = gc[j];
#pragma unroll
                for (int r = 0; r < 4; ++r) { const int i = 16 * wt + 4 * lq + r; const float dec = (j <= i) ? __expf(gi[r] - gj) : 0.f;
                    Lm[i * 64 + j] = (j < i) ? bi[r] * kk[r] * dec : 0.f;
                    As[i * 72 + j] = (bf16)(pk2(qk[r] * dec, 0.f) & 0xffffu); }
            }
        }
        LBAR();
        if (act && lim >= 3) {
            if (rt_ < 64) {
                const int bb = rt_ >> 4, cc = rt_ & 15; const LAS float* Lb = Lm + (16 * bb) * 64 + 16 * bb; float t[16]; f32x4 lv[15][4];
#pragma unroll
                for (int r = 1; r < 16; ++r)
#pragma unroll
                    for (int j4 = 0; j4 < (r + 3) / 4; ++j4) lv[r - 1][j4] = *(const LAS f32x4*)(Lb + r * 64 + 4 * j4);
                __builtin_amdgcn_sched_barrier(0);
#pragma unroll
                for (int r = 0; r < 16; ++r) { float a = (r == cc) ? 1.f : 0.f;
#pragma unroll
                    for (int j4 = 0; j4 < (r + 3) / 4; ++j4) { const f32x4 l = lv[r > 0 ? r - 1 : 0][j4];
#pragma unroll
                        for (int e = 0; e < 4; ++e) if (4 * j4 + e < r) a -= l[e] * t[4 * j4 + e]; }
                    t[r] = a; }
                LDS_WAIT(); asm volatile("" ::: "memory");
#pragma unroll
                for (int r = 0; r < 16; ++r) ((LAS float*)Lb)[r * 64 + cc] = t[r];
            } else if (rt_ >= 128) {
                const int t2 = rt_ - 128, rrow = t2 >> 1, half = t2 & 1;
                { const float eg = eq[rrow]; v4u in[4], ou[4];
#pragma unroll
                  for (int i = 0; i < 4; ++i) in[i] = *(const LAS v4u*)(Qs + rrow * 72 + 32 * half + 8 * i);
                  unsigned g4[16];
#pragma unroll
                  for (int kk4 = 0; kk4 < 8; ++kk4) { const unsigned a0 = in[kk4 >> 1][(kk4 & 1) * 2], a1 = in[kk4 >> 1][(kk4 & 1) * 2 + 1]; const int p4 = 2 * (kk4 & 3) + (kk4 >> 2);
                      g4[2 * p4] = pk2(bflo(a0) * eg, bfhi(a0) * eg); g4[2 * p4 + 1] = pk2(bflo(a1) * eg, bfhi(a1) * eg); }
#pragma unroll
                  for (int i = 0; i < 4; ++i) { ou[i] = (v4u){g4[4 * i], g4[4 * i + 1], g4[4 * i + 2], g4[4 * i + 3]}; *(v4u*)(DQG + (size_t)uid * 4096 + rrow * 64 + 32 * half + 8 * i) = ou[i]; } }
                { v4u in[4], ou[4];
#pragma unroll
                  for (int i = 0; i < 4; ++i) in[i] = *(const LAS v4u*)(As + rrow * 72 + 32 * half + 8 * i);
                  unsigned g4[16];
#pragma unroll
                  for (int kk4 = 0; kk4 < 8; ++kk4) { const int p4 = 2 * (kk4 & 3) + (kk4 >> 2); g4[2 * p4] = in[kk4 >> 1][(kk4 & 1) * 2]; g4[2 * p4 + 1] = in[kk4 >> 1][(kk4 & 1) * 2 + 1]; }
#pragma unroll
                  for (int i = 0; i < 4; ++i) { ou[i] = (v4u){g4[4 * i], g4[4 * i + 1], g4[4 * i + 2], g4[4 * i + 3]}; *(v4u*)(DA + (size_t)uid * 4096 + rrow * 64 + 32 * half + 8 * i) = ou[i]; } }
                {
                  unsigned g4[16]; bf16 kv_[32]; f32x4 ev_[8];
#pragma unroll
                  for (int i = 0; i < 32; ++i) kv_[i] = Ks[(32 * half + i) * 72 + rrow];
#pragma unroll
                  for (int i = 0; i < 8; ++i) ev_[i] = *(const LAS f32x4*)(ek + 32 * half + 4 * i);
                  __builtin_amdgcn_sched_barrier(0);
#pragma unroll
                  for (int kk4 = 0; kk4 < 8; ++kk4) { const int p4 = 2 * (kk4 & 3) + (kk4 >> 2); float f[4];
#pragma unroll
                      for (int e = 0; e < 4; ++e) f[e] = bf1(kv_[4 * kk4 + e]) * ev_[kk4][e];
                      g4[2 * p4] = pk2(f[0], f[1]); g4[2 * p4 + 1] = pk2(f[2], f[3]); }
#pragma unroll
                  for (int i = 0; i < 4; ++i) *(v4u*)(DKDT + (size_t)uid * 4096 + rrow * 64 + 32 * half + 8 * i) = (v4u){g4[4 * i], g4[4 * i + 1], g4[4 * i + 2], g4[4 * i + 3]}; }
                if (t2 == 0) GL[uid] = eq[63];
            }
        }
        LBAR();
        if (act && lim >= 4) {
            f32x4 X[2][4]; bf16x4 xb[2][4]; f32x4 racc[4][2], lfr[4][4];
#pragma unroll
            for (int bb = 0; bb < 4; ++bb) {
#pragma unroll
                for (int c2 = 0; c2 < 2; ++c2)
#pragma unroll
                    for (int r = 0; r < 4; ++r) racc[bb][c2][r] = RHS[(16 * bb + 4 * lq + r) * 128 + 32 * wt + 16 * c2 + l15];
#pragma unroll
                for (int j = 0; j < 4; ++j) if (j <= bb) lfr[bb][j] = *(const LAS f32x4*)(Lm + (16 * bb + l15) * 64 + 16 * j + 4 * lq); }
            __builtin_amdgcn_sched_barrier(0);
#pragma unroll
            for (int bb = 0; bb < 4; ++bb) {
                f32x4 acc[2]; acc[0] = racc[bb][0]; acc[1] = racc[bb][1];
#pragma unroll
                for (int j = 0; j < 4; ++j) if (j < bb) { const f32x4 lv = lfr[bb][j]; const bf16x4 la = cvt4(-lv);
#pragma unroll
                    for (int c2 = 0; c2 < 2; ++c2) acc[c2] = __builtin_amdgcn_mfma_f32_16x16x16bf16_1k(la, xb[c2][j], acc[c2], 0, 0, 0); }
                const f32x4 tv = lfr[bb][bb]; const bf16x4 ta = cvt4(tv);
#pragma unroll
                for (int c2 = 0; c2 < 2; ++c2) { const bf16x4 yb = cvt4(acc[c2]); X[c2][bb] = __builtin_amdgcn_mfma_f32_16x16x16bf16_1k(ta, yb, (f32x4){0.f, 0.f, 0.f, 0.f}, 0, 0, 0); xb[c2][bb] = cvt4(X[c2][bb]); }
            }
            if (wt < 2) {
#pragma unroll
                for (int c2 = 0; c2 < 2; ++c2) { bf16* up = DU + (size_t)uid * 4096 + ((2 * wt + c2) * 64 + lane) * 16; v4u w0, w1;
                    w0.x = pk2(X[c2][0][0], X[c2][0][1]); w0.y = pk2(X[c2][0][2], X[c2][0][3]); w0.z = pk2(X[c2][1][0], X[c2][1][1]); w0.w = pk2(X[c2][1][2], X[c2][1][3]);
                    w1.x = pk2(X[c2][2][0], X[c2][2][1]); w1.y = pk2(X[c2][2][2], X[c2][2][3]); w1.z = pk2(X[c2][3][0], X[c2][3][1]); w1.w = pk2(X[c2][3][2], X[c2][3][3]);
                    *(v4u*)up = w0; *(v4u*)(up + 8) = w1; }
            } else {
#pragma unroll
                for (int c2 = 0; c2 < 2; ++c2) { bf16* wp = DW + (size_t)uid * 4096 + dstperm(32 * (wt - 2) + 16 * c2 + l15);
#pragma unroll
                    for (int bb = 0; bb < 4; ++bb)
#pragma unroll
                        for (int r = 0; r < 4; ++r) wp[(16 * bb + 4 * lq + r) * 64] = (bf16)(pk2(X[c2][bb][r], 0.f) & 0xffffu); }
            }
        }
    }
    LBAR();
#undef P2_FETCH
}

constexpr int SC_W = 0, SC_QG = 9216, SC_A = 18432, SC_KDT = 27648, SC_U = 36864, SC_STAGE = 45056, SC_O = 2 * SC_STAGE, SC_OSTRIDE = 68, SC_OBYTES = 64 * SC_OSTRIDE * 4;
__device__ __forceinline__ void p3_scan(LAS unsigned char* lds, int sq, const bf16* __restrict__ DQG, const bf16* __restrict__ DKDT, const bf16* __restrict__ DW, const bf16* __restrict__ DU, const bf16* __restrict__ DA,
                                        const float* __restrict__ GL, bf16* Z, const float* __restrict__ o_norm, const int wave_s, const bool dostore = true) {
    int lane_ = __builtin_amdgcn_mbcnt_hi(~0u, __builtin_amdgcn_mbcnt_lo(~0u, 0u)); asm volatile("" : "+v"(lane_)); const int tid = wave_s * 64 + lane_; const int wid = wave_s, lane = lane_, l15 = lane & 15, lq = lane >> 4;
    const int b = sq / 12, h = sq - 12 * b; const size_t uid0 = (size_t)sq * 64; const size_t row0 = (size_t)b * SEQ;
    const int ht = tid - 256;
#define SC_LOAD(n) do { const size_t ub = (uid0 + (n)) * 8192; \
        _Pragma("unroll") for (int i = 0; i < 2; ++i) { const int p = ht + 256 * i; \
            st[0][i] = *(const v4u*)((const char*)DW + ub + p * 16); st[1][i] = *(const v4u*)((const char*)DQG + ub + p * 16); st[2][i] = *(const v4u*)((const char*)DA + ub + p * 16); \
            st[3][i] = *(const v4u*)((const char*)DKDT + ub + p * 16); st[4][i] = *(const v4u*)((const char*)DU + ub + p * 16); } } while (0)
#define SC_STORE(s) do { LAS unsigned char* sb_ = lds + (s) * SC_STAGE; \
        _Pragma("unroll") for (int i = 0; i < 2; ++i) { const int p = ht + 256 * i; const int ro = (p >> 3) * 144 + (p & 7) * 16; \
            *(LAS v4u*)(sb_ + SC_W + ro) = st[0][i]; *(LAS v4u*)(sb_ + SC_QG + ro) = st[1][i]; *(LAS v4u*)(sb_ + SC_A + ro) = st[2][i]; *(LAS v4u*)(sb_ + SC_KDT + ro) = st[3][i]; \
            *(LAS v4u*)(sb_ + SC_U + p * 16) = st[4][i]; } } while (0)
#define SC_EPI(n) do { const int row_ = ht >> 2, sg_ = ht & 3; bf16* zp_ = Z + (row0 + (size_t)(n) * 64 + row_) * 1024 + h * 64 + sg_ * 16; \
        const v4u z0_ = *(const v4u*)zp_, z1_ = *(const v4u*)(zp_ + 8); const LAS float* op_ = (const LAS float*)(lds + SC_O + ((n) & 1) * SC_OBYTES) + row_ * SC_OSTRIDE + sg_ * 16; \
        f32x4 o_[4]; float ss_ = 0.f; \
        _Pragma("unroll") for (int i = 0; i < 4; ++i) { o_[i] = *(const LAS f32x4*)(op_ + 4 * i); ss_ += (o_[i][0] * o_[i][0] + o_[i][1] * o_[i][1]) + (o_[i][2] * o_[i][2] + o_[i][3] * o_[i][3]); } \
        ss_ = DPP_ADD(ss_, 0xB1); ss_ = DPP_ADD(ss_, 0x4E); const float rstd_ = rsqrtf(ss_ * (1.f / 64.f) + EPS); \
        v4u y0_, y1_; \
        _Pragma("unroll") for (int i = 0; i < 4; ++i) { const unsigned zz_ = (i < 2) ? z0_[2 * i] : z1_[2 * (i - 2)], zw_ = (i < 2) ? z0_[2 * i + 1] : z1_[2 * (i - 2) + 1]; \
            const unsigned a_ = pk2(o_[i][0] * rstd_ * onv[4 * i] * silu_f(bflo(zz_)), o_[i][1] * rstd_ * onv[4 * i + 1] * silu_f(bfhi(zz_))); \
            const unsigned b_ = pk2(o_[i][2] * rstd_ * onv[4 * i + 2] * silu_f(bflo(zw_)), o_[i][3] * rstd_ * onv[4 * i + 3] * silu_f(bfhi(zw_))); \
            if (i < 2) { y0_[2 * i] = a_; y0_[2 * i + 1] = b_; } else { y1_[2 * (i - 2)] = a_; y1_[2 * (i - 2) + 1] = b_; } } \
        if (dostore) { *(v4u*)zp_ = y0_; *(v4u*)(zp_ + 8) = y1_; } } while (0)
    v4u st[5][2]; float onv[16];
    if (wid >= 4) { SC_LOAD(0); SC_STORE(0); SC_LOAD(1);
#pragma unroll
        for (int i = 0; i < 16; ++i) onv[i] = o_norm[(ht & 3) * 16 + i]; }
    LBAR();
    f32x4 S[4];
#pragma unroll
    for (int i = 0; i < 4; ++i) S[i] = (f32x4){0.f, 0.f, 0.f, 0.f};
    float gl_next = GL[uid0];
    for (int n = 0; n < 64; ++n) {
        if (wid >= 4) {
            if (n + 1 < 64) { SC_STORE((n + 1) & 1); if (n + 2 < 64) SC_LOAD(n + 2); }
            if (n > 0) SC_EPI(n - 1);
        } else {
            const LAS unsigned char* sb = lds + (n & 1) * SC_STAGE; const int fo = l15 * 144 + lq * 16;
            const float gl = gl_next; gl_next = GL[uid0 + (n + 1 < 64 ? n + 1 : n)];
            bf16x8 sbv[2], vb[2];
#pragma unroll
            for (int ks = 0; ks < 2; ++ks) { v4u w; w.x = pk2(S[2 * ks][0], S[2 * ks][1]); w.y = pk2(S[2 * ks][2], S[2 * ks][3]); w.z = pk2(S[2 * ks + 1][0], S[2 * ks + 1][1]); w.w = pk2(S[2 * ks + 1][2], S[2 * ks + 1][3]); sbv[ks] = __builtin_bit_cast(bf16x8, w); }
            f32x4 vn[4];
#pragma unroll
            for (int rt = 0; rt < 4; ++rt) { f32x4 a = {0.f, 0.f, 0.f, 0.f};
#pragma unroll
                for (int ks = 0; ks < 2; ++ks) a = __builtin_amdgcn_mfma_f32_16x16x32_bf16(*(const LAS bf16x8*)(sb + SC_W + rt * 2304 + ks * 64 + fo), sbv[ks], a, 0, 0, 0);
                const v2u uu = *(const LAS v2u*)(sb + SC_U + ((wid * 64 + lane) * 16 + rt * 4) * 2);
                vn[rt] = (f32x4){bflo(uu.x), bfhi(uu.x), bflo(uu.y), bfhi(uu.y)} - a; }
#pragma unroll
            for (int ks = 0; ks < 2; ++ks) { v4u w; w.x = pk2(vn[2 * ks][0], vn[2 * ks][1]); w.y = pk2(vn[2 * ks][2], vn[2 * ks][3]); w.z = pk2(vn[2 * ks + 1][0], vn[2 * ks + 1][1]); w.w = pk2(vn[2 * ks + 1][2], vn[2 * ks + 1][3]); vb[ks] = __builtin_bit_cast(bf16x8, w); }
            LAS float* ob = (LAS float*)(lds + SC_O + (n & 1) * SC_OBYTES) + 16 * wid + l15;
#pragma unroll
            for (int rt = 0; rt < 4; ++rt) { f32x4 a = {0.f, 0.f, 0.f, 0.f};
#pragma unroll
                for (int ks = 0; ks < 2; ++ks) { a = __builtin_amdgcn_mfma_f32_16x16x32_bf16(*(const LAS bf16x8*)(sb + SC_QG + rt * 2304 + ks * 64 + fo), sbv[ks], a, 0, 0, 0);
                    a = __builtin_amdgcn_mfma_f32_16x16x32_bf16(*(const LAS bf16x8*)(sb + SC_A + rt * 2304 + ks * 64 + fo), vb[ks], a, 0, 0, 0); }
#pragma unroll
                for (int r = 0; r < 4; ++r) ob[(16 * rt + 4 * lq + r) * SC_OSTRIDE] = a[r]; }
#pragma unroll
            for (int dt = 0; dt < 4; ++dt) { f32x4 a = S[dt] * gl;
#pragma unroll
                for (int ks = 0; ks < 2; ++ks) a = __builtin_amdgcn_mfma_f32_16x16x32_bf16(*(const LAS bf16x8*)(sb + SC_KDT + dt * 2304 + ks * 64 + fo), vb[ks], a, 0, 0, 0);
                S[dt] = a; }
        }
        LBAR();
    }
    if (wid >= 4) SC_EPI(63);
    LBAR();
#undef SC_LOAD
#undef SC_STORE
#undef SC_EPI
}
constexpr int PTR_OFF = 161792;
#define GAS __attribute__((address_space(1)))
__device__ __forceinline__ GAS void* ldp(LAS unsigned char* lds, int k) {
    asm volatile("" ::: "memory");
    const LAS unsigned* t = (const LAS unsigned*)(lds + PTR_OFF) + 2 * k; unsigned lo = t[0], hi = t[1];
    lo = __builtin_amdgcn_readfirstlane(lo); hi = __builtin_amdgcn_readfirstlane(hi);
    return (GAS void*)(((unsigned long long)hi << 32) | lo);
}
#define x_ ((const float*)(GAS const float*)ldp(lds, 0))
#define mem_ ((const float*)(GAS const float*)ldp(lds, 1))
#define positions_ ((const int*)(GAS const int*)ldp(lds, 2))
#define norm_0_ ((const float*)(GAS const float*)ldp(lds, 3))
#define w_in_0_ ((const float*)(GAS const float*)ldp(lds, 4))
#define conv_w_ ((const float*)(GAS const float*)ldp(lds, 5))
#define a_log_ ((const float*)(GAS const float*)ldp(lds, 6))
#define dt_bias_ ((const float*)(GAS const float*)ldp(lds, 7))
#define o_norm_ ((const float*)(GAS const float*)ldp(lds, 8))
#define mem_norm_0_ ((const float*)(GAS const float*)ldp(lds, 9))
#define w_mkv_0_ ((const float*)(GAS const float*)ldp(lds, 10))
#define w_out_0_ ((const float*)(GAS const float*)ldp(lds, 11))
#define norm_1_ ((const float*)(GAS const float*)ldp(lds, 12))
#define w_in_1_ ((const float*)(GAS const float*)ldp(lds, 13))
#define mem_norm_1_ ((const float*)(GAS const float*)ldp(lds, 14))
#define w_mkv_1_ ((const float*)(GAS const float*)ldp(lds, 15))
#define w_out_1_ ((const float*)(GAS const float*)ldp(lds, 16))
#define final_norm_ ((const float*)(GAS const float*)ldp(lds, 17))
#define out_ ((float*)(GAS float*)ldp(lds, 18))
#define KSUM_ ((float*)(GAS float*)((GAS unsigned char*)ldp(lds, 19) + WS_KSUM))
#define GL_ ((float*)(GAS float*)((GAS unsigned char*)ldp(lds, 19) + WS_GL))
#define WCAT0_ ((bf16*)(GAS bf16*)((GAS unsigned char*)ldp(lds, 19) + WS_WCAT0))
#define WOUT0_ ((bf16*)(GAS bf16*)((GAS unsigned char*)ldp(lds, 19) + WS_WOUT0))
#define WIN1_ ((bf16*)(GAS bf16*)((GAS unsigned char*)ldp(lds, 19) + WS_WIN1))
#define WOUT1_ ((bf16*)(GAS bf16*)((GAS unsigned char*)ldp(lds, 19) + WS_WOUT1))
#define RT_ ((float*)(GAS float*)((GAS unsigned char*)ldp(lds, 19) + WS_ROPE))
#define ACAT_ ((bf16*)(GAS bf16*)((GAS unsigned char*)ldp(lds, 19) + WS_ACAT))
#define MKV_ ((bf16*)(GAS bf16*)((GAS unsigned char*)ldp(lds, 19) + WS_MKV))
#define QKV_ ((bf16*)(GAS bf16*)((GAS unsigned char*)ldp(lds, 19) + WS_QKV))
#define Zb_ ((bf16*)(GAS bf16*)((GAS unsigned char*)ldp(lds, 19) + WS_Z))
#define MQ_ ((bf16*)(GAS bf16*)((GAS unsigned char*)ldp(lds, 19) + WS_MQ))
#define BA_ ((float*)(GAS float*)((GAS unsigned char*)ldp(lds, 19) + WS_BA))
#define PS_ ((float*)(GAS float*)((GAS unsigned char*)ldp(lds, 19) + WS_PS))
#define DW_ ((bf16*)(GAS bf16*)((GAS unsigned char*)ldp(lds, 19) + WS_DW))
#define DU_ ((bf16*)(GAS bf16*)((GAS unsigned char*)ldp(lds, 19) + WS_DU))
#define DA_ ((bf16*)(GAS bf16*)((GAS unsigned char*)ldp(lds, 19) + WS_DA))
#define DQG_ ((bf16*)(GAS bf16*)ldp(lds, 18))
#define DKDT_ ((bf16*)((GAS bf16*)ldp(lds, 18) + (size_t)NUNIT_D * 4096))
#define Q1_ (QKV_)
#define K1_ (QKV_ + (size_t)M * 768)
#define V1_ (QKV_ + (size_t)2 * M * 768)
__device__ __forceinline__ void mem_attn_unit(int u, int layer, LAS unsigned char* lds, char* shm, const int wave_s) {
    const int qb = u & 15, hm = (u >> 4) & 3, b = u >> 6; const size_t r0 = (size_t)b * SEQ + (size_t)qb * 256;
    GAS unsigned char* ws_ = (GAS unsigned char*)ldp(lds, 19);
    const attn_body::bf16* Kh = (const attn_body::bf16*)(GAS attn_body::bf16*)(ws_ + WS_MKV) + (size_t)layer * MROWS * 512 + (size_t)b * NMEM * 512 + hm * 64;
    attn_body::attn_unit<8, 0, 256, 512, 1024>(4, (const attn_body::bf16*)(GAS attn_body::bf16*)(ws_ + WS_MQ) + r0 * 256 + hm * 64, Kh, Kh + 256,
                               (attn_body::bf16*)(GAS attn_body::bf16*)(ws_ + WS_Z) + r0 * 1024 + 768 + hm * 64, nullptr, 0, shm, wave_s);
}
__device__ __forceinline__ void moba_attn_unit(int bh, int qb, LAS unsigned char* lds, char* shm, const int wave_s, const bool dry = false) {
    const int b = bh / 12, h = bh - 12 * b; const size_t r0 = (size_t)b * SEQ + (size_t)qb * 256;
    GAS unsigned char* ws_ = (GAS unsigned char*)ldp(lds, 19);
    const attn_body::bf16* qkv_ = (const attn_body::bf16*)(GAS attn_body::bf16*)(ws_ + WS_QKV);
    attn_body::attn_unit<8, 1, 768, 768, 1024>(4 * (qb + 1), qkv_ + r0 * 768 + h * 64, qkv_ + (size_t)M * 768 + (size_t)b * SEQ * 768 + h * 64, qkv_ + (size_t)2 * M * 768 + (size_t)b * SEQ * 768 + h * 64,
                               (attn_body::bf16*)(GAS attn_body::bf16*)(ws_ + WS_Z) + r0 * 1024 + h * 64, (const float*)(GAS float*)(ws_ + WS_KSUM) + (size_t)b * 16 * 768 + h * 64, qb, shm, wave_s, dry,
                               (const float*)(GAS float*)(ws_ + WS_ROPE) + r0 * 64);
}
#define XB_TMO      128
#define XB_XCNT(j)  (256  + 64 * (j))
#define XB_XSUB(j)  (1280 + 64 * (j))
#define XB_XGEN(j)  (2304 + 64 * (j))
#define XB_TOP      3328
#define XB_TOPGEN   3392
#define XCD_BAR_WORDS 3456
#define XB_SPIN_CAP (1u << 18)

__device__ __forceinline__ unsigned xb_ld(unsigned* p)              { return __hip_atomic_load(p, __ATOMIC_RELAXED, __HIP_MEMORY_SCOPE_AGENT); }
__device__ __forceinline__ unsigned xb_add(unsigned* p, unsigned v) { return __hip_atomic_fetch_add(p, v, __ATOMIC_RELAXED, __HIP_MEMORY_SCOPE_AGENT); }
__device__ __forceinline__ unsigned xb_xcc_id() { return (unsigned)__builtin_amdgcn_s_getreg((3 << 11) | 20) & 0xFu; }
#define XB_SPIN(cond, bar) do { unsigned _sp = 0; while (cond) { __builtin_amdgcn_s_sleep(1); \
    if ((++_sp & 255u) == 0u) { if (xb_ld(&(bar)[XB_TMO])) break; if (_sp > XB_SPIN_CAP) { atomicAdd(&(bar)[XB_TMO], 1u); break; } } } } while (0)

struct XcdBarrier {
    unsigned* bar; unsigned x;
    volatile LAS unsigned* st;
};

__device__ __forceinline__ XcdBarrier xcd_barrier_post(unsigned* bar, volatile LAS unsigned* st) {
    XcdBarrier b; b.bar = bar; b.x = xb_xcc_id(); b.st = st;
    if (threadIdx.x == 0) (void)xb_add(&bar[XB_XCNT(b.x)], 1u);
    return b;
}
__device__ __forceinline__ void xcd_barrier_complete(unsigned* bar, unsigned x, unsigned& nloc, unsigned& nx) {
    const unsigned G = gridDim.x * gridDim.y * gridDim.z;
    unsigned sum, cnt, mine, sp = 0u;
    for (;;) {
        sum = 0u; cnt = 0u; mine = 0u;
#pragma unroll
        for (unsigned j = 0; j < 16; ++j) { const unsigned c = xb_ld(&bar[XB_XCNT(j)]); sum += c; cnt += (c > 0u) ? 1u : 0u; mine = (j == x) ? c : mine; }
        if (sum == G) break;
        __builtin_amdgcn_s_sleep(1);
        if ((++sp & 255u) == 0u) { if (xb_ld(&bar[XB_TMO])) break; if (sp > XB_SPIN_CAP) { atomicAdd(&bar[XB_TMO], 1u); break; } }
    }
    nloc = mine > 0u ? mine : 1u; nx = cnt > 0u ? cnt : 1u;
}

__device__ __forceinline__ void xcd_barrier(const XcdBarrier& b) {
    asm volatile("s_waitcnt vmcnt(0)" ::: "memory");
    __syncthreads();
    if (threadIdx.x == 0) {
        unsigned* bar = b.bar;
        __builtin_amdgcn_s_waitcnt(0);
        unsigned nloc = b.st[0], nx = b.st[1];
        if (nloc == 0u) { xcd_barrier_complete(bar, b.x, nloc, nx); b.st[0] = nloc; b.st[1] = nx; }
        const unsigned old = xb_add(&bar[XB_XSUB(b.x)], 1u);
        const unsigned gen = old / nloc;
        if (old + 1u == (gen + 1u) * nloc) {
            __builtin_amdgcn_fence(__ATOMIC_RELEASE, "agent");
            asm volatile("s_waitcnt vmcnt(0)" ::: "memory");
            const unsigned og = xb_add(&bar[XB_TOP], 1u);
            const unsigned tg = og / nx;
            if (og + 1u == (tg + 1u) * nx) xb_add(&bar[XB_TOPGEN], 1u);
            else XB_SPIN(xb_ld(&bar[XB_TOPGEN]) == tg, bar);
            __builtin_amdgcn_fence(__ATOMIC_ACQUIRE, "agent");
            xb_add(&bar[XB_XGEN(b.x)], 1u);
            asm volatile("s_waitcnt vmcnt(0)" ::: "memory");
        } else {
            XB_SPIN(xb_ld(&bar[XB_XGEN(b.x)]) == gen, bar);
            __builtin_amdgcn_fence(__ATOMIC_ACQUIRE, "agent");
            asm volatile("s_waitcnt vmcnt(0)" ::: "memory");
        }
    }
    __syncthreads();
}

constexpr size_t WS_BAR = 1 * MiB;
struct Args { const float* in[18]; float* out; unsigned char* ws; };
__global__ void __launch_bounds__(NTHREADS, 2) hybrid_fwd(Args args) {
    extern __shared__ __attribute__((aligned(16))) unsigned char lds_raw[];
    cg::grid_group grid = cg::this_grid();
    LAS unsigned char* lds = (LAS unsigned char*)lds_raw;
    const int G = gridDim.x, bid = blockIdx.x;
    const int wave_s = __builtin_amdgcn_readfirstlane((int)threadIdx.x >> 6);
    if (threadIdx.x < 20) { const unsigned long long pv = threadIdx.x < 18 ? (unsigned long long)args.in[threadIdx.x < 18 ? threadIdx.x : 0] : (threadIdx.x == 18 ? (unsigned long long)args.out : (unsigned long long)args.ws);
        ((LAS unsigned long long*)(lds + PTR_OFF))[threadIdx.x] = pv; }
    if (threadIdx.x == 32) { ((LAS unsigned*)(lds + PTR_OFF + 192))[0] = 0u; ((LAS unsigned*)(lds + PTR_OFF + 192))[1] = 0u; }
    __syncthreads();
    const XcdBarrier xbar = xcd_barrier_post((unsigned*)(args.ws + WS_BAR), (volatile LAS unsigned*)(lds + PTR_OFF + 192));
    const int vcu = (G % 8 == 0) ? (bid % 8) * (G / 8) + bid / 8 : bid;
    const int NGW = G * 8;
#define FRESH_IDS() int lane = __builtin_amdgcn_mbcnt_hi(~0u, __builtin_amdgcn_mbcnt_lo(~0u, 0u)); asm volatile("" : "+v"(lane)); const int wave = wave_s, tid = wave_s * 64 + lane; (void)tid; const int gw = vcu * 8 + wave; (void)lane; (void)gw

#ifndef SKIP_P0
    {
        FRESH_IDS();
        LAS float* scr = (LAS float*)(lds + wave * 16384);
        constexpr int I_IN0 = 16 * 113, I_MKV = 16 * 16, I_OUT = 16 * 32, I_IN1 = 16 * 112;
        constexpr int NITEMS = I_IN0 + 2 * I_MKV + 2 * I_OUT + I_IN1;
        for (int it = gw; it < NITEMS; it += NGW) {
            int r = it;
            if (r < I_IN0) { p0_transpose_item(w_in_0_, DM, N_IN0, 113, WCAT0_, 0, false, scr, r, lane); continue; } r -= I_IN0;
            if (r < I_MKV) { p0_transpose_item(w_mkv_0_, DM, 512, 16, WCAT0_, N_IN0P, false, scr, r, lane); continue; } r -= I_MKV;
            if (r < I_MKV) { p0_transpose_item(w_mkv_1_, DM, 512, 16, WCAT0_, N_IN0P + 512, false, scr, r, lane); continue; } r -= I_MKV;
            if (r < I_OUT) { p0_transpose_item(w_out_0_, DM, DM, 32, WOUT0_, 0, false, scr, r, lane); continue; } r -= I_OUT;
            if (r < I_OUT) { p0_transpose_item(w_out_1_, DM, DM, 32, WOUT1_, 0, false, scr, r, lane); continue; } r -= I_OUT;
            p0_transpose_item(w_in_1_, DM, N_IN1, 112, WIN1_, 0, true, scr, r, lane);
        }
        { const size_t z0 = (size_t)3616 * DM * 2, z1 = (size_t)N_IN0P * DM * 2;
          for (size_t p = z0 + ((size_t)bid * NTHREADS + tid) * 16; p < z1; p += (size_t)G * NTHREADS * 16) *(v4u*)((unsigned char*)WCAT0_ + p) = (v4u){0u, 0u, 0u, 0u}; }
        for (int i = bid * NTHREADS + tid; i < BATCH * 16 * 768; i += G * NTHREADS) KSUM_[i] = 0.f;
        { int m = gw; for (; m + NGW < M; m += 2 * NGW) rms_row2_to_bf16(x_ + (size_t)m * DM, x_ + (size_t)(m + NGW) * DM, norm_0_, ACAT_ + (size_t)m * DM, ACAT_ + (size_t)(m + NGW) * DM, lane);
          if (m < M) rms_row_to_bf16(x_ + (size_t)m * DM, norm_0_, ACAT_ + (size_t)m * DM, nullptr, nullptr, lane); }
        for (int m = gw; m < MROWS; m += NGW) rms_row_to_bf16(mem_ + (size_t)m * DM, mem_norm_0_, ACAT_ + (size_t)(M + m) * DM, mem_norm_1_, ACAT_ + (size_t)(M + MROWS + m) * DM, lane);
        for (int i = bid * NTHREADS + tid; i < M * 32; i += G * NTHREADS) { const int row = i >> 5, f = i & 31;
            const double ang = (double)positions_[row] * (double)ROPE_INVF[f]; double rv = ang * 0.15915494309189535; rv -= __builtin_rint(rv); const float rf = (float)rv;
            RT_[2 * (size_t)i] = __builtin_amdgcn_cosf(rf); RT_[2 * (size_t)i + 1] = __builtin_amdgcn_sinf(rf); }
    }
#ifdef DUP_P0
    grid.sync();
    {
        FRESH_IDS();
        LAS float* scr = (LAS float*)(lds + wave * 16384);
        constexpr int I_IN0 = 16 * 113, I_MKV = 16 * 16, I_OUT = 16 * 32, I_IN1 = 16 * 112;
        constexpr int NITEMS = I_IN0 + 2 * I_MKV + 2 * I_OUT + I_IN1;
        for (int it = gw; it < NITEMS; it += NGW) {
            int r = it;
            if (r < I_IN0) { p0_transpose_item(w_in_0_, DM, N_IN0, 113, WCAT0_, 0, false, scr, r, lane); continue; } r -= I_IN0;
            if (r < I_MKV) { p0_transpose_item(w_mkv_0_, DM, 512, 16, WCAT0_, N_IN0P, false, scr, r, lane); continue; } r -= I_MKV;
            if (r < I_MKV) { p0_transpose_item(w_mkv_1_, DM, 512, 16, WCAT0_, N_IN0P + 512, false, scr, r, lane); continue; } r -= I_MKV;
            if (r < I_OUT) { p0_transpose_item(w_out_0_, DM, DM, 32, WOUT0_, 0, false, scr, r, lane); continue; } r -= I_OUT;
            if (r < I_OUT) { p0_transpose_item(w_out_1_, DM, DM, 32, WOUT1_, 0, false, scr, r, lane); continue; } r -= I_OUT;
            p0_transpose_item(w_in_1_, DM, N_IN1, 112, WIN1_, 0, true, scr, r, lane);
        }
        { const size_t z0 = (size_t)3616 * DM * 2, z1 = (size_t)N_IN0P * DM * 2;
          for (size_t p = z0 + ((size_t)bid * NTHREADS + tid) * 16; p < z1; p += (size_t)G * NTHREADS * 16) *(v4u*)((unsigned char*)WCAT0_ + p) = (v4u){0u, 0u, 0u, 0u}; }
        for (int i = bid * NTHREADS + tid; i < BATCH * 16 * 768; i += G * NTHREADS) KSUM_[i] = 0.f;
        { int m = gw; for (; m + NGW < M; m += 2 * NGW) rms_row2_to_bf16(x_ + (size_t)m * DM, x_ + (size_t)(m + NGW) * DM, norm_0_, ACAT_ + (size_t)m * DM, ACAT_ + (size_t)(m + NGW) * DM, lane);
          if (m < M) rms_row_to_bf16(x_ + (size_t)m * DM, norm_0_, ACAT_ + (size_t)m * DM, nullptr, nullptr, lane); }
        for (int m = gw; m < MROWS; m += NGW) rms_row_to_bf16(mem_ + (size_t)m * DM, mem_norm_0_, ACAT_ + (size_t)(M + m) * DM, mem_norm_1_, ACAT_ + (size_t)(M + MROWS + m) * DM, lane);
        for (int i = bid * NTHREADS + tid; i < M * 32; i += G * NTHREADS) { const int row = i >> 5, f = i & 31;
            const double ang = (double)positions_[row] * (double)ROPE_INVF[f]; double rv = ang * 0.15915494309189535; rv -= __builtin_rint(rv); const float rf = (float)rv;
            RT_[2 * (size_t)i] = __builtin_amdgcn_cosf(rf); RT_[2 * (size_t)i + 1] = __builtin_amdgcn_sinf(rf); }
    }
#endif
#endif
    xcd_barrier(xbar);
    if (G > (1 << 24)) grid.sync();

#ifndef SKIP_P1
    {
        pg8::Gemm g{ACAT_, WCAT0_, M + 2 * MROWS, N_IN0P + 1024, DM}; OrderX S; S.init(128, 15, G, bid, 32);
        EpiIn0 E{QKV_, Zb_, MQ_, MKV_, BA_};
        pg8::gemm_phase<EpiIn0, OrderX, true, true>(lds, g, S, E, wave_s);
    }
#ifdef DUP_GEMMS
    xcd_barrier(xbar);
    {
        pg8::Gemm g{ACAT_, WCAT0_, M + 2 * MROWS, N_IN0P + 1024, DM}; OrderX S; S.init(128, 15, G, bid, 32);
        EpiIn0 E{QKV_, Zb_, MQ_, MKV_, BA_};
        pg8::gemm_phase<EpiIn0, OrderX, true, true>(lds, g, S, E, wave_s);
    }
#endif
#endif
    xcd_barrier(xbar);

#ifndef SKIP_P2
#ifdef DUP_P2
    p2_delta_prep(lds, G, QKV_, BA_, conv_w_, a_log_, dt_bias_, DQG_, DKDT_, DW_, DU_, DA_, GL_, wave_s, DUP_P2);
    xcd_barrier(xbar);
#endif
    p2_delta_prep(lds, G, QKV_, BA_, conv_w_, a_log_, dt_bias_, DQG_, DKDT_, DW_, DU_, DA_, GL_, wave_s);
#endif
    xcd_barrier(xbar);

#ifndef SKIP_P3
    {
        const int nscan = G < 96 ? G : 96;
#ifdef DUP_P3
        if (bid < nscan) { for (int sq = bid; sq < 96; sq += nscan) p3_scan(lds, sq, DQG_, DKDT_, DW_, DU_, DA_, GL_, Zb_, o_norm_, wave_s, false); }
        xcd_barrier(xbar);
#endif
        if (bid < nscan) { for (int sq = bid; sq < 96; sq += nscan) p3_scan(lds, sq, DQG_, DKDT_, DW_, DU_, DA_, GL_, Zb_, o_norm_, wave_s); }
        const int u0 = (G > 96) ? (bid >= 96 ? bid - 96 : 512) : bid, ustep = (G > 96) ? G - 96 : G;
        for (int u = u0; u < 512; u += ustep) mem_attn_unit(u, 0, lds, (char*)lds_raw, wave_s);
    }
#endif
    xcd_barrier(xbar);

#ifndef SKIP_P4
    {
        pg8::Gemm g{Zb_, WOUT0_, M, DM, DM}; OrderX S; S.init(128, 4, G, bid, 0);
        EpiOut E{x_, out_};
        pg8::gemm_phase<EpiOut, OrderX, true, true>(lds, g, S, E, wave_s);
    }
#ifdef DUP_GEMMS
    xcd_barrier(xbar);
    {
        pg8::Gemm g{Zb_, WOUT0_, M, DM, DM}; OrderX S; S.init(128, 4, G, bid, 0);
        EpiOut E{x_, out_};
        pg8::gemm_phase<EpiOut, OrderX, true, true>(lds, g, S, E, wave_s);
    }
#endif
#endif
    xcd_barrier(xbar);

#ifndef SKIP_P5
    { FRESH_IDS(); int m = gw; for (; m + NGW < M; m += 2 * NGW) rms_row2_to_bf16(out_ + (size_t)m * DM, out_ + (size_t)(m + NGW) * DM, norm_1_, ACAT_ + (size_t)m * DM, ACAT_ + (size_t)(m + NGW) * DM, lane);
      if (m < M) rms_row_to_bf16(out_ + (size_t)m * DM, norm_1_, ACAT_ + (size_t)m * DM, nullptr, nullptr, lane); }
#endif
    xcd_barrier(xbar);

#ifndef SKIP_P6
    {
        pg8::Gemm g{ACAT_, WIN1_, M, N_IN1, DM}; OrderX S; S.init(128, 14, G, bid, 0);
        EpiIn1 E{QKV_, Zb_, MQ_};
        pg8::gemm_phase<EpiIn1, OrderX, true, true>(lds, g, S, E, wave_s);
    }
#ifdef DUP_GEMMS
    xcd_barrier(xbar);
    {
        pg8::Gemm g{ACAT_, WIN1_, M, N_IN1, DM}; OrderX S; S.init(128, 14, G, bid, 0);
        EpiIn1 E{QKV_, Zb_, MQ_};
        pg8::gemm_phase<EpiIn1, OrderX, true, true>(lds, g, S, E, wave_s);
    }
#endif
#endif
    xcd_barrier(xbar);

#ifndef SKIP_P6B
    p6b_rope(lds, G, K1_, RT_, KSUM_, wave_s);
#endif
    xcd_barrier(xbar);

#ifndef SKIP_P7
    {
        const int npair = (768 - vcu + G - 1) / G;
#ifdef DUP_P7
        for (int i = 0; i < 2 * npair; ++i) { const int p = vcu + (i >> 1) * G, bh = p >> 3, s = p & 7;
            moba_attn_unit(bh, (i & 1) ? s : 15 - s, lds, (char*)lds_raw, wave_s, true); }
        xcd_barrier(xbar);
#endif
        for (int i = 0; i < 2 * npair; ++i) { const int p = vcu + (i >> 1) * G, bh = p >> 3, s = p & 7;
            moba_attn_unit(bh, (i & 1) ? s : 15 - s, lds, (char*)lds_raw, wave_s); }
        for (int u = vcu; u < 512; u += G) mem_attn_unit(u, 1, lds, (char*)lds_raw, wave_s);
    }
#endif
    xcd_barrier(xbar);

#ifndef SKIP_P8
    {
        pg8::Gemm g{Zb_, WOUT1_, M, DM, DM}; OrderX S; S.init(128, 4, G, bid, 0);
        EpiOut E{out_, out_};
        pg8::gemm_phase<EpiOut, OrderX, true, true>(lds, g, S, E, wave_s);
    }
#endif
    xcd_barrier(xbar);

#ifdef DUP_SYNC
    for (int i_ = 0; i_ < 20; ++i_) xcd_barrier(xbar);
#endif
#ifndef SKIP_P9
    { FRESH_IDS();
    for (int m = gw; m < M; m += 2 * NGW) {
        const bool two = (m + NGW) < M;
        f32x4* xr = (f32x4*)(out_ + (size_t)m * DM) + lane; f32x4* xs = (f32x4*)(out_ + (size_t)(two ? m + NGW : m) * DM) + lane; f32x4 v[4], u[4]; float s = 0.f, s2 = 0.f;
#pragma unroll
        for (int j = 0; j < 4; ++j) { v[j] = xr[64 * j]; u[j] = xs[64 * j]; }
#pragma unroll
        for (int j = 0; j < 4; ++j) { s += (v[j].x * v[j].x + v[j].y * v[j].y) + (v[j].z * v[j].z + v[j].w * v[j].w); s2 += (u[j].x * u[j].x + u[j].y * u[j].y) + (u[j].z * u[j].z + u[j].w * u[j].w); }
        const float rstd = rsqrtf(wave_sum(s) * (1.f / DM) + EPS), rstd2 = rsqrtf(wave_sum(s2) * (1.f / DM) + EPS);
#pragma unroll
        for (int j = 0; j < 4; ++j) { const f32x4 g = ((const f32x4*)final_norm_)[lane + 64 * j]; xr[64 * j] = v[j] * rstd * g; if (two) xs[64 * j] = u[j] * rstd2 * g; }
    } }
#endif
}

extern "C" void kernel_launch(void* const* d_in, const int* in_sizes, int n_in, void* d_out, int out_size, void* d_ws, size_t ws_size, hipStream_t stream) {
    static int grid = 0;
    if (grid == 0) {
        if (n_in != 18 || out_size != M * DM || ws_size < WS_END) { fprintf(stderr, "kernel_launch: unexpected shapes (n_in %d, out %d, ws %zu)\n", n_in, out_size, ws_size); grid = -1; return; }
        int dev = 0, cus = 0, per_cu = 0;
        hipGetDevice(&dev); hipDeviceGetAttribute(&cus, hipDeviceAttributeMultiprocessorCount, dev);
        if (hipFuncSetAttribute((const void*)hybrid_fwd, hipFuncAttributeMaxDynamicSharedMemorySize, LDS_BYTES) != hipSuccess) { fprintf(stderr, "kernel_launch: hipFuncSetAttribute failed\n"); grid = -1; return; }
        if (hipOccupancyMaxActiveBlocksPerMultiprocessor(&per_cu, (const void*)hybrid_fwd, NTHREADS, LDS_BYTES) != hipSuccess || per_cu < 1) { fprintf(stderr, "kernel_launch: occupancy query says %d\n", per_cu); per_cu = 1; }
        (void)hipGetLastError();
        grid = cus * 1;
    }
    if (grid < 0) return;
    if (hipMemsetAsync((char*)d_ws + WS_BAR, 0, 16384, stream) != hipSuccess) { fprintf(stderr, "kernel_launch: memset failed\n"); return; }
    Args a{};
    for (int i = 0; i < 18; ++i) a.in[i] = (const float*)d_in[i];
    a.out = (float*)d_out; a.ws = (unsigned char*)d_ws;
    void* kargs[] = {&a};
    hipError_t e = hipLaunchCooperativeKernel((const void*)hybrid_fwd, dim3(grid), dim3(NTHREADS), kargs, LDS_BYTES, stream);
    if (e != hipSuccess) fprintf(stderr, "kernel_launch: cooperative launch failed: %s (grid %d)\n", hipGetErrorString(e), grid);
}
```

```cpp
#include <hip/hip_runtime.h>
#include <hip/hip_cooperative_groups.h>
#include <hip/hip_bf16.h>
#include <cstdio>
#include <cstdint>
#include <cmath>
namespace pg8 {
#define PG8_LAS __attribute__((address_space(3)))
typedef unsigned short bf16_t;
typedef short bf16x8 __attribute__((ext_vector_type(8)));
typedef float f32x4 __attribute__((ext_vector_type(4)));
typedef unsigned u32x4 __attribute__((ext_vector_type(4)));
constexpr int BM = 256, BK = 64, HALF = 128, HTB = HALF * BK * 2  , STAGE_BYTES = 8 * HTB, NXCD = 8, WGM = 8;

__host__ __device__ __forceinline__ int lds_byte(int r, int c) { const int st = (r >> 4) * 2 + (c >> 5), rr = r & 15, cc = c & 31, ob = rr * 64 + cc * 2; return st * 1024 + (ob ^ (((ob >> 9) & 1) << 5)); }
__host__ __device__ __forceinline__ void stage_rc(int b, int& R, int& C) { const int st = b / 1024, sb = b % 1024, swz = sb ^ (((sb >> 9) & 1) << 5); R = (st >> 1) * 16 + swz / 64; C = (st & 1) * 32 + (swz % 64) / 2; }
__host__ __device__ __forceinline__ int perm32(int rho) { const int n = rho >> 4, i = rho & 15; return 8 * (i >> 2) + 4 * n + (i & 3); }

struct Unit { int pm, pn; };
struct Gemm { const bf16_t* A; const bf16_t* Bt; int M, N, K; };
__device__ __forceinline__ unsigned cvt_pk_bf16(float lo, float hi) { unsigned r; asm volatile("v_cvt_pk_bf16_f32 %0, %1, %2" : "=v"(r) : "v"(lo), "v"(hi)); return r; }
typedef float f32x2 __attribute__((ext_vector_type(2)));
template <class Epi, class Sched, bool ALIGN_EPI = false, bool SP2 = false>
__device__ __forceinline__ void gemm_phase(PG8_LAS unsigned char* lds, const Gemm g, const Sched& S, const Epi& E, const int wave_s) {
    int lane_ = __builtin_amdgcn_mbcnt_hi(~0u, __builtin_amdgcn_mbcnt_lo(~0u, 0u)); asm volatile("" : "+v"(lane_)); const int tid = wave_s * 64 + lane_; const int wid = wave_s, lane = tid & 63, wr = wid >> 2, wc = wid & 3, fr = lane & 15, fq = lane >> 4;
    const int K = g.K, nt = K / BK;
    unsigned voffA[2], voffB[2];
#pragma unroll
    for (int i = 0; i < 2; ++i) { int R, C; stage_rc(tid * 16 + i * 8192, R, C); const int Rb = Epi::PERM ? ((R & ~31) + perm32(R & 31)) : R;
        voffA[i] = (unsigned)(R * K + C) * 2u; voffB[i] = (unsigned)(Rb * K + C) * 2u; }
    const size_t kstep = (size_t)(BK * 2);
    const size_t hstep = (size_t)HALF * K * 2;
    const size_t tstep = 2 * hstep;
    const unsigned ldsw = (unsigned)wid * 1024u;
    const int aoff = lds_byte(wr * 64 + fr, fq * 8), boff = lds_byte(wc * 32 + fr, fq * 8);
#define PG8_SA(b, h) (((b) * 2 + (h)) * HTB)
#define PG8_SB(b, h) ((4 + (b) * 2 + (h)) * HTB)
#define PG8_STAGE(bufoff, gbase, voff) do { _Pragma("unroll") for (int _i = 0; _i < 2; ++_i) \
        __builtin_amdgcn_global_load_lds((const unsigned*)((const char*)(gbase) + (voff)[_i]), (PG8_LAS unsigned*)(lds + (bufoff) + ldsw + _i * 8192), 16, 0, 0); } while (0)
#define PG8_LDA(dst, b, h) do { _Pragma("unroll") for (int m = 0; m < 4; ++m) _Pragma("unroll") for (int k = 0; k < 2; ++k) dst[m][k] = *(const PG8_LAS bf16x8*)(lds + PG8_SA(b, h) + aoff + m * 2048 + k * 1024); } while (0)
#define PG8_LDB(dst, b, h) do { _Pragma("unroll") for (int n = 0; n < 2; ++n) _Pragma("unroll") for (int k = 0; k < 2; ++k) dst[n][k] = *(const PG8_LAS bf16x8*)(lds + PG8_SB(b, h) + boff + n * 2048 + k * 1024); } while (0)
#define PG8_MMA(ai, bj, At, Bt) do { __builtin_amdgcn_s_setprio(1); _Pragma("unroll") for (int m = 0; m < 4; ++m) _Pragma("unroll") for (int n = 0; n < 2; ++n) _Pragma("unroll") for (int k = 0; k < 2; ++k) \
        acc[ai][bj][m][n] = __builtin_amdgcn_mfma_f32_16x16x32_bf16(Bt[n][k], At[m][k], acc[ai][bj][m][n], 0, 0, 0); __builtin_amdgcn_s_setprio(0); } while (0)
#define PG8_WAIT_V(n) asm volatile("s_waitcnt vmcnt(" #n ")" ::: "memory")
#define PG8_WAIT_L(n) asm volatile("s_waitcnt lgkmcnt(" #n ")" ::: "memory")
#define PG8_BAR __builtin_amdgcn_s_barrier()
#define PG8_SCHED __builtin_amdgcn_sched_barrier(0)
    Unit cur, nxt; int ui = 0;
    if (!S.next(0, cur)) return;
    f32x4 acc[2][2][4][2];
#pragma unroll
    for (int a = 0; a < 2; ++a)
#pragma unroll
        for (int b = 0; b < 2; ++b)
#pragma unroll
            for (int m = 0; m < 4; ++m)
#pragma unroll
                for (int n = 0; n < 2; ++n) acc[a][b][m][n] = (f32x4){0.f, 0.f, 0.f, 0.f};
    bf16x8 At[4][2], B0[2][2], B1[2][2];
    const char* cA = (const char*)g.A + (size_t)cur.pm * tstep; const char* cB = (const char*)g.Bt + (size_t)cur.pn * tstep;
    S.a_ready(cur);
    if constexpr (SP2) {
        PG8_STAGE(PG8_SB(0, 0), cB, voffB); PG8_STAGE(PG8_SB(0, 1), cB + hstep, voffB); PG8_STAGE(PG8_SA(0, 0), cA, voffA); PG8_STAGE(PG8_SA(0, 1), cA + hstep, voffA);
        if (wr == 1) PG8_BAR;
        PG8_WAIT_V(2); PG8_BAR;
        PG8_STAGE(PG8_SB(1, 0), cB + kstep, voffB); PG8_STAGE(PG8_SA(1, 0), cA + kstep, voffA); PG8_STAGE(PG8_SB(1, 1), cB + hstep + kstep, voffB);
        PG8_WAIT_V(6); PG8_BAR;
    } else {
        PG8_STAGE(PG8_SB(0, 0), cB, voffB); PG8_STAGE(PG8_SA(0, 0), cA, voffA); PG8_STAGE(PG8_SB(0, 1), cB + hstep, voffB); PG8_STAGE(PG8_SA(0, 1), cA + hstep, voffA);
        if (wr == 1) PG8_BAR;
        PG8_WAIT_V(4); PG8_BAR;
        PG8_STAGE(PG8_SB(1, 0), cB + kstep, voffB); PG8_STAGE(PG8_SA(1, 0), cA + kstep, voffA); PG8_STAGE(PG8_SB(1, 1), cB + hstep + kstep, voffB);
        PG8_WAIT_V(6); PG8_BAR;
    }
    for (;;) {
        const bool has_next = S.next(ui + 1, nxt);
        const char* nA = has_next ? (const char*)g.A + (size_t)nxt.pm * tstep : cA; const char* nB = has_next ? (const char*)g.Bt + (size_t)nxt.pn * tstep : cB;
        for (int t = 0; t < nt; t += 2) {
            const bool last = (t == nt - 2);
            const char* a1 = cA + (size_t)(t + 1) * kstep;
            const char* a2 = last ? nA : cA + (size_t)(t + 2) * kstep; const char* b2 = last ? nB : cB + (size_t)(t + 2) * kstep;
            const char* a3 = a2 + kstep; const char* b3 = b2 + kstep;
            if (last && has_next) S.a_ready(nxt);
            if constexpr (SP2) {
            PG8_LDB(B0, 0, 0); PG8_LDB(B1, 0, 1); PG8_SCHED; PG8_LDA(At, 0, 0); PG8_STAGE(PG8_SA(1, 1), a1 + hstep, voffA);
            PG8_WAIT_V(8); PG8_WAIT_L(0); PG8_BAR; PG8_MMA(0, 0, At, B0); PG8_MMA(0, 1, At, B1); PG8_BAR; PG8_SCHED;
            PG8_LDA(At, 0, 1); PG8_STAGE(PG8_SB(0, 0), b2, voffB); PG8_STAGE(PG8_SB(0, 1), b2 + hstep, voffB); PG8_STAGE(PG8_SA(0, 0), a2, voffA);
            PG8_WAIT_V(8); PG8_WAIT_L(0); PG8_BAR; PG8_MMA(1, 0, At, B0); PG8_MMA(1, 1, At, B1); PG8_BAR; PG8_SCHED;
            PG8_LDB(B0, 1, 0); PG8_LDB(B1, 1, 1); PG8_SCHED; PG8_LDA(At, 1, 0); PG8_STAGE(PG8_SA(0, 1), a2 + hstep, voffA);
            PG8_WAIT_V(8); PG8_WAIT_L(0); PG8_BAR; PG8_MMA(0, 0, At, B0); PG8_MMA(0, 1, At, B1); PG8_BAR; PG8_SCHED;
            PG8_LDA(At, 1, 1); PG8_STAGE(PG8_SB(1, 0), b3, voffB); PG8_STAGE(PG8_SB(1, 1), b3 + hstep, voffB); PG8_STAGE(PG8_SA(1, 0), a3, voffA);
            PG8_WAIT_V(8); PG8_WAIT_L(0); PG8_BAR; PG8_MMA(1, 0, At, B0); PG8_MMA(1, 1, At, B1); PG8_BAR; PG8_SCHED;
            } else {
            PG8_LDB(B0, 0, 0); PG8_SCHED; PG8_LDA(At, 0, 0); PG8_STAGE(PG8_SA(1, 1), a1 + hstep, voffA);
            PG8_WAIT_L(8); PG8_BAR; PG8_WAIT_L(0); PG8_MMA(0, 0, At, B0); PG8_BAR; PG8_SCHED;
            PG8_LDB(B1, 0, 1); PG8_STAGE(PG8_SB(0, 0), b2, voffB);
            PG8_BAR; PG8_WAIT_L(0); PG8_MMA(0, 1, At, B1); PG8_BAR;
            PG8_LDA(At, 0, 1); PG8_STAGE(PG8_SA(0, 0), a2, voffA);
            PG8_BAR; PG8_WAIT_L(0); PG8_MMA(1, 0, At, B0); PG8_BAR; PG8_SCHED;
            PG8_STAGE(PG8_SB(0, 1), b2 + hstep, voffB);
            PG8_WAIT_V(6); PG8_BAR; PG8_MMA(1, 1, At, B1); PG8_BAR;
            PG8_LDB(B0, 1, 0); PG8_SCHED; PG8_LDA(At, 1, 0); PG8_STAGE(PG8_SA(0, 1), a2 + hstep, voffA);
            PG8_WAIT_L(8); PG8_BAR; PG8_WAIT_L(0); PG8_MMA(0, 0, At, B0); PG8_BAR; PG8_SCHED;
            PG8_LDB(B1, 1, 1); PG8_STAGE(PG8_SB(1, 0), b3, voffB);
            PG8_BAR; PG8_WAIT_L(0); PG8_MMA(0, 1, At, B1); PG8_BAR;
            PG8_LDA(At, 1, 1); PG8_STAGE(PG8_SA(1, 0), a3, voffA);
            PG8_BAR; PG8_WAIT_L(0); PG8_MMA(1, 0, At, B0); PG8_BAR; PG8_SCHED;
            PG8_STAGE(PG8_SB(1, 1), b3 + hstep, voffB);
            PG8_WAIT_V(6); PG8_BAR; PG8_MMA(1, 1, At, B1); PG8_BAR;
            }
        }
        if constexpr (ALIGN_EPI) { if (wr == 0) PG8_BAR; }
        if constexpr (!Epi::AFTER_DRAIN) { E(acc, cur, wr, wc, fr, fq); S.done(cur); }
        if (!has_next) break;
#pragma unroll
        for (int a = 0; a < 2; ++a)
#pragma unroll
            for (int b = 0; b < 2; ++b)
#pragma unroll
                for (int m = 0; m < 4; ++m)
#pragma unroll
                    for (int n = 0; n < 2; ++n) acc[a][b][m][n] = (f32x4){0.f, 0.f, 0.f, 0.f};
        cur = nxt; cA = nA; cB = nB; ++ui;
        if constexpr (ALIGN_EPI) { if (wr == 1) PG8_BAR; }
    }
    PG8_WAIT_V(0);
    if constexpr (!ALIGN_EPI) { if (wr == 0) PG8_BAR; }
    PG8_BAR;
    if constexpr (Epi::AFTER_DRAIN) { E.fused(acc, cur, wr, wc, fr, fq, lds, wid, lane); S.done(cur); }
#undef PG8_SA
#undef PG8_SB
#undef PG8_STAGE
#undef PG8_LDA
#undef PG8_LDB
#undef PG8_MMA
#undef PG8_WAIT_V
#undef PG8_WAIT_L
#undef PG8_BAR
#undef PG8_SCHED
}
}
namespace attn_body {
using bf16=__hip_bfloat16;
using bf16x8=__attribute__((ext_vector_type(8)))short;
using s16x4=__attribute__((ext_vector_type(4)))short;
using f32x16=__attribute__((ext_vector_type(16)))float;
using u32x4=__attribute__((ext_vector_type(4)))unsigned;
using f32x4_t=__attribute__((ext_vector_type(4)))float;
__device__ __forceinline__ float bf2f(short v){return __uint_as_float(((unsigned)(unsigned short)v)<<16);}
constexpr int D=64;
constexpr int NW=8,QBLK=32,QB=QBLK*NW,KVBLK=64;
__device__ __forceinline__ int crow(int r,int hi){return (r&3)+8*(r>>2)+4*hi;}
#define SBAR() __builtin_amdgcn_sched_barrier(0)
__device__ __forceinline__ void cmask(f32x16&p0,f32x16&p1,int jb,int qrel,int hi){
  const float NEG=-INFINITY; int kb=64*jb+4*hi;
  #pragma unroll
  for(int r=0;r<16;++r){int kv=kb+(r&3)+8*(r>>2); if(kv>qrel)p0[r]=NEG; if(kv+32>qrel)p1[r]=NEG;}
}

constexpr int NSLOT=3, SLOTB=8192;
constexpr int LDS_K=0, LDS_V=NSLOT*SLOTB, LDS_WS=2*NSLOT*SLOTB, LDS_OST=LDS_WS+NW*64*4, LDS_BYTES=LDS_OST+NW*4096;
constexpr float C2=0.125f*1.4426950408889634f;
__device__ __forceinline__ void glds16(const void*gsrc,unsigned lds_dst){unsigned keep;
  asm volatile("s_mov_b32 %0, m0\n\ts_mov_b32 m0, %2\n\ts_nop 0\n\tglobal_load_lds_dwordx4 %1, off\n\ts_mov_b32 m0, %0":"=&s"(keep):"v"(gsrc),"s"(lds_dst):"memory");}
__device__ __forceinline__ float max3f(float a,float b,float c){float r;asm("v_max3_f32 %0, %1, %2, %3":"=v"(r):"v"(a),"v"(b),"v"(c));return r;}
__device__ __forceinline__ float max2f(float a,float b){float r;asm("v_max_f32_e32 %0, %1, %2":"=v"(r):"v"(a),"v"(b));return r;}
__device__ __forceinline__ float fadd_s(float a,float b){float r;asm("v_add_f32_e32 %0, %1, %2":"=v"(r):"v"(a),"v"(b));return r;}
__device__ __forceinline__ float fsub_s(float a,float b){float r;asm("v_sub_f32_e32 %0, %1, %2":"=v"(r):"v"(a),"v"(b));return r;}
typedef float f32x2_t __attribute__((ext_vector_type(2))); typedef __bf16 bf16x2_t __attribute__((ext_vector_type(2)));
__device__ __forceinline__ unsigned cvtpk_s(float lo,float hi){f32x2_t v={lo,hi};bf16x2_t b=__builtin_convertvector(v,bf16x2_t);return __builtin_bit_cast(unsigned,b);}
#define WAIT_BAR(N) asm volatile("s_waitcnt vmcnt(" #N ") lgkmcnt(0)\n\ts_barrier":::"memory")

__device__ __forceinline__ float wave_max_f(float v){
  #define DPPMX(ctrl) v=__builtin_fmaxf(v,__builtin_bit_cast(float,__builtin_amdgcn_update_dpp(__builtin_bit_cast(int,v),__builtin_bit_cast(int,v),(ctrl),0xf,0xf,false)))
  DPPMX(0xB1); DPPMX(0x4E); DPPMX(0x141); DPPMX(0x140);
  #undef DPPMX
  const int vi=__builtin_bit_cast(int,v);
  return __builtin_fmaxf(__builtin_fmaxf(__builtin_bit_cast(float,__builtin_amdgcn_readlane(vi,0)),__builtin_bit_cast(float,__builtin_amdgcn_readlane(vi,16))),__builtin_fmaxf(__builtin_bit_cast(float,__builtin_amdgcn_readlane(vi,32)),__builtin_bit_cast(float,__builtin_amdgcn_readlane(vi,48))));
}
__device__ __forceinline__ void qkt(f32x16&p0,f32x16&p1,const char*Kslot,const bf16x8*qr,const f32x16&negm,int r32,int hi){
  const char*kb=Kslot+hi*1024+r32*16;
  #pragma unroll
  for(int d0=0;d0<4;++d0){
    const bf16x8 b0=*reinterpret_cast<const bf16x8*>(kb+d0*2048);
    const bf16x8 b1=*reinterpret_cast<const bf16x8*>(kb+d0*2048+512);
    if(d0==0){p0=__builtin_amdgcn_mfma_f32_32x32x16_bf16(b0,qr[0],negm,0,0,0);p1=__builtin_amdgcn_mfma_f32_32x32x16_bf16(b1,qr[0],negm,0,0,0);}
    else{p0=__builtin_amdgcn_mfma_f32_32x32x16_bf16(b0,qr[d0],p0,0,0,0);p1=__builtin_amdgcn_mfma_f32_32x32x16_bf16(b1,qr[d0],p1,0,0,0);}}
}
typedef __attribute__((address_space(3))) const char* lds_cptr;
typedef short v4i16_t __attribute__((ext_vector_type(4)));
__device__ __forceinline__ void kload8(bf16x8*kf,lds_cptr kp){
  kf[0]=*(const __attribute__((address_space(3))) bf16x8*)(kp);      kf[1]=*(const __attribute__((address_space(3))) bf16x8*)(kp+512);
  kf[2]=*(const __attribute__((address_space(3))) bf16x8*)(kp+2048); kf[3]=*(const __attribute__((address_space(3))) bf16x8*)(kp+2560);
  kf[4]=*(const __attribute__((address_space(3))) bf16x8*)(kp+4096); kf[5]=*(const __attribute__((address_space(3))) bf16x8*)(kp+4608);
  kf[6]=*(const __attribute__((address_space(3))) bf16x8*)(kp+6144); kf[7]=*(const __attribute__((address_space(3))) bf16x8*)(kp+6656);
}
__device__ __forceinline__ void kload2(bf16x8*kf,lds_cptr kp,int j){ kf[2*j]=*(const __attribute__((address_space(3))) bf16x8*)(kp+j*2048); kf[2*j+1]=*(const __attribute__((address_space(3))) bf16x8*)(kp+j*2048+512); }
__device__ __forceinline__ s16x4 vtr(lds_cptr p){ return __builtin_bit_cast(s16x4,__builtin_amdgcn_ds_read_tr16_b64_v4i16((__attribute__((address_space(3))) v4i16_t*)p)); }
__device__ __forceinline__ float rowmax(const f32x16&p0,const f32x16&p1){
  float a=max3f(p0[0],p0[1],p1[0]),b=max3f(p0[2],p0[3],p1[1]);a=max3f(a,p1[2],p1[3]);
  #pragma unroll
  for(int r=4;r<16;r+=4){a=max3f(a,p0[r],p0[r+1]);b=max3f(b,p0[r+2],p0[r+3]);a=max3f(a,p1[r],p1[r+1]);b=max3f(b,p1[r+2],p1[r+3]);}
  const float m=max2f(a,b);
  auto rr=__builtin_amdgcn_permlane32_swap(__float_as_uint(m),__float_as_uint(m),false,false);
  return max2f(__uint_as_float(rr[0]),__uint_as_float(rr[1]));
}
__device__ __forceinline__ void pv(f32x16*o,int vb,bf16x8 pa0,bf16x8 pa1,bf16x8 pa2,bf16x8 pa3){
  #pragma unroll
  for(int d0=0;d0<2;++d0){s16x4 lo[4],hi[4];
    #pragma unroll
    for(int ks=0;ks<4;++ks){
      asm volatile("ds_read_b64_tr_b16 %0,%1 offset:%c2":"=&v"(lo[ks]):"v"(vb),"i"(d0*4096+ks*1024):"memory");
      asm volatile("ds_read_b64_tr_b16 %0,%1 offset:%c2":"=&v"(hi[ks]):"v"(vb),"i"(d0*4096+ks*1024+512):"memory");}
    asm volatile("s_waitcnt lgkmcnt(0)":::"memory");SBAR();
    #define PK(k) (bf16x8){lo[k][0],lo[k][1],lo[k][2],lo[k][3],hi[k][0],hi[k][1],hi[k][2],hi[k][3]}
    o[d0]=__builtin_amdgcn_mfma_f32_32x32x16_bf16(pa0,PK(0),o[d0],0,0,0);
    o[d0]=__builtin_amdgcn_mfma_f32_32x32x16_bf16(pa1,PK(1),o[d0],0,0,0);
    o[d0]=__builtin_amdgcn_mfma_f32_32x32x16_bf16(pa2,PK(2),o[d0],0,0,0);
    o[d0]=__builtin_amdgcn_mfma_f32_32x32x16_bf16(pa3,PK(3),o[d0],0,0,0);
    #undef PK
  }
}

#ifndef ATTN_STORE16
#define ATTN_STORE16(p,v) (*(u32x4*)(p)=(v))
#endif
template<int THRL,int MODE,int qp,int kvp,int zp> __device__ __forceinline__ void attn_unit(int NT,const bf16*Qu,const bf16*__restrict__ Kh,const bf16*__restrict__ Vh,bf16*Zu,const float*ksum,int nsel,char*shm,const int wave_s,const bool dry=false,const float*rtq=nullptr){
  int lane=__builtin_amdgcn_mbcnt_hi(~0u,__builtin_amdgcn_mbcnt_lo(~0u,0u)); asm volatile("":"+v"(lane));   const int tid=wave_s*64+lane; (void)tid; const int r32=lane&31,hi=lane>>5; float zf=0.f; asm volatile("":"+v"(zf)); const int wid=wave_s;
  const bf16*Qw=Qu+(long)(wid*QBLK)*qp;
  const unsigned lds0=(unsigned)(uintptr_t)shm;
  float*wsf=(float*)(shm+LDS_WS)+wid*64;
  const bf16*ksrc=Kh+(long)lane*kvp+wid*8;
  const bf16*vsrc=Vh+(long)(16*(wid&3)+(lane>>2))*kvp+(wid>>2)*32+(lane&3)*8;
  const unsigned kdst=lds0+LDS_K+wid*1024, vdst=lds0+LDS_V+wid*1024;
  #define DMA_K(t,slot) glds16(ksrc+(long)(t)*KVBLK*kvp,(unsigned)__builtin_amdgcn_readfirstlane(kdst+(slot)))
  #define DMA_V(t,slot) glds16(vsrc+(long)(t)*KVBLK*kvp,(unsigned)__builtin_amdgcn_readfirstlane(vdst+(slot)))
  const int vb0=(int)(lds0+LDS_V)+((lane>>4)&1)*32+(lane&3)*8+(4*hi+((lane&15)>>2))*64;
  const char*Kbase=shm+LDS_K; bf16x8 kf[8];
  const lds_cptr shm3=(lds_cptr)shm; const lds_cptr kp0=shm3+LDS_K+hi*1024+r32*16; const lds_cptr vp0=shm3+LDS_V+((lane>>4)&1)*32+(lane&3)*8+(4*hi+((lane&15)>>2))*64;
  DMA_K(0,0);DMA_V(0,0);DMA_K(1,SLOTB);
  bf16x8 qr[4];
  #pragma unroll
  for(int d0=0;d0<4;++d0)qr[d0]=*reinterpret_cast<const bf16x8*>(&Qw[(long)r32*qp+d0*16+hi*8]);
  if(MODE==1){ const float*rp_=rtq+(long)(wid*QBLK+r32)*64+8*hi;
    _Pragma("unroll") for(int d0=0;d0<4;++d0){ const f32x4_t t0=*(const f32x4_t*)(rp_+16*d0), t1=*(const f32x4_t*)(rp_+16*d0+4);
      const float a0=bf2f(qr[d0][0]),b0=bf2f(qr[d0][1]),a1=bf2f(qr[d0][2]),b1=bf2f(qr[d0][3]),a2=bf2f(qr[d0][4]),b2=bf2f(qr[d0][5]),a3=bf2f(qr[d0][6]),b3=bf2f(qr[d0][7]);
      u32x4 w_; w_[0]=cvtpk_s((a0*t0[0]-b0*t0[1])*C2,(b0*t0[0]+a0*t0[1])*C2); w_[1]=cvtpk_s((a1*t0[2]-b1*t0[3])*C2,(b1*t0[2]+a1*t0[3])*C2);
      w_[2]=cvtpk_s((a2*t1[0]-b2*t1[1])*C2,(b2*t1[0]+a2*t1[1])*C2); w_[3]=cvtpk_s((a3*t1[2]-b3*t1[3])*C2,(b3*t1[2]+a3*t1[3])*C2); qr[d0]=__builtin_bit_cast(bf16x8,w_); } }
  unsigned selmask=0xffffffffu;
  if(MODE==1){ if(nsel>3){ float v0=-INFINITY,v1=-INFINITY,v2=-INFINITY; int i0=0,i1=0,i2=0;
      for(int j=0;j<nsel;++j){ const float*kp=ksum+(long)j*768+hi*8; float g=0.f;
        _Pragma("unroll") for(int d0=0;d0<4;++d0){ const f32x4_t ka=*(const f32x4_t*)(kp+d0*16), kb=*(const f32x4_t*)(kp+d0*16+4);
          g+=bf2f(qr[d0][0])*ka[0]+bf2f(qr[d0][1])*ka[1]+bf2f(qr[d0][2])*ka[2]+bf2f(qr[d0][3])*ka[3]+bf2f(qr[d0][4])*kb[0]+bf2f(qr[d0][5])*kb[1]+bf2f(qr[d0][6])*kb[2]+bf2f(qr[d0][7])*kb[3]; }
        { auto rr_=__builtin_amdgcn_permlane32_swap(__float_as_uint(g),__float_as_uint(g),false,false); g=__uint_as_float(rr_[0])+__uint_as_float(rr_[1]); }
        if(g>v0){v2=v1;i2=i1;v1=v0;i1=i0;v0=g;i0=j;} else if(g>v1){v2=v1;i2=i1;v1=g;i1=j;} else if(g>v2){v2=g;i2=j;} }
      selmask=(1u<<i0)|(1u<<i1)|(1u<<i2); } }
  float mhat=0.f,l_reg=0.f;f32x16 o[2];_Pragma("unroll") for(int r=0;r<16;++r){o[0][r]=zf;o[1][r]=zf;} const f32x16 negm=f32x16{};
  const int qrel=wid*QBLK+r32;
  #define CMASK(P0,P1,t) do{ if(MODE==1){int jb_=(t)-(NT-4); if(jb_>=0)cmask(P0,P1,jb_,qrel,hi);} }while(0)
  bool resc=false;
  #define START(P0,P1) do{ const float rm=rowmax(P0,P1); resc=false; \
    { const float wm_=wave_max_f(rm); const float dl=(rm==-INFINITY)?((wm_==-INFINITY)?0.f:wm_):rm; mhat=fadd_s(mhat,dl);     \
      _Pragma("unroll") for(int r=0;r<16;++r){P0[r]=fsub_s(P0[r],dl);P1[r]=fsub_s(P1[r],dl);} \
      } \
    _Pragma("unroll") for(int r=0;r<16;++r)P0[r]=__builtin_amdgcn_exp2f(P0[r]); }while(0)
  #define RESC() do{ if(resc){ asm volatile("s_waitcnt lgkmcnt(0)":::"memory"); \
      _Pragma("unroll") for(int d_=0;d_<2;++d_) _Pragma("unroll") for(int r=0;r<16;++r)o[d_][r]*=wsf[crow(r,hi)]; } }while(0)
  f32x16 pA0,pA1,pB0,pB1;
  int sl_prev=0,sl_cur=0,sl_next=SLOTB;
  #define ROT() do{sl_prev=sl_cur;sl_cur=sl_next;sl_next=(sl_next==(NSLOT-1)*SLOTB)?0:sl_next+SLOTB;}while(0)
  DMA_K(2,2*SLOTB);
  WAIT_BAR(3);
  qkt(pA0,pA1,Kbase,qr,negm,r32,hi);asm volatile("s_nop 15\n\ts_nop 7":"+v"(pA0),"+v"(pA1));CMASK(pA0,pA1,0);
  if(MODE==1){ const float ms0=(NT>4&&!(selmask&1u))?INFINITY:0.f; _Pragma("unroll") for(int r=0;r<16;++r){pA0[r]-=ms0;pA1[r]-=ms0;} }
  START(pA0,pA1);
  _Pragma("unroll") for(int r=0;r<16;++r)pA1[r]=__builtin_amdgcn_exp2f(pA1[r]);
  WAIT_BAR(0);
  DMA_K(3,0);DMA_V(1,SLOTB);
  ROT();
  kload8(kf,kp0+sl_cur);
  WAIT_BAR(2);
  s16x4 vlo[8],vhi[8]; u32x4 pw0,pw1,pw2,pw3; f32x16 cin;
  #define PKW(P,B) cvtpk_s(P[B],P[B+1])
  #define PAF(k) __builtin_bit_cast(bf16x8,pw##k)
  #define VFR(i) (bf16x8){vlo[i][0],vlo[i][1],vlo[i][2],vlo[i][3],vhi[i][0],vhi[i][1],vhi[i][2],vhi[i][3]}
  #define PIN(x) asm volatile("":"+v"(x))
  #define MX3(a,b,c) __builtin_fmaxf(__builtin_fmaxf((a),(b)),(c))
  #define GAPA(MF,A0,A1,A2,A3,W0,W1,PW) do{ MF; sacc+=A0; sacc+=A1; sacc+=A2; sacc+=A3; PIN(sacc); W0; W1; PIN(PW); SBAR(); }while(0)
  #define EX(v) __builtin_amdgcn_exp2f(v)
  #define GAPB(MF,X,B) do{ MF; X[B]=EX(X[B]); X[B+1]=EX(X[B+1]); X[B+2]=EX(X[B+2]); X[B+3]=EX(X[B+3]); PIN(X); SBAR(); }while(0)
  #define VRD(i) do{ vlo[i]=vtr(vp_+(((i)>>2)*4096+((i)&3)*1024)); vhi[i]=vtr(vp_+(((i)>>2)*4096+((i)&3)*1024+512)); }while(0)
  #define KRD(G,j) do{ if(G){ kload2(kf,kp0+sl_next,j); SBAR(); } }while(0)
  #define STEP(C0,C1,P0,P1,t,GK,GV,GL) do{ { const float cv_=(MODE==1&&(t)<NT-4&&!((selmask>>((t)>>2))&1u))?-INFINITY:-mhat; _Pragma("unroll") for(int r=0;r<16;++r)cin[r]=cv_; asm volatile("":"+v"(cin)); } SBAR(); \
    const lds_cptr vp_=vp0+sl_prev; \
    VRD(0); SBAR(); float sacc=(P0[0]+P0[1]); \
    GAPA(C0=__builtin_amdgcn_mfma_f32_32x32x16_bf16(kf[0],qr[0],cin,0,0,0), P0[2],P0[3],P0[4],P0[5],     pw0[0]=PKW(P0,0), pw0[1]=PKW(P0,2), pw0); \
    VRD(4); SBAR(); GAPA(C1=__builtin_amdgcn_mfma_f32_32x32x16_bf16(kf[1],qr[0],cin,0,0,0), P0[6],P0[7],P0[8],P0[9],     pw0[2]=PKW(P0,4), pw0[3]=PKW(P0,6), pw0); \
    VRD(1); SBAR(); GAPA(C0=__builtin_amdgcn_mfma_f32_32x32x16_bf16(kf[2],qr[1],C0,0,0,0),   P0[10],P0[11],P0[12],P0[13], pw1[0]=PKW(P0,8), pw1[1]=PKW(P0,10), pw1); \
    VRD(5); SBAR(); GAPA(C1=__builtin_amdgcn_mfma_f32_32x32x16_bf16(kf[3],qr[1],C1,0,0,0),   P0[14],P0[15],P1[0],P1[1],   pw1[2]=PKW(P0,12),pw1[3]=PKW(P0,14), pw1); \
    VRD(2); SBAR(); GAPA(C0=__builtin_amdgcn_mfma_f32_32x32x16_bf16(kf[4],qr[2],C0,0,0,0),   P1[2],P1[3],P1[4],P1[5],     pw2[0]=PKW(P1,0), pw2[1]=PKW(P1,2), pw2); \
    VRD(6); SBAR(); GAPA(C1=__builtin_amdgcn_mfma_f32_32x32x16_bf16(kf[5],qr[2],C1,0,0,0),   P1[6],P1[7],P1[8],P1[9],     pw2[2]=PKW(P1,4), pw2[3]=PKW(P1,6), pw2); \
    VRD(3); SBAR(); GAPA(C0=__builtin_amdgcn_mfma_f32_32x32x16_bf16(kf[6],qr[3],C0,0,0,0),   P1[10],P1[11],P1[12],P1[13], pw3[0]=PKW(P1,8), pw3[1]=PKW(P1,10), pw3); \
    VRD(7); SBAR(); GAPA(C1=__builtin_amdgcn_mfma_f32_32x32x16_bf16(kf[7],qr[3],C1,0,0,0),   P1[14],P1[15],0.f,0.f,       pw3[2]=PKW(P1,12),pw3[3]=PKW(P1,14), pw3); \
    l_reg+=sacc; \
    if(GK){DMA_K((t)+3,sl_cur);} if(GV){DMA_V((t)+1,sl_next);} \
    CMASK(C0,C1,t); \
    { float a=MX3(C0[0],C0[1],C1[0]),b=MX3(C0[2],C0[3],C1[1]); a=MX3(a,C1[2],C1[3]); \
      _Pragma("unroll") for(int r=4;r<16;r+=4){a=MX3(a,C0[r],C0[r+1]);b=MX3(b,C0[r+2],C0[r+3]);a=MX3(a,C1[r],C1[r+1]);b=MX3(b,C1[r+2],C1[r+3]);} \
      float rm=__builtin_fmaxf(a,b); { auto rr=__builtin_amdgcn_permlane32_swap(__float_as_uint(rm),__float_as_uint(rm),false,false); rm=__builtin_fmaxf(__uint_as_float(rr[0]),__uint_as_float(rr[1])); } \
      resc=false; \
      if(__builtin_expect(__any(rm>(float)THRL),0)){ const float dl=__builtin_fmaxf(rm,0.f); mhat+=dl; \
        _Pragma("unroll") for(int r=0;r<16;++r){C0[r]-=dl;C1[r]-=dl;} \
        const float f=__builtin_amdgcn_exp2f(-dl); l_reg*=f; if(hi==0)wsf[r32]=f; resc=true; } } \
    SBAR(); \
    GAPB(o[0]=__builtin_amdgcn_mfma_f32_32x32x16_bf16(PAF(0),VFR(0),o[0],0,0,0), C0,0); \
    GAPB(o[1]=__builtin_amdgcn_mfma_f32_32x32x16_bf16(PAF(0),VFR(4),o[1],0,0,0), C0,4); \
    KRD(GL,0); GAPB(o[0]=__builtin_amdgcn_mfma_f32_32x32x16_bf16(PAF(1),VFR(1),o[0],0,0,0), C0,8); \
    KRD(GL,1); GAPB(o[1]=__builtin_amdgcn_mfma_f32_32x32x16_bf16(PAF(1),VFR(5),o[1],0,0,0), C0,12); \
    KRD(GL,2); GAPB(o[0]=__builtin_amdgcn_mfma_f32_32x32x16_bf16(PAF(2),VFR(2),o[0],0,0,0), C1,0); \
    KRD(GL,3); GAPB(o[1]=__builtin_amdgcn_mfma_f32_32x32x16_bf16(PAF(2),VFR(6),o[1],0,0,0), C1,4); \
    GAPB(o[0]=__builtin_amdgcn_mfma_f32_32x32x16_bf16(PAF(3),VFR(3),o[0],0,0,0), C1,8); \
    GAPB(o[1]=__builtin_amdgcn_mfma_f32_32x32x16_bf16(PAF(3),VFR(7),o[1],0,0,0), C1,12); \
    }while(0)
  int t=1;
  #undef CMASK
  #define CMASK(P0,P1,t) do{ if(MODE==1){int jb_=(t)-(NT-4); if(jb_>=0)cmask(P0,P1,jb_,qrel,hi);} }while(0)
  for(;t+5<NT;t+=2){
    STEP(pB0,pB1,pA0,pA1,t,true,true,true);     WAIT_BAR(2); RESC(); ROT();
    STEP(pA0,pA1,pB0,pB1,t+1,true,true,true);   WAIT_BAR(2); RESC(); ROT();
  }
  #undef CMASK
  #define CMASK(P0,P1,t) do{ if(MODE==1){int jb_=(t)-(NT-4); if(jb_>=0)cmask(P0,P1,jb_,qrel,hi);} }while(0)
  #define ENDW(tt) do{ if((tt)+3<NT){WAIT_BAR(2);} else if((tt)+2<NT){WAIT_BAR(1);} else {WAIT_BAR(0);} }while(0)
  for(;t+1<NT;t+=2){
    STEP(pB0,pB1,pA0,pA1,t,(t+3<NT),(t+1<NT),(t+1<NT));       ENDW(t);   RESC(); ROT();
    STEP(pA0,pA1,pB0,pB1,t+1,(t+4<NT),(t+2<NT),(t+2<NT));     ENDW(t+1); RESC(); ROT();
  }
  STEP(pB0,pB1,pA0,pA1,NT-1,false,false,false); RESC();
  { float sacc=pB0[0]+pB0[1]; _Pragma("unroll") for(int r=2;r<16;++r)sacc+=pB0[r]; _Pragma("unroll") for(int r=0;r<16;++r)sacc+=pB1[r]; l_reg+=sacc;
    pw0=(u32x4){PKW(pB0,0),PKW(pB0,2),PKW(pB0,4),PKW(pB0,6)};pw1=(u32x4){PKW(pB0,8),PKW(pB0,10),PKW(pB0,12),PKW(pB0,14)};pw2=(u32x4){PKW(pB1,0),PKW(pB1,2),PKW(pB1,4),PKW(pB1,6)};pw3=(u32x4){PKW(pB1,8),PKW(pB1,10),PKW(pB1,12),PKW(pB1,14)};
    SBAR(); pv(o,vb0+sl_cur,PAF(0),PAF(1),PAF(2),PAF(3)); }
  #undef PKW
  #undef PAF
  #undef VFR
  #undef PIN
  #undef MX3
  #undef GAPA
  #undef GAPB
  #undef EX
  #undef VRD
  #undef KRD
  #undef STEP
  #undef ENDW
  bf16*Zw=Zu+(long)(wid*QBLK)*zp;
  u32x4 zq[4];
  #pragma unroll
  for(int i=0;i<4;++i)zq[i]=*(const u32x4*)(Zw+(long)(i*8+(lane>>3))*zp+(lane&7)*8);
  {auto rr=__builtin_amdgcn_permlane32_swap(__float_as_uint(l_reg),__float_as_uint(l_reg),false,false);l_reg=__uint_as_float(rr[0])+__uint_as_float(rr[1]);}
  if(hi==0)wsf[32+r32]=l_reg;asm volatile("s_waitcnt lgkmcnt(0)":::"memory");
  float rli[16];
  #pragma unroll
  for(int r=0;r<16;++r)rli[r]=__builtin_amdgcn_rcpf(wsf[32+crow(r,hi)]);
  { bf16*stg=(bf16*)(shm+LDS_OST)+wid*2048;
    #pragma unroll
    for(int r=0;r<16;++r){const int orow=crow(r,hi);
      #pragma unroll
      for(int d0=0;d0<2;++d0)stg[orow*64+d0*32+r32]=__float2bfloat16(o[d0][r]*rli[r]);}
    asm volatile("s_waitcnt lgkmcnt(0)":::"memory");
    #pragma unroll
    for(int i=0;i<4;++i){const int row=i*8+(lane>>3),ch=lane&7; const u32x4 v=*(const u32x4*)(stg+row*64+ch*8); u32x4*zpz=(u32x4*)(Zw+(long)row*zp+ch*8); const u32x4 zz=zq[i]; u32x4 yy;
      _Pragma("unroll") for(int e=0;e<4;++e){ const float o0=__uint_as_float(v[e]<<16),o1=__uint_as_float(v[e]&0xffff0000u),z0=__uint_as_float(zz[e]<<16),z1=__uint_as_float(zz[e]&0xffff0000u);
        yy[e]=cvtpk_s(o0*z0*__builtin_amdgcn_rcpf(1.f+__expf(-z0)),o1*z1*__builtin_amdgcn_rcpf(1.f+__expf(-z1))); }
      if(!dry)*zpz=yy;} }
  asm volatile("s_waitcnt lgkmcnt(0)\n\ts_barrier":::"memory");
  #undef DMA_K
  #undef DMA_V
  #undef CMASK
  #undef START
  #undef RESC
  #undef ROT
}
constexpr int ATTN_LDS_BYTES=LDS_BYTES;
#undef SBAR
#undef WAIT_BAR
}
namespace cg = cooperative_groups;
constexpr int BATCH = 8, SEQ = 4096, DM = 1024, M = BATCH * SEQ;
constexpr int NMEM = 256, MROWS = BATCH * NMEM;
constexpr int N_IN0 = 3608, N_IN0P = 3840, N_IN1 = 3584;
constexpr int NUNIT_D = BATCH * 12 * 64;
constexpr float C2 = 0.125f * 1.4426950408889634f;
constexpr float EPS = 1e-6f;
constexpr int NTHREADS = 512;
constexpr int LDS_BYTES = 161792 + 512;
constexpr size_t MiB = 1u << 20;
constexpr size_t WS_KSUM = 0;
constexpr size_t WS_GL = 512 * 1024;
constexpr size_t WS_WCAT0 = 2 * MiB;
constexpr size_t WS_WOUT0 = 12 * MiB, WS_WIN1 = 14 * MiB, WS_WOUT1 = 21 * MiB;
constexpr size_t WS_ROPE = 24 * MiB;
constexpr size_t WS_ACAT = 32 * MiB;
constexpr size_t WS_MKV = 104 * MiB;
constexpr size_t WS_QKV = 108 * MiB;
constexpr size_t WS_Z = 252 * MiB;
constexpr size_t WS_MQ = 316 * MiB;
constexpr size_t WS_BA = 332 * MiB;
constexpr size_t WS_DW = WS_ACAT;
constexpr size_t WS_DU = 336 * MiB, WS_DA = 384 * MiB;
constexpr size_t WS_PS = 432 * MiB;
constexpr size_t WS_END = 434 * MiB;

#define LAS __attribute__((address_space(3)))
typedef unsigned short bf16;
typedef unsigned v4u __attribute__((ext_vector_type(4)));
typedef unsigned v2u __attribute__((ext_vector_type(2)));
typedef float f32x4 __attribute__((ext_vector_type(4)));
typedef float f32x2v __attribute__((ext_vector_type(2)));
typedef __bf16 bf16x2v __attribute__((ext_vector_type(2)));
typedef short bf16x8 __attribute__((ext_vector_type(8)));
#define LDS_WAIT() asm volatile("s_waitcnt lgkmcnt(0)" ::: "memory")
__device__ __forceinline__ unsigned pk2(float lo, float hi) { f32x2v v = {lo, hi}; bf16x2v b = __builtin_convertvector(v, bf16x2v); return __builtin_bit_cast(unsigned, b); }
__device__ __forceinline__ float bflo(unsigned u) { return __uint_as_float(u << 16); }
__device__ __forceinline__ float bfhi(unsigned u) { return __uint_as_float(u & 0xffff0000u); }
__device__ __forceinline__ float bf1(bf16 u) { return __uint_as_float(((unsigned)u) << 16); }
__device__ __forceinline__ float dppf(float v, const int ctrl_dummy);
#define DPP_ADD(v, ctrl) ((v) + __builtin_bit_cast(float, __builtin_amdgcn_update_dpp(0, __builtin_bit_cast(int, (v)), (ctrl), 0xf, 0xf, true)))
__device__ __forceinline__ float row8_sum(float v) { v = DPP_ADD(v, 0xB1); v = DPP_ADD(v, 0x4E); v = DPP_ADD(v, 0x141); return v; }
__device__ __forceinline__ float row16_sum(float v) { v = row8_sum(v); v = DPP_ADD(v, 0x140); return v; }
__device__ __forceinline__ float wave_sum(float v) {
    v = row16_sum(v); const int vi = __builtin_bit_cast(int, v);
    return (__builtin_bit_cast(float, __builtin_amdgcn_readlane(vi, 0)) + __builtin_bit_cast(float, __builtin_amdgcn_readlane(vi, 16))) + (__builtin_bit_cast(float, __builtin_amdgcn_readlane(vi, 32)) + __builtin_bit_cast(float, __builtin_amdgcn_readlane(vi, 48)));
}
__device__ __forceinline__ float silu_f(float x) { return x * __builtin_amdgcn_rcpf(1.f + __expf(-x)); }
__device__ const float ROPE_INVF[32] = {1.000000000e+00f, 7.498942614e-01f, 5.623413324e-01f, 4.216965139e-01f, 3.162277639e-01f, 2.371373773e-01f, 1.778279394e-01f, 1.333521307e-01f, 1.000000015e-01f, 7.498941571e-02f, 5.623413250e-02f, 4.216965288e-02f, 3.162277490e-02f, 2.371373773e-02f, 1.778279431e-02f, 1.333521493e-02f, 9.999999776e-03f, 7.498941850e-03f, 5.623413250e-03f, 4.216964822e-03f, 3.162277630e-03f, 2.371373586e-03f, 1.778279431e-03f, 1.333521446e-03f, 1.000000047e-03f, 7.498942432e-04f, 5.623413017e-04f, 4.216965172e-04f, 3.162277571e-04f, 2.371373703e-04f, 1.778279402e-04f, 1.333521504e-04f};

struct OrderX {
    int nM, nN, nwg, G, c, nextra;
    __device__ void init(int nM_, int nN_, int G_, int c_, int nextra_) { nM = nM_; nN = nN_; nwg = nM * nN; G = G_; c = c_; nextra = nextra_; }
    __device__ bool next(int i, pg8::Unit& u) const {
        const long L = (long)i * G + c; if (L >= nwg + nextra) return false;
        if (L >= nwg) { const int e = (int)L - nwg, layer = e >> 4; u.pm = 128 + 8 * layer + ((e & 15) >> 1); u.pn = 15 + 2 * layer + (e & 1); return true; }
        int wgid = (int)L; { const int q = nwg / pg8::NXCD, r = nwg % pg8::NXCD, xcd = wgid % pg8::NXCD, off = wgid / pg8::NXCD; wgid = (xcd < r ? xcd * (q + 1) : r * (q + 1) + (xcd - r) * q) + off; }
        const int nig = pg8::WGM * nN, gid = wgid / nig, fm = gid * pg8::WGM, gsz = (nM - fm) < pg8::WGM ? (nM - fm) : pg8::WGM;
        u.pm = fm + ((wgid % nig) % gsz); u.pn = (wgid % nig) / gsz; return true;
    }
    __device__ __forceinline__ void a_ready(const pg8::Unit&) const {}
    __device__ __forceinline__ void done(const pg8::Unit&) const {}
};
struct EpiIn0 {
    static constexpr bool PERM = true, AFTER_DRAIN = false;
    bf16 *QKV, *Z, *MQ, *MKV; float* BA;
    __device__ __forceinline__ void operator()(const f32x4 (&acc)[2][2][4][2], const pg8::Unit& u, int wr, int wc, int fr_in, int fq_in) const {
        int fr = fr_in, fq = fq_in; asm volatile("" : "+v"(fr), "+v"(fq));
        const int pm = u.pm, pn = u.pn; bf16* base = QKV; int ld = 2304, colt = pn * 256, rowt = pm * 256; float sc = 1.f; bool isba = false;
        if (pm < 128) {
            if (pn < 9) {}
            else if (pn < 13) { base = Z; ld = 1024; colt = (pn - 9) * 256; }
            else if (pn == 13) { base = MQ; ld = 256; colt = 0; sc = C2; }
            else isba = true;
        } else { const int layer = (pm - 128) >> 3; base = MKV + (size_t)layer * (MROWS * 512); ld = 512; colt = (pn - 15 - 2 * layer) * 256; rowt = (pm - 128 - 8 * layer) * 256; }
        const int row0 = rowt + wr * 64 + fr, col0 = colt + wc * 32 + 8 * fq;
        if (!isba) {
#pragma unroll
            for (int ai = 0; ai < 2; ++ai)
#pragma unroll
                for (int m = 0; m < 4; ++m) { bf16* rowp = base + (unsigned)((row0 + ai * 128 + m * 16) * ld + col0);
#pragma unroll
                    for (int bj = 0; bj < 2; ++bj) { const f32x4 v0 = acc[ai][bj][m][0] * sc, v1 = acc[ai][bj][m][1] * sc; v4u w; w.x = pk2(v0[0], v0[1]); w.y = pk2(v0[2], v0[3]); w.z = pk2(v1[0], v1[1]); w.w = pk2(v1[2], v1[3]);
                        *(v4u*)(rowp + bj * 128) = w; } }
        } else if (wc == 0) {
#pragma unroll
            for (int ai = 0; ai < 2; ++ai)
#pragma unroll
                for (int m = 0; m < 4; ++m) { float* p = BA + (unsigned)((row0 + ai * 128 + m * 16) * 32 + 8 * fq); *(f32x4*)p = acc[ai][0][m][0]; *(f32x4*)(p + 4) = acc[ai][0][m][1]; }
        }
    }
};
struct EpiIn1 {
    static constexpr bool PERM = true, AFTER_DRAIN = false;
    bf16 *QKV, *Z, *MQ; const float* RT; float* KSUM;
    __device__ __forceinline__ void operator()(const f32x4 (&acc)[2][2][4][2], const pg8::Unit& u, int wr, int wc, int fr_in, int fq_in) const {
        int fr = fr_in, fq = fq_in, pm = u.pm, pn = u.pn; asm volatile("" : "+v"(fr), "+v"(fq), "+s"(pm), "+s"(pn));
        if (pn >= 3 && pn < 6) {
            bf16* base = QKV + (size_t)M * 768; const int colt = (pn - 3) * 256;
            const int row0 = pm * 256 + wr * 64 + fr, col0 = colt + wc * 32 + 8 * fq, i0 = (wc & 1) * 16 + 4 * fq;
#pragma unroll
            for (int bj = 0; bj < 2; ++bj) { float cs[8];
#pragma unroll
                for (int e = 0; e < 8; ++e) cs[e] = 0.f;
#pragma unroll
                for (int ai = 0; ai < 2; ++ai)
#pragma unroll
                    for (int m = 0; m < 4; ++m) { const int row = row0 + ai * 128 + m * 16;
                        const f32x4 t0 = *(const f32x4*)(RT + (unsigned)(row * 64 + 2 * i0)), t1 = *(const f32x4*)(RT + (unsigned)(row * 64 + 2 * i0 + 4));
                        const f32x4 v0 = acc[ai][bj][m][0], v1 = acc[ai][bj][m][1]; float o[8];
                        o[0] = v0[0] * t0[0] - v0[1] * t0[1]; o[1] = v0[1] * t0[0] + v0[0] * t0[1]; o[2] = v0[2] * t0[2] - v0[3] * t0[3]; o[3] = v0[3] * t0[2] + v0[2] * t0[3];
                        o[4] = v1[0] * t1[0] - v1[1] * t1[1]; o[5] = v1[1] * t1[0] + v1[0] * t1[1]; o[6] = v1[2] * t1[2] - v1[3] * t1[3]; o[7] = v1[3] * t1[2] + v1[2] * t1[3];
#pragma unroll
                        for (int e = 0; e < 8; ++e) cs[e] += o[e];
                        v4u w; w.x = pk2(o[0], o[1]); w.y = pk2(o[2], o[3]); w.z = pk2(o[4], o[5]); w.w = pk2(o[6], o[7]);
                        *(v4u*)(base + (unsigned)(row * 768 + col0 + bj * 128)) = w;
                        asm volatile("" ::: "memory"); }
#pragma unroll
                for (int e = 0; e < 8; ++e) { const float sm = row16_sum(cs[e]); if (fr == 0) atomicAdd(KSUM + (unsigned)(pm * 768 + colt + bj * 128 + wc * 32 + 8 * fq + e), sm); }
            }
        } else {
            bf16* base; int ld = 768, colt; float sc = 1.f;
            if (pn < 9) { const int t = pn / 3; base = QKV + (size_t)t * M * 768; colt = (pn - 3 * t) * 256; }
            else if (pn < 13) { base = Z; ld = 1024; colt = (pn - 9) * 256; }
            else { base = MQ; ld = 256; colt = 0; sc = C2; }
            const int row0 = pm * 256 + wr * 64 + fr, col0 = colt + wc * 32 + 8 * fq;
#pragma unroll
            for (int ai = 0; ai < 2; ++ai)
#pragma unroll
                for (int m = 0; m < 4; ++m) { bf16* rowp = base + (unsigned)((row0 + ai * 128 + m * 16) * ld + col0);
#pragma unroll
                    for (int bj = 0; bj < 2; ++bj) { const f32x4 v0 = acc[ai][bj][m][0] * sc, v1 = acc[ai][bj][m][1] * sc; v4u w; w.x = pk2(v0[0], v0[1]); w.y = pk2(v0[2], v0[3]); w.z = pk2(v1[0], v1[1]); w.w = pk2(v1[2], v1[3]);
                        *(v4u*)(rowp + bj * 128) = w; } }
        }
    }
};
__device__ __forceinline__ void p6b_rope(LAS unsigned char* lds, int G, bf16* K, const float* __restrict__ RT, float* KSUM, const int wave_s) {
    int lane_ = __builtin_amdgcn_mbcnt_hi(~0u, __builtin_amdgcn_mbcnt_lo(~0u, 0u)); asm volatile("" : "+v"(lane_)); const int tid = wave_s * 64 + lane_;
    LAS float* red = (LAS float*)lds;
    for (int u = blockIdx.x; u < 256; u += G) {
        const int pm = u >> 1, ch = u & 1;
        float cs[8];
#pragma unroll
        for (int e = 0; e < 8; ++e) cs[e] = 0.f;
        const int cc = tid % 48, rg = tid / 48, col = 384 * ch + 8 * cc, i0 = ((col & 63) >> 1);
        if (tid < 384) {
#pragma unroll 4
            for (int rr = 0; rr < 32; ++rr) { const int row = pm * 256 + rg * 32 + rr; v4u* p = (v4u*)(K + (unsigned)(row * 768 + col)); const v4u w = *p;
                const f32x4 t0 = *(const f32x4*)(RT + (unsigned)(row * 64 + 2 * i0)), t1 = *(const f32x4*)(RT + (unsigned)(row * 64 + 2 * i0 + 4)); float o[8];
                { const float a = bflo(w.x), b = bfhi(w.x); o[0] = a * t0[0] - b * t0[1]; o[1] = b * t0[0] + a * t0[1]; }
                { const float a = bflo(w.y), b = bfhi(w.y); o[2] = a * t0[2] - b * t0[3]; o[3] = b * t0[2] + a * t0[3]; }
                { const float a = bflo(w.z), b = bfhi(w.z); o[4] = a * t1[0] - b * t1[1]; o[5] = b * t1[0] + a * t1[1]; }
                { const float a = bflo(w.w), b = bfhi(w.w); o[6] = a * t1[2] - b * t1[3]; o[7] = b * t1[2] + a * t1[3]; }
#pragma unroll
                for (int e = 0; e < 8; ++e) cs[e] += o[e];
                v4u y; y.x = pk2(o[0], o[1]); y.y = pk2(o[2], o[3]); y.z = pk2(o[4], o[5]); y.w = pk2(o[6], o[7]); *p = y; }
#pragma unroll
            for (int e = 0; e < 8; ++e) red[rg * 384 + cc * 8 + e] = cs[e];
        }
        __syncthreads();
        if (tid < 384) { float s = 0.f;
#pragma unroll
            for (int g8 = 0; g8 < 8; ++g8) s += red[g8 * 384 + tid];
            KSUM[(unsigned)(pm * 768 + 384 * ch + tid)] = s; }
        __syncthreads();
    }
}
struct EpiOut {
    static constexpr bool PERM = true, AFTER_DRAIN = false;
    const float* resid; float* out;
    __device__ __forceinline__ void operator()(const f32x4 (&acc)[2][2][4][2], const pg8::Unit& u, int wr, int wc, int fr_in, int fq_in) const {
        int fr = fr_in, fq = fq_in; asm volatile("" : "+v"(fr), "+v"(fq));
        const int row0 = u.pm * 256 + wr * 64 + fr, col0 = u.pn * 256 + wc * 32 + 8 * fq;
#pragma unroll
        for (int ai = 0; ai < 2; ++ai)
#pragma unroll
            for (int m = 0; m < 4; ++m) { const unsigned off = (unsigned)((row0 + ai * 128 + m * 16) * DM + col0);
#pragma unroll
                for (int bj = 0; bj < 2; ++bj) { const f32x4 r0 = *(const f32x4*)(resid + off + bj * 128), r1 = *(const f32x4*)(resid + off + bj * 128 + 4);
                    *(f32x4*)(out + off + bj * 128) = r0 + acc[ai][bj][m][0]; *(f32x4*)(out + off + bj * 128 + 4) = r1 + acc[ai][bj][m][1]; } }
    }
};
struct EpiOutN {
    static constexpr bool PERM = true, AFTER_DRAIN = false;
    const float* resid; float* out; const float* gain; bf16* XN; float* PS;
    __device__ __forceinline__ void operator()(const f32x4 (&acc)[2][2][4][2], const pg8::Unit& u, int wr, int wc, int fr_in, int fq_in) const {
        int fr = fr_in, fq = fq_in; asm volatile("" : "+v"(fr), "+v"(fq));
        const int row0 = u.pm * 256 + wr * 64 + fr, col0 = u.pn * 256 + wc * 32 + 8 * fq;
        f32x4 gv[2][2];
#pragma unroll
        for (int bj = 0; bj < 2; ++bj) { gv[bj][0] = *(const f32x4*)(gain + col0 + bj * 128); gv[bj][1] = *(const f32x4*)(gain + col0 + bj * 128 + 4); }
#pragma unroll
        for (int ai = 0; ai < 2; ++ai)
#pragma unroll
            for (int m = 0; m < 4; ++m) { const int row = row0 + ai * 128 + m * 16; const unsigned off = (unsigned)(row * DM + col0); float ss = 0.f;
#pragma unroll
                for (int bj = 0; bj < 2; ++bj) { const f32x4 r0 = *(const f32x4*)(resid + off + bj * 128), r1 = *(const f32x4*)(resid + off + bj * 128 + 4);
                    const f32x4 h0 = r0 + acc[ai][bj][m][0], h1 = r1 + acc[ai][bj][m][1];
                    *(f32x4*)(out + off + bj * 128) = h0; *(f32x4*)(out + off + bj * 128 + 4) = h1;
                    ss += (h0[0] * h0[0] + h0[1] * h0[1]) + (h0[2] * h0[2] + h0[3] * h0[3]) + (h1[0] * h1[0] + h1[1] * h1[1]) + (h1[2] * h1[2] + h1[3] * h1[3]);
                    const f32x4 y0 = h0 * gv[bj][0], y1 = h1 * gv[bj][1]; v4u w; w.x = pk2(y0[0], y0[1]); w.y = pk2(y0[2], y0[3]); w.z = pk2(y1[0], y1[1]); w.w = pk2(y1[2], y1[3]);
                    *(v4u*)(XN + off + bj * 128) = w; }
                ss += __shfl_xor(ss, 16); ss += __shfl_xor(ss, 32);
                if (fq == 0) PS[(unsigned)(row * 16 + u.pn * 4 + wc)] = ss;
                if (m & 1) asm volatile("" ::: "memory"); }
    }
};

__device__ __forceinline__ int rope_row(int n) { const int d = n & 63; return (n - d) + ((d < 32) ? 2 * d : 2 * (d - 32) + 1); }
__device__ __forceinline__ void p0_transpose_item(const float* W, int K, int N, int nblk, bf16* WT, int row_off, bool ropeperm, LAS float* scr, int item, int lane) {
    const int kb = item / nblk, nb = item % nblk, k0 = 64 * kb, n0 = 32 * nb;
    const int nn = n0 + (lane & 31);
#pragma unroll 8
    for (int i = 0; i < 32; ++i) { const int kk = 2 * i + (lane >> 5); scr[kk * 33 + (lane & 31)] = (nn < N) ? W[(size_t)(k0 + kk) * N + nn] : 0.f; }
    LDS_WAIT(); asm volatile("" ::: "memory");
    const int c = lane & 7;
#pragma unroll
    for (int j = 0; j < 4; ++j) { const int nl = (lane >> 3) + 8 * j; const LAS float* s = scr + (8 * c) * 33 + nl; int n = n0 + nl; if (ropeperm && n < 1536) n = rope_row(n);
        v4u o; o.x = pk2(s[0 * 33], s[1 * 33]); o.y = pk2(s[2 * 33], s[3 * 33]); o.z = pk2(s[4 * 33], s[5 * 33]); o.w = pk2(s[6 * 33], s[7 * 33]);
        *(v4u*)(WT + (size_t)(row_off + n) * K + k0 + 8 * c) = o; }
    LDS_WAIT(); asm volatile("" ::: "memory");
}
__device__ __forceinline__ void rms_row_to_bf16(const float* xrow, const float* g0, bf16* o0, const float* g1, bf16* o1, int lane) {
    const f32x4* xr = (const f32x4*)xrow + lane; f32x4 v[4]; float s = 0.f;
#pragma unroll
    for (int j = 0; j < 4; ++j) { v[j] = xr[64 * j]; s += (v[j].x * v[j].x + v[j].y * v[j].y) + (v[j].z * v[j].z + v[j].w * v[j].w); }
    const float rstd = rsqrtf(wave_sum(s) * (1.f / DM) + EPS);
#pragma unroll
    for (int j = 0; j < 4; ++j) { const f32x4 g = ((const f32x4*)g0)[lane + 64 * j]; const f32x4 y = v[j] * rstd * g; v2u w; w.x = pk2(y.x, y.y); w.y = pk2(y.z, y.w); ((v2u*)o0)[lane + 64 * j] = w; }
    if (g1) {
#pragma unroll
        for (int j = 0; j < 4; ++j) { const f32x4 g = ((const f32x4*)g1)[lane + 64 * j]; const f32x4 y = v[j] * rstd * g; v2u w; w.x = pk2(y.x, y.y); w.y = pk2(y.z, y.w); ((v2u*)o1)[lane + 64 * j] = w; }
    }
}

__device__ __forceinline__ void rms_row2_to_bf16(const float* xa, const float* xb, const float* g0, bf16* oa, bf16* ob, int lane) {
    const f32x4* ra = (const f32x4*)xa + lane; const f32x4* rb = (const f32x4*)xb + lane; f32x4 va[4], vb[4]; float sa = 0.f, sb = 0.f;
#pragma unroll
    for (int j = 0; j < 4; ++j) { va[j] = ra[64 * j]; vb[j] = rb[64 * j]; }
#pragma unroll
    for (int j = 0; j < 4; ++j) { sa += (va[j].x * va[j].x + va[j].y * va[j].y) + (va[j].z * va[j].z + va[j].w * va[j].w); sb += (vb[j].x * vb[j].x + vb[j].y * vb[j].y) + (vb[j].z * vb[j].z + vb[j].w * vb[j].w); }
    const float rsa = rsqrtf(wave_sum(sa) * (1.f / DM) + EPS), rsb = rsqrtf(wave_sum(sb) * (1.f / DM) + EPS);
#pragma unroll
    for (int j = 0; j < 4; ++j) { const f32x4 g = ((const f32x4*)g0)[lane + 64 * j]; const f32x4 ya = va[j] * rsa * g, yb = vb[j] * rsb * g; v2u wa, wb; wa.x = pk2(ya.x, ya.y); wa.y = pk2(ya.z, ya.w); wb.x = pk2(yb.x, yb.y); wb.y = pk2(yb.z, yb.w);
        ((v2u*)oa)[lane + 64 * j] = wa; ((v2u*)ob)[lane + 64 * j] = wb; }
}
__device__ __forceinline__ int dstperm(int k) { return (k & ~31) + 8 * ((k >> 2) & 3) + 4 * ((k >> 4) & 1) + (k & 3); }
constexpr int P2_TEAM_BYTES = 80896;
typedef short bf16x4 __attribute__((ext_vector_type(4)));
__device__ __forceinline__ bf16x4 cvt4(f32x4 v) { v2u w; w.x = pk2(v[0], v[1]); w.y = pk2(v[2], v[3]); return __builtin_bit_cast(bf16x4, w); }
#define LBAR() do { asm volatile("s_waitcnt lgkmcnt(0)" ::: "memory"); __builtin_amdgcn_s_barrier(); asm volatile("" ::: "memory"); } while (0)
__device__ __forceinline__ void p2_delta_prep(LAS unsigned char* lds, int G, const bf16* __restrict__ QKV, const float* __restrict__ BA, const float* __restrict__ conv_w, const float* __restrict__ a_log,
                                              const float* __restrict__ dt_bias, bf16* __restrict__ DQG, bf16* __restrict__ DKDT, bf16* __restrict__ DW, bf16* __restrict__ DU, bf16* __restrict__ DA, float* __restrict__ GL, const int wave_s, const int lim = 4) {
    const int team = wave_s >> 2, wt = wave_s & 3;
    LAS unsigned char* tb = lds + team * P2_TEAM_BYTES;
    LAS bf16* Qs = (LAS bf16*)tb; LAS bf16* Ks = (LAS bf16*)(tb + 9216); LAS bf16* As = (LAS bf16*)(tb + 18432);
    LAS float* RHS = (LAS float*)(tb + 27648); LAS float* Lm = (LAS float*)(tb + 60416); LAS float* gc = (LAS float*)(tb + 76800); LAS float* bt = (LAS float*)(tb + 77056); LAS float* eq = (LAS float*)(tb + 77312); LAS float* ek = (LAS float*)(tb + 77568); LAS float* CW = (LAS float*)(tb + 77824);
    const int nteams = G * 2, per = (NUNIT_D + nteams - 1) / nteams, ubase = ((int)blockIdx.x * 2 + team) * per;
    v4u raw[3][5]; float ba_b = 0.f, ba_a = 0.f;
#define P2_FETCH(uid_) do { const int bh_ = (uid_) >> 6, c_ = (uid_) & 63, b_ = bh_ / 12, h_ = bh_ - 12 * b_; const size_t r0_ = (size_t)b_ * SEQ + (size_t)c_ * 64; \
        _Pragma("unroll") for (int mtx = 0; mtx < 3; ++mtx) _Pragma("unroll") for (int r = 0; r < 5; ++r) { const int s = c_ * 64 + t0 - 3 + r; \
            raw[mtx][r] = *(const v4u*)(QKV + (r0_ + (s >= 0 ? t0 - 3 + r : 0)) * 2304 + mtx * 768 + h_ * 64 + 8 * dg); }     \
        ba_b = BA[(r0_ + lane) * 32 + h_]; ba_a = BA[(r0_ + lane) * 32 + 12 + h_]; } while (0)
    int h_prev = -1; float h_nal = 0.f, h_dtb = 0.f;
    { int lane = __builtin_amdgcn_mbcnt_hi(~0u, __builtin_amdgcn_mbcnt_lo(~0u, 0u)); asm volatile("" : "+v"(lane)); const int tt = wt * 64 + lane, dg = tt & 7, t0 = (tt >> 3) * 2; if (ubase < NUNIT_D) P2_FETCH(ubase); }
    for (int it = 0; it < per; ++it) {
        int lane = __builtin_amdgcn_mbcnt_hi(~0u, __builtin_amdgcn_mbcnt_lo(~0u, 0u)); asm volatile("" : "+v"(lane));
        const int tt = wt * 64 + lane, dg = tt & 7, t0 = (tt >> 3) * 2;
        const int rt_ = tt ^ (team << 7);
        const int uid = ubase + it; const bool act = uid < NUNIT_D;
        const int bh = uid >> 6, b = bh / 12, h = bh - 12 * b;
        if (act && h != h_prev) {
            h_nal = -__expf(a_log[h]); h_dtb = dt_bias[h];
            for (int i = tt; i < 768; i += 256) { const int mtx = i >> 8, tap = (i >> 6) & 3, dd = i & 63; CW[i] = conv_w[tap * 2304 + mtx * 768 + h * 64 + dd]; }
        }
        h_prev = h;
        LBAR();
        if (act) {
            { const float beta = __builtin_amdgcn_rcpf(1.f + __expf(-ba_b)); const float xx = ba_a + h_dtb; const float sp = xx > 20.f ? xx : log1pf(__expf(xx));
              const float g0 = h_nal * sp;
#define DPPF(src, ctrl, rm, bm) __builtin_bit_cast(float, __builtin_amdgcn_update_dpp(0, __builtin_bit_cast(int, (src)), (ctrl), (rm), (bm), false))
              float g = g0 + DPPF(g0, 0x111, 0xf, 0xf); g += DPPF(g0, 0x112, 0xf, 0xf); g += DPPF(g0, 0x113, 0xf, 0xf);
              g += DPPF(g, 0x114, 0xf, 0xe); g += DPPF(g, 0x118, 0xf, 0xc); g += DPPF(g, 0x142, 0xa, 0xf); g += DPPF(g, 0x143, 0xc, 0xf);
#undef DPPF
              const float gl_ = __builtin_bit_cast(float, __builtin_amdgcn_readlane(__builtin_bit_cast(int, g), 63));
              gc[lane] = g; bt[lane] = beta; eq[lane] = __expf(g); ek[lane] = __expf(gl_ - g); }
            { const int c_now = uid & 63;
#pragma unroll
              for (int r = 0; r < 5; ++r) if (c_now * 64 + t0 - 3 + r < 0) {
#pragma unroll
                  for (int mtx = 0; mtx < 3; ++mtx) raw[mtx][r] = (v4u){0u, 0u, 0u, 0u}; } }
            float q[2][8], k[2][8], v[2][8];
#pragma unroll
            for (int mtx = 0; mtx < 3; ++mtx) {
                f32x4 cw[4][2];
#pragma unroll
                for (int tap = 0; tap < 4; ++tap) { cw[tap][0] = *(const LAS f32x4*)(CW + mtx * 256 + tap * 64 + 8 * dg); cw[tap][1] = *(const LAS f32x4*)(CW + mtx * 256 + tap * 64 + 8 * dg + 4); }
#pragma unroll
                for (int tk = 0; tk < 2; ++tk) { float o[8];
#pragma unroll
                    for (int e = 0; e < 8; ++e) o[e] = 0.f;
#pragma unroll
                    for (int tap = 0; tap < 4; ++tap) { const v4u rw = raw[mtx][tk + tap];
                        o[0] += cw[tap][0][0] * bflo(rw.x); o[1] += cw[tap][0][1] * bfhi(rw.x); o[2] += cw[tap][0][2] * bflo(rw.y); o[3] += cw[tap][0][3] * bfhi(rw.y);
                        o[4] += cw[tap][1][0] * bflo(rw.z); o[5] += cw[tap][1][1] * bfhi(rw.z); o[6] += cw[tap][1][2] * bflo(rw.w); o[7] += cw[tap][1][3] * bfhi(rw.w); }
#pragma unroll
                    for (int e = 0; e < 8; ++e) { const float y = silu_f(o[e]); if (mtx == 0) q[tk][e] = y; else if (mtx == 1) k[tk][e] = y; else v[tk][e] = y; } }
            }
#pragma unroll
            for (int tk = 0; tk < 2; ++tk) { float sq = 0.f, sk = 0.f;
#pragma unroll
                for (int e = 0; e < 8; ++e) { sq += q[tk][e] * q[tk][e]; sk += k[tk][e] * k[tk][e]; }
                sq = row8_sum(sq); sk = row8_sum(sk); const float rq = rsqrtf(sq + EPS) * 0.125f, rk = rsqrtf(sk + EPS);
#pragma unroll
                for (int e = 0; e < 8; ++e) { q[tk][e] *= rq; k[tk][e] *= rk; } }
            LDS_WAIT();
#pragma unroll
            for (int tk = 0; tk < 2; ++tk) { const int t = t0 + tk; const float beta = bt[t], eg = eq[t] * beta;
                v4u w; w.x = pk2(q[tk][0], q[tk][1]); w.y = pk2(q[tk][2], q[tk][3]); w.z = pk2(q[tk][4], q[tk][5]); w.w = pk2(q[tk][6], q[tk][7]); *(LAS v4u*)(Qs + t * 72 + 8 * dg) = w;
                w.x = pk2(k[tk][0], k[tk][1]); w.y = pk2(k[tk][2], k[tk][3]); w.z = pk2(k[tk][4], k[tk][5]); w.w = pk2(k[tk][6], k[tk][7]); *(LAS v4u*)(Ks + t * 72 + 8 * dg) = w;
                *(LAS f32x4*)(RHS + t * 128 + 8 * dg) = (f32x4){v[tk][0] * beta, v[tk][1] * beta, v[tk][2] * beta, v[tk][3] * beta};
                *(LAS f32x4*)(RHS + t * 128 + 8 * dg + 4) = (f32x4){v[tk][4] * beta, v[tk][5] * beta, v[tk][6] * beta, v[tk][7] * beta};
                *(LAS f32x4*)(RHS + t * 128 + 64 + 8 * dg) = (f32x4){k[tk][0] * eg, k[tk][1] * eg, k[tk][2] * eg, k[tk][3] * eg};
                *(LAS f32x4*)(RHS + t * 128 + 64 + 8 * dg + 4) = (f32x4){k[tk][4] * eg, k[tk][5] * eg, k[tk][6] * eg, k[tk][7] * eg}; }
        }
        LBAR();
        if (it + 1 < per && uid + 1 < NUNIT_D) P2_FETCH(uid + 1);
        const int l15 = lane & 15, lq = lane >> 4;
        if (act && lim >= 2) {
            bf16x8 ka[2], qa[2];
#pragma unroll
            for (int ks = 0; ks < 2; ++ks) { ka[ks] = *(const LAS bf16x8*)(Ks + (16 * wt + l15) * 72 + 32 * ks + 8 * lq); qa[ks] = *(const LAS bf16x8*)(Qs + (16 * wt + l15) * 72 + 32 * ks + 8 * lq); }
            float gi[4], bi[4];
#pragma unroll
            for (int r = 0; r < 4; ++r) { gi[r] = gc[16 * wt + 4 * lq + r]; bi[r] = bt[16 * wt + 4 * lq + r]; }
#pragma unroll
            for (int ct = 0; ct < 4; ++ct) {
                const bf16x8 kb0 = *(const LAS bf16x8*)(Ks + (16 * ct + l15) * 72 + 8 * lq), kb1 = *(const LAS bf16x8*)(Ks + (16 * ct + l15) * 72 + 32 + 8 * lq);
                f32x4 kk = {0.f, 0.f, 0.f, 0.f}, qk = {0.f, 0.f, 0.f, 0.f};
                kk = __builtin_amdgcn_mfma_f32_16x16x32_bf16(ka[0], kb0, kk, 0, 0, 0); kk = __builtin_amdgcn_mfma_f32_16x16x32_bf16(ka[1], kb1, kk, 0, 0, 0);
                qk = __builtin_amdgcn_mfma_f32_16x16x32_bf16(qa[0], kb0, qk, 0, 0, 0); qk = __builtin_amdgcn_mfma_f32_16x16x32_bf16(qa[1], kb1, qk, 0, 0, 0);
                const int j = 16 * ct + l15; const float gj = gc[j];
#pragma unroll
                for (int r = 0; r < 4; ++r) { const int i = 16 * wt + 4 * lq + r; const float dec = (j <= i) ? __expf(gi[r] - gj) : 0.f;
                    Lm[i * 64 + j] = (j < i) ? bi[r] * kk[r] * dec : 0.f;
                    As[i * 72 + j] = (bf16)(pk2(qk[r] * dec, 0.f) & 0xffffu); }
            }
        }
        LBAR();
        if (act && lim >= 3) {
            if (rt_ < 64) {
                const int bb = rt_ >> 4, cc = rt_ & 15; const LAS float* Lb = Lm + (16 * bb) * 64 + 16 * bb; float t[16]; f32x4 lv[15][4];
#pragma unroll
                for (int r = 1; r < 16; ++r)
#pragma unroll
                    for (int j4 = 0; j4 < (r + 3) / 4; ++j4) lv[r - 1][j4] = *(const LAS f32x4*)(Lb + r * 64 + 4 * j4);
                __builtin_amdgcn_sched_barrier(0);
#pragma unroll
                for (int r = 0; r < 16; ++r) { float a = (r == cc) ? 1.f : 0.f;
#pragma unroll
                    for (int j4 = 0; j4 < (r + 3) / 4; ++j4) { const f32x4 l = lv[r > 0 ? r - 1 : 0][j4];
#pragma unroll
                        for (int e = 0; e < 4; ++e) if (4 * j4 + e < r) a -= l[e] * t[4 * j4 + e]; }
                    t[r] = a; }
                LDS_WAIT(); asm volatile("" ::: "memory");
#pragma unroll
                for (int r = 0; r < 16; ++r) ((LAS float*)Lb)[r * 64 + cc] = t[r];
            } else if (rt_ >= 128) {
                const int t2 = rt_ - 128, rrow = t2 >> 1, half = t2 & 1;
                { const float eg = eq[rrow]; v4u in[4], ou[4];
#pragma unroll
                  for (int i = 0; i < 4; ++i) in[i] = *(const LAS v4u*)(Qs + rrow * 72 + 32 * half + 8 * i);
                  unsigned g4[16];
#pragma unroll
                  for (int kk4 = 0; kk4 < 8; ++kk4) { const unsigned a0 = in[kk4 >> 1][(kk4 & 1) * 2], a1 = in[kk4 >> 1][(kk4 & 1) * 2 + 1]; const int p4 = 2 * (kk4 & 3) + (kk4 >> 2);
                      g4[2 * p4] = pk2(bflo(a0) * eg, bfhi(a0) * eg); g4[2 * p4 + 1] = pk2(bflo(a1) * eg, bfhi(a1) * eg); }
#pragma unroll
                  for (int i = 0; i < 4; ++i) { ou[i] = (v4u){g4[4 * i], g4[4 * i + 1], g4[4 * i + 2], g4[4 * i + 3]}; *(v4u*)(DQG + (size_t)uid * 4096 + rrow * 64 + 32 * half + 8 * i) = ou[i]; } }
                { v4u in[4], ou[4];
#pragma unroll
                  for (int i = 0; i < 4; ++i) in[i] = *(const LAS v4u*)(As + rrow * 72 + 32 * half + 8 * i);
                  unsigned g4[16];
#pragma unroll
                  for (int kk4 = 0; kk4 < 8; ++kk4) { const int p4 = 2 * (kk4 & 3) + (kk4 >> 2); g4[2 * p4] = in[kk4 >> 1][(kk4 & 1) * 2]; g4[2 * p4 + 1] = in[kk4 >> 1][(kk4 & 1) * 2 + 1]; }
#pragma unroll
                  for (int i = 0; i < 4; ++i) { ou[i] = (v4u){g4[4 * i], g4[4 * i + 1], g4[4 * i + 2], g4[4 * i + 3]}; *(v4u*)(DA + (size_t)uid * 4096 + rrow * 64 + 32 * half + 8 * i) = ou[i]; } }
                {
                  unsigned g4[16]; bf16 kv_[32]; f32x4 ev_[8];
#pragma unroll
                  for (int i = 0; i < 32; ++i) kv_[i] = Ks[(32 * half + i) * 72 + rrow];
#pragma unroll
                  for (int i = 0; i < 8; ++i) ev_[i] = *(const LAS f32x4*)(ek + 32 * half + 4 * i);
                  __builtin_amdgcn_sched_barrier(0);
#pragma unroll
                  for (int kk4 = 0; kk4 < 8; ++kk4) { const int p4 = 2 * (kk4 & 3) + (kk4 >> 2); float f[4];
#pragma unroll
                      for (int e = 0; e < 4; ++e) f[e] = bf1(kv_[4 * kk4 + e]) * ev_[kk4][e];
                      g4[2 * p4] = pk2(f[0], f[1]); g4[2 * p4 + 1] = pk2(f[2], f[3]); }
#pragma unroll
                  for (int i = 0; i < 4; ++i) *(v4u*)(DKDT + (size_t)uid * 4096 + rrow * 64 + 32 * half + 8 * i) = (v4u){g4[4 * i], g4[4 * i + 1], g4[4 * i + 2], g4[4 * i + 3]}; }
                if (t2 == 0) GL[uid] = eq[63];
            }
        }
        LBAR();
        if (act && lim >= 4) {
            f32x4 X[2][4]; bf16x4 xb[2][4]; f32x4 racc[4][2], lfr[4][4];
#pragma unroll
            for (int bb = 0; bb < 4; ++bb) {
#pragma unroll
                for (int c2 = 0; c2 < 2; ++c2)
#pragma unroll
                    for (int r = 0; r < 4; ++r) racc[bb][c2][r] = RHS[(16 * bb + 4 * lq + r) * 128 + 32 * wt + 16 * c2 + l15];
#pragma unroll
                for (int j = 0; j < 4; ++j) if (j <= bb) lfr[bb][j] = *(const LAS f32x4*)(Lm + (16 * bb + l15) * 64 + 16 * j + 4 * lq); }
            __builtin_amdgcn_sched_barrier(0);
#pragma unroll
            for (int bb = 0; bb < 4; ++bb) {
                f32x4 acc[2]; acc[0] = racc[bb][0]; acc[1] = racc[bb][1];
#pragma unroll
                for (int j = 0; j < 4; ++j) if (j < bb) { const f32x4 lv = lfr[bb][j]; const bf16x4 la = cvt4(-lv);
#pragma unroll
                    for (int c2 = 0; c2 < 2; ++c2) acc[c2] = __builtin_amdgcn_mfma_f32_16x16x16bf16_1k(la, xb[c2][j], acc[c2], 0, 0, 0); }
                const f32x4 tv = lfr[bb][bb]; const bf16x4 ta = cvt4(tv);
#pragma unroll
                for (int c2 = 0; c2 < 2; ++c2) { const bf16x4 yb = cvt4(acc[c2]); X[c2][bb] = __builtin_amdgcn_mfma_f32_16x16x16bf16_1k(ta, yb, (f32x4){0.f, 0.f, 0.f, 0.f}, 0, 0, 0); xb[c2][bb] = cvt4(X[c2][bb]); }
            }
            if (wt < 2) {
#pragma unroll
                for (int c2 = 0; c2 < 2; ++c2) { bf16* up = DU + (size_t)uid * 4096 + ((2 * wt + c2) * 64 + lane) * 16; v4u w0, w1;
                    w0.x = pk2(X[c2][0][0], X[c2][0][1]); w0.y = pk2(X[c2][0][2], X[c2][0][3]); w0.z = pk2(X[c2][1][0], X[c2][1][1]); w0.w = pk2(X[c2][1][2], X[c2][1][3]);
                    w1.x = pk2(X[c2][2][0], X[c2][2][1]); w1.y = pk2(X[c2][2][2], X[c2][2][3]); w1.z = pk2(X[c2][3][0], X[c2][3][1]); w1.w = pk2(X[c2][3][2], X[c2][3][3]);
                    *(v4u*)up = w0; *(v4u*)(up + 8) = w1; }
            } else {
#pragma unroll
                for (int c2 = 0; c2 < 2; ++c2) { bf16* wp = DW + (size_t)uid * 4096 + dstperm(32 * (wt - 2) + 16 * c2 + l15);
#pragma unroll
                    for (int bb = 0; bb < 4; ++bb)
#pragma unroll
                        for (int r = 0; r < 4; ++r) wp[(16 * bb + 4 * lq + r) * 64] = (bf16)(pk2(X[c2][bb][r], 0.f) & 0xffffu); }
            }
        }
    }
    LBAR();
#undef P2_FETCH
}

constexpr int SC_W = 0, SC_QG = 9216, SC_A = 18432, SC_KDT = 27648, SC_U = 36864, SC_STAGE = 45056, SC_O = 2 * SC_STAGE, SC_OSTRIDE = 68, SC_OBYTES = 64 * SC_OSTRIDE * 4;
__device__ __forceinline__ void p3_scan(LAS unsigned char* lds, int sq, const bf16* __restrict__ DQG, const bf16* __restrict__ DKDT, const bf16* __restrict__ DW, const bf16* __restrict__ DU, const bf16* __restrict__ DA,
                                        const float* __restrict__ GL, bf16* Z, const float* __restrict__ o_norm, const int wave_s, const bool dostore = true) {
    int lane_ = __builtin_amdgcn_mbcnt_hi(~0u, __builtin_amdgcn_mbcnt_lo(~0u, 0u)); asm volatile("" : "+v"(lane_)); const int tid = wave_s * 64 + lane_; const int wid = wave_s, lane = lane_, l15 = lane & 15, lq = lane >> 4;
    const int b = sq / 12, h = sq - 12 * b; const size_t uid0 = (size_t)sq * 64; const size_t row0 = (size_t)b * SEQ;
    const int ht = tid - 256;
#define SC_LOAD(n) do { const size_t ub = (uid0 + (n)) * 8192; \
        _Pragma("unroll") for (int i = 0; i < 2; ++i) { const int p = ht + 256 * i; \
            st[0][i] = *(const v4u*)((const char*)DW + ub + p * 16); st[1][i] = *(const v4u*)((const char*)DQG + ub + p * 16); st[2][i] = *(const v4u*)((const char*)DA + ub + p * 16); \
            st[3][i] = *(const v4u*)((const char*)DKDT + ub + p * 16); st[4][i] = *(const v4u*)((const char*)DU + ub + p * 16); } } while (0)
#define SC_STORE(s) do { LAS unsigned char* sb_ = lds + (s) * SC_STAGE; \
        _Pragma("unroll") for (int i = 0; i < 2; ++i) { const int p = ht + 256 * i; const int ro = (p >> 3) * 144 + (p & 7) * 16; \
            *(LAS v4u*)(sb_ + SC_W + ro) = st[0][i]; *(LAS v4u*)(sb_ + SC_QG + ro) = st[1][i]; *(LAS v4u*)(sb_ + SC_A + ro) = st[2][i]; *(LAS v4u*)(sb_ + SC_KDT + ro) = st[3][i]; \
            *(LAS v4u*)(sb_ + SC_U + p * 16) = st[4][i]; } } while (0)
#define SC_EPI(n) do { const int row_ = ht >> 2, sg_ = ht & 3; bf16* zp_ = Z + (row0 + (size_t)(n) * 64 + row_) * 1024 + h * 64 + sg_ * 16; \
        const v4u z0_ = *(const v4u*)zp_, z1_ = *(const v4u*)(zp_ + 8); const LAS float* op_ = (const LAS float*)(lds + SC_O + ((n) & 1) * SC_OBYTES) + row_ * SC_OSTRIDE + sg_ * 16; \
        f32x4 o_[4]; float ss_ = 0.f; \
        _Pragma("unroll") for (int i = 0; i < 4; ++i) { o_[i] = *(const LAS f32x4*)(op_ + 4 * i); ss_ += (o_[i][0] * o_[i][0] + o_[i][1] * o_[i][1]) + (o_[i][2] * o_[i][2] + o_[i][3] * o_[i][3]); } \
        ss_ = DPP_ADD(ss_, 0xB1); ss_ = DPP_ADD(ss_, 0x4E); const float rstd_ = rsqrtf(ss_ * (1.f / 64.f) + EPS); \
        v4u y0_, y1_; \
        _Pragma("unroll") for (int i = 0; i < 4; ++i) { const unsigned zz_ = (i < 2) ? z0_[2 * i] : z1_[2 * (i - 2)], zw_ = (i < 2) ? z0_[2 * i + 1] : z1_[2 * (i - 2) + 1]; \
            const unsigned a_ = pk2(o_[i][0] * rstd_ * onv[4 * i] * silu_f(bflo(zz_)), o_[i][1] * rstd_ * onv[4 * i + 1] * silu_f(bfhi(zz_))); \
            const unsigned b_ = pk2(o_[i][2] * rstd_ * onv[4 * i + 2] * silu_f(bflo(zw_)), o_[i][3] * rstd_ * onv[4 * i + 3] * silu_f(bfhi(zw_))); \
            if (i < 2) { y0_[2 * i] = a_; y0_[2 * i + 1] = b_; } else { y1_[2 * (i - 2)] = a_; y1_[2 * (i - 2) + 1] = b_; } } \
        if (dostore) { *(v4u*)zp_ = y0_; *(v4u*)(zp_ + 8) = y1_; } } while (0)
    v4u st[5][2]; float onv[16];
    if (wid >= 4) { SC_LOAD(0); SC_STORE(0); SC_LOAD(1);
#pragma unroll
        for (int i = 0; i < 16; ++i) onv[i] = o_norm[(ht & 3) * 16 + i]; }
    LBAR();
    f32x4 S[4];
#pragma unroll
    for (int i = 0; i < 4; ++i) S[i] = (f32x4){0.f, 0.f, 0.f, 0.f};
    float gl_next = GL[uid0];
    for (int n = 0; n < 64; ++n) {
        if (wid >= 4) {
            if (n + 1 < 64) { SC_STORE((n + 1) & 1); if (n + 2 < 64) SC_LOAD(n + 2); }
            if (n > 0) SC_EPI(n - 1);
        } else {
            const LAS unsigned char* sb = lds + (n & 1) * SC_STAGE; const int fo = l15 * 144 + lq * 16;
            const float gl = gl_next; gl_next = GL[uid0 + (n + 1 < 64 ? n + 1 : n)];
            bf16x8 sbv[2], vb[2];
#pragma unroll
            for (int ks = 0; ks < 2; ++ks) { v4u w; w.x = pk2(S[2 * ks][0], S[2 * ks][1]); w.y = pk2(S[2 * ks][2], S[2 * ks][3]); w.z = pk2(S[2 * ks + 1][0], S[2 * ks + 1][1]); w.w = pk2(S[2 * ks + 1][2], S[2 * ks + 1][3]); sbv[ks] = __builtin_bit_cast(bf16x8, w); }
            f32x4 vn[4];
#pragma unroll
            for (int rt = 0; rt < 4; ++rt) { f32x4 a = {0.f, 0.f, 0.f, 0.f};
#pragma unroll
                for (int ks = 0; ks < 2; ++ks) a = __builtin_amdgcn_mfma_f32_16x16x32_bf16(*(const LAS bf16x8*)(sb + SC_W + rt * 2304 + ks * 64 + fo), sbv[ks], a, 0, 0, 0);
                const v2u uu = *(const LAS v2u*)(sb + SC_U + ((wid * 64 + lane) * 16 + rt * 4) * 2);
                vn[rt] = (f32x4){bflo(uu.x), bfhi(uu.x), bflo(uu.y), bfhi(uu.y)} - a; }
#pragma unroll
            for (int ks = 0; ks < 2; ++ks) { v4u w; w.x = pk2(vn[2 * ks][0], vn[2 * ks][1]); w.y = pk2(vn[2 * ks][2], vn[2 * ks][3]); w.z = pk2(vn[2 * ks + 1][0], vn[2 * ks + 1][1]); w.w = pk2(vn[2 * ks + 1][2], vn[2 * ks + 1][3]); vb[ks] = __builtin_bit_cast(bf16x8, w); }
            LAS float* ob = (LAS float*)(lds + SC_O + (n & 1) * SC_OBYTES) + 16 * wid + l15;
#pragma unroll
            for (int rt = 0; rt < 4; ++rt) { f32x4 a = {0.f, 0.f, 0.f, 0.f};
#pragma unroll
                for (int ks = 0; ks < 2; ++ks) { a = __builtin_amdgcn_mfma_f32_16x16x32_bf16(*(const LAS bf16x8*)(sb + SC_QG + rt * 2304 + ks * 64 + fo), sbv[ks], a, 0, 0, 0);
                    a = __builtin_amdgcn_mfma_f32_16x16x32_bf16(*(const LAS bf16x8*)(sb + SC_A + rt * 2304 + ks * 64 + fo), vb[ks], a, 0, 0, 0); }
#pragma unroll
                for (int r = 0; r < 4; ++r) ob[(16 * rt + 4 * lq + r) * SC_OSTRIDE] = a[r]; }
#pragma unroll
            for (int dt = 0; dt < 4; ++dt) { f32x4 a = S[dt] * gl;
#pragma unroll
                for (int ks = 0; ks < 2; ++ks) a = __builtin_amdgcn_mfma_f32_16x16x32_bf16(*(const LAS bf16x8*)(sb + SC_KDT + dt * 2304 + ks * 64 + fo), vb[ks], a, 0, 0, 0);
                S[dt] = a; }
        }
        LBAR();
    }
    if (wid >= 4) SC_EPI(63);
    LBAR();
#undef SC_LOAD
#undef SC_STORE
#undef SC_EPI
}
constexpr int PTR_OFF = 161792;
#define GAS __attribute__((address_space(1)))
__device__ __forceinline__ GAS void* ldp(LAS unsigned char* lds, int k) {
    asm volatile("" ::: "memory");
    const LAS unsigned* t = (const LAS unsigned*)(lds + PTR_OFF) + 2 * k; unsigned lo = t[0], hi = t[1];
    lo = __builtin_amdgcn_readfirstlane(lo); hi = __builtin_amdgcn_readfirstlane(hi);
    return (GAS void*)(((unsigned long long)hi << 32) | lo);
}
#define x_ ((const float*)(GAS const float*)ldp(lds, 0))
#define mem_ ((const float*)(GAS const float*)ldp(lds, 1))
#define positions_ ((const int*)(GAS const int*)ldp(lds, 2))
#define norm_0_ ((const float*)(GAS const float*)ldp(lds, 3))
#define w_in_0_ ((const float*)(GAS const float*)ldp(lds, 4))
#define conv_w_ ((const float*)(GAS const float*)ldp(lds, 5))
#define a_log_ ((const float*)(GAS const float*)ldp(lds, 6))
#define dt_bias_ ((const float*)(GAS const float*)ldp(lds, 7))
#define o_norm_ ((const float*)(GAS const float*)ldp(lds, 8))
#define mem_norm_0_ ((const float*)(GAS const float*)ldp(lds, 9))
#define w_mkv_0_ ((const float*)(GAS const float*)ldp(lds, 10))
#define w_out_0_ ((const float*)(GAS const float*)ldp(lds, 11))
#define norm_1_ ((const float*)(GAS const float*)ldp(lds, 12))
#define w_in_1_ ((const float*)(GAS const float*)ldp(lds, 13))
#define mem_norm_1_ ((const float*)(GAS const float*)ldp(lds, 14))
#define w_mkv_1_ ((const float*)(GAS const float*)ldp(lds, 15))
#define w_out_1_ ((const float*)(GAS const float*)ldp(lds, 16))
#define final_norm_ ((const float*)(GAS const float*)ldp(lds, 17))
#define out_ ((float*)(GAS float*)ldp(lds, 18))
#define KSUM_ ((float*)(GAS float*)((GAS unsigned char*)ldp(lds, 19) + WS_KSUM))
#define GL_ ((float*)(GAS float*)((GAS unsigned char*)ldp(lds, 19) + WS_GL))
#define WCAT0_ ((bf16*)(GAS bf16*)((GAS unsigned char*)ldp(lds, 19) + WS_WCAT0))
#define WOUT0_ ((bf16*)(GAS bf16*)((GAS unsigned char*)ldp(lds, 19) + WS_WOUT0))
#define WIN1_ ((bf16*)(GAS bf16*)((GAS unsigned char*)ldp(lds, 19) + WS_WIN1))
#define WOUT1_ ((bf16*)(GAS bf16*)((GAS unsigned char*)ldp(lds, 19) + WS_WOUT1))
#define RT_ ((float*)(GAS float*)((GAS unsigned char*)ldp(lds, 19) + WS_ROPE))
#define ACAT_ ((bf16*)(GAS bf16*)((GAS unsigned char*)ldp(lds, 19) + WS_ACAT))
#define MKV_ ((bf16*)(GAS bf16*)((GAS unsigned char*)ldp(lds, 19) + WS_MKV))
#define QKV_ ((bf16*)(GAS bf16*)((GAS unsigned char*)ldp(lds, 19) + WS_QKV))
#define Zb_ ((bf16*)(GAS bf16*)((GAS unsigned char*)ldp(lds, 19) + WS_Z))
#define MQ_ ((bf16*)(GAS bf16*)((GAS unsigned char*)ldp(lds, 19) + WS_MQ))
#define BA_ ((float*)(GAS float*)((GAS unsigned char*)ldp(lds, 19) + WS_BA))
#define PS_ ((float*)(GAS float*)((GAS unsigned char*)ldp(lds, 19) + WS_PS))
#define DW_ ((bf16*)(GAS bf16*)((GAS unsigned char*)ldp(lds, 19) + WS_DW))
#define DU_ ((bf16*)(GAS bf16*)((GAS unsigned char*)ldp(lds, 19) + WS_DU))
#define DA_ ((bf16*)(GAS bf16*)((GAS unsigned char*)ldp(lds, 19) + WS_DA))
#define DQG_ ((bf16*)(GAS bf16*)ldp(lds, 18))
#define DKDT_ ((bf16*)((GAS bf16*)ldp(lds, 18) + (size_t)NUNIT_D * 4096))
#define Q1_ (QKV_)
#define K1_ (QKV_ + (size_t)M * 768)
#define V1_ (QKV_ + (size_t)2 * M * 768)
__device__ __forceinline__ void mem_attn_unit(int u, int layer, LAS unsigned char* lds, char* shm, const int wave_s) {
    const int qb = u & 15, hm = (u >> 4) & 3, b = u >> 6; const size_t r0 = (size_t)b * SEQ + (size_t)qb * 256;
    GAS unsigned char* ws_ = (GAS unsigned char*)ldp(lds, 19);
    const attn_body::bf16* Kh = (const attn_body::bf16*)(GAS attn_body::bf16*)(ws_ + WS_MKV) + (size_t)layer * MROWS * 512 + (size_t)b * NMEM * 512 + hm * 64;
    attn_body::attn_unit<8, 0, 256, 512, 1024>(4, (const attn_body::bf16*)(GAS attn_body::bf16*)(ws_ + WS_MQ) + r0 * 256 + hm * 64, Kh, Kh + 256,
                               (attn_body::bf16*)(GAS attn_body::bf16*)(ws_ + WS_Z) + r0 * 1024 + 768 + hm * 64, nullptr, 0, shm, wave_s);
}
__device__ __forceinline__ void moba_attn_unit(int bh, int qb, LAS unsigned char* lds, char* shm, const int wave_s, const bool dry = false) {
    const int b = bh / 12, h = bh - 12 * b; const size_t r0 = (size_t)b * SEQ + (size_t)qb * 256;
    GAS unsigned char* ws_ = (GAS unsigned char*)ldp(lds, 19);
    const attn_body::bf16* qkv_ = (const attn_body::bf16*)(GAS attn_body::bf16*)(ws_ + WS_QKV);
    attn_body::attn_unit<8, 1, 768, 768, 1024>(4 * (qb + 1), qkv_ + r0 * 768 + h * 64, qkv_ + (size_t)M * 768 + (size_t)b * SEQ * 768 + h * 64, qkv_ + (size_t)2 * M * 768 + (size_t)b * SEQ * 768 + h * 64,
                               (attn_body::bf16*)(GAS attn_body::bf16*)(ws_ + WS_Z) + r0 * 1024 + h * 64, (const float*)(GAS float*)(ws_ + WS_KSUM) + (size_t)b * 16 * 768 + h * 64, qb, shm, wave_s, dry,
                               (const float*)(GAS float*)(ws_ + WS_ROPE) + r0 * 64);
}
#define XB_TMO      128
#define XB_XCNT(j)  (256  + 64 * (j))
#define XB_XSUB(j)  (1280 + 64 * (j))
#define XB_XGEN(j)  (2304 + 64 * (j))
#define XB_TOP      3328
#define XB_TOPGEN   3392
#define XCD_BAR_WORDS 3456
#define XB_SPIN_CAP (1u << 18)

__device__ __forceinline__ unsigned xb_ld(unsigned* p)              { return __hip_atomic_load(p, __ATOMIC_RELAXED, __HIP_MEMORY_SCOPE_AGENT); }
__device__ __forceinline__ unsigned xb_add(unsigned* p, unsigned v) { return __hip_atomic_fetch_add(p, v, __ATOMIC_RELAXED, __HIP_MEMORY_SCOPE_AGENT); }
__device__ __forceinline__ unsigned xb_xcc_id() { return (unsigned)__builtin_amdgcn_s_getreg((3 << 11) | 20) & 0xFu; }
#define XB_SPIN(cond, bar) do { unsigned _sp = 0; while (cond) { __builtin_amdgcn_s_sleep(1); \
    if ((++_sp & 255u) == 0u) { if (xb_ld(&(bar)[XB_TMO])) break; if (_sp > XB_SPIN_CAP) { atomicAdd(&(bar)[XB_TMO], 1u); break; } } } } while (0)

struct XcdBarrier {
    unsigned* bar; unsigned x;
    volatile LAS unsigned* st;
};

__device__ __forceinline__ XcdBarrier xcd_barrier_post(unsigned* bar, volatile LAS unsigned* st) {
    XcdBarrier b; b.bar = bar; b.x = xb_xcc_id(); b.st = st;
    if (threadIdx.x == 0) (void)xb_add(&bar[XB_XCNT(b.x)], 1u);
    return b;
}
__device__ __forceinline__ void xcd_barrier_complete(unsigned* bar, unsigned x, unsigned& nloc, unsigned& nx) {
    const unsigned G = gridDim.x * gridDim.y * gridDim.z;
    unsigned sum, cnt, mine, sp = 0u;
    for (;;) {
        sum = 0u; cnt = 0u; mine = 0u;
#pragma unroll
        for (unsigned j = 0; j < 16; ++j) { const unsigned c = xb_ld(&bar[XB_XCNT(j)]); sum += c; cnt += (c > 0u) ? 1u : 0u; mine = (j == x) ? c : mine; }
        if (sum == G) break;
        __builtin_amdgcn_s_sleep(1);
        if ((++sp & 255u) == 0u) { if (xb_ld(&bar[XB_TMO])) break; if (sp > XB_SPIN_CAP) { atomicAdd(&bar[XB_TMO], 1u); break; } }
    }
    nloc = mine > 0u ? mine : 1u; nx = cnt > 0u ? cnt : 1u;
}

__device__ __forceinline__ void xcd_barrier(const XcdBarrier& b) {
    asm volatile("s_waitcnt vmcnt(0)" ::: "memory");
    __syncthreads();
    if (threadIdx.x == 0) {
        unsigned* bar = b.bar;
        __builtin_amdgcn_s_waitcnt(0);
        unsigned nloc = b.st[0], nx = b.st[1];
        if (nloc == 0u) { xcd_barrier_complete(bar, b.x, nloc, nx); b.st[0] = nloc; b.st[1] = nx; }
        const unsigned old = xb_add(&bar[XB_XSUB(b.x)], 1u);
        const unsigned gen = old / nloc;
        if (old + 1u == (gen + 1u) * nloc) {
            __builtin_amdgcn_fence(__ATOMIC_RELEASE, "agent");
            asm volatile("s_waitcnt vmcnt(0)" ::: "memory");
            const unsigned og = xb_add(&bar[XB_TOP], 1u);
            const unsigned tg = og / nx;
            if (og + 1u == (tg + 1u) * nx) xb_add(&bar[XB_TOPGEN], 1u);
            else XB_SPIN(xb_ld(&bar[XB_TOPGEN]) == tg, bar);
            __builtin_amdgcn_fence(__ATOMIC_ACQUIRE, "agent");
            xb_add(&bar[XB_XGEN(b.x)], 1u);
            asm volatile("s_waitcnt vmcnt(0)" ::: "memory");
        } else {
            XB_SPIN(xb_ld(&bar[XB_XGEN(b.x)]) == gen, bar);
            __builtin_amdgcn_fence(__ATOMIC_ACQUIRE, "agent");
            asm volatile("s_waitcnt vmcnt(0)" ::: "memory");
        }
    }
    __syncthreads();
}

constexpr size_t WS_BAR = 1 * MiB;
struct Args { const float* in[18]; float* out; unsigned char* ws; };
__global__ void __launch_bounds__(NTHREADS, 2) hybrid_fwd(Args args) {
    extern __shared__ __attribute__((aligned(16))) unsigned char lds_raw[];
    cg::grid_group grid = cg::this_grid();
    LAS unsigned char* lds = (LAS unsigned char*)lds_raw;
    const int G = gridDim.x, bid = blockIdx.x;
    const int wave_s = __builtin_amdgcn_readfirstlane((int)threadIdx.x >> 6);
    if (threadIdx.x < 20) { const unsigned long long pv = threadIdx.x < 18 ? (unsigned long long)args.in[threadIdx.x < 18 ? threadIdx.x : 0] : (threadIdx.x == 18 ? (unsigned long long)args.out : (unsigned long long)args.ws);
        ((LAS unsigned long long*)(lds + PTR_OFF))[threadIdx.x] = pv; }
    if (threadIdx.x == 32) { ((LAS unsigned*)(lds + PTR_OFF + 192))[0] = 0u; ((LAS unsigned*)(lds + PTR_OFF + 192))[1] = 0u; }
    __syncthreads();
    const XcdBarrier xbar = xcd_barrier_post((unsigned*)(args.ws + WS_BAR), (volatile LAS unsigned*)(lds + PTR_OFF + 192));
    const int vcu = (G % 8 == 0) ? (bid % 8) * (G / 8) + bid / 8 : bid;
    const int NGW = G * 8;
#define FRESH_IDS() int lane = __builtin_amdgcn_mbcnt_hi(~0u, __builtin_amdgcn_mbcnt_lo(~0u, 0u)); asm volatile("" : "+v"(lane)); const int wave = wave_s, tid = wave_s * 64 + lane; (void)tid; const int gw = vcu * 8 + wave; (void)lane; (void)gw

#ifndef SKIP_P0
    {
        FRESH_IDS();
        LAS float* scr = (LAS float*)(lds + wave * 16384);
        constexpr int I_IN0 = 16 * 113, I_MKV = 16 * 16, I_OUT = 16 * 32, I_IN1 = 16 * 112;
        constexpr int NITEMS = I_IN0 + 2 * I_MKV + 2 * I_OUT + I_IN1;
        for (int it = gw; it < NITEMS; it += NGW) {
            int r = it;
            if (r < I_IN0) { p0_transpose_item(w_in_0_, DM, N_IN0, 113, WCAT0_, 0, false, scr, r, lane); continue; } r -= I_IN0;
            if (r < I_MKV) { p0_transpose_item(w_mkv_0_, DM, 512, 16, WCAT0_, N_IN0P, false, scr, r, lane); continue; } r -= I_MKV;
            if (r < I_MKV) { p0_transpose_item(w_mkv_1_, DM, 512, 16, WCAT0_, N_IN0P + 512, false, scr, r, lane); continue; } r -= I_MKV;
            if (r < I_OUT) { p0_transpose_item(w_out_0_, DM, DM, 32, WOUT0_, 0, false, scr, r, lane); continue; } r -= I_OUT;
            if (r < I_OUT) { p0_transpose_item(w_out_1_, DM, DM, 32, WOUT1_, 0, false, scr, r, lane); continue; } r -= I_OUT;
            p0_transpose_item(w_in_1_, DM, N_IN1, 112, WIN1_, 0, true, scr, r, lane);
        }
        { const size_t z0 = (size_t)3616 * DM * 2, z1 = (size_t)N_IN0P * DM * 2;
          for (size_t p = z0 + ((size_t)bid * NTHREADS + tid) * 16; p < z1; p += (size_t)G * NTHREADS * 16) *(v4u*)((unsigned char*)WCAT0_ + p) = (v4u){0u, 0u, 0u, 0u}; }
        for (int i = bid * NTHREADS + tid; i < BATCH * 16 * 768; i += G * NTHREADS) KSUM_[i] = 0.f;
        { int m = gw; for (; m + NGW < M; m += 2 * NGW) rms_row2_to_bf16(x_ + (size_t)m * DM, x_ + (size_t)(m + NGW) * DM, norm_0_, ACAT_ + (size_t)m * DM, ACAT_ + (size_t)(m + NGW) * DM, lane);
          if (m < M) rms_row_to_bf16(x_ + (size_t)m * DM, norm_0_, ACAT_ + (size_t)m * DM, nullptr, nullptr, lane); }
        for (int m = gw; m < MROWS; m += NGW) rms_row_to_bf16(mem_ + (size_t)m * DM, mem_norm_0_, ACAT_ + (size_t)(M + m) * DM, mem_norm_1_, ACAT_ + (size_t)(M + MROWS + m) * DM, lane);
        for (int i = bid * NTHREADS + tid; i < M * 32; i += G * NTHREADS) { const int row = i >> 5, f = i & 31;
            const double ang = (double)positions_[row] * (double)ROPE_INVF[f]; double rv = ang * 0.15915494309189535; rv -= __builtin_rint(rv); const float rf = (float)rv;
            RT_[2 * (size_t)i] = __builtin_amdgcn_cosf(rf); RT_[2 * (size_t)i + 1] = __builtin_amdgcn_sinf(rf); }
    }
#ifdef DUP_P0
    grid.sync();
    {
        FRESH_IDS();
        LAS float* scr = (LAS float*)(lds + wave * 16384);
        constexpr int I_IN0 = 16 * 113, I_MKV = 16 * 16, I_OUT = 16 * 32, I_IN1 = 16 * 112;
        constexpr int NITEMS = I_IN0 + 2 * I_MKV + 2 * I_OUT + I_IN1;
        for (int it = gw; it < NITEMS; it += NGW) {
            int r = it;
            if (r < I_IN0) { p0_transpose_item(w_in_0_, DM, N_IN0, 113, WCAT0_, 0, false, scr, r, lane); continue; } r -= I_IN0;
            if (r < I_MKV) { p0_transpose_item(w_mkv_0_, DM, 512, 16, WCAT0_, N_IN0P, false, scr, r, lane); continue; } r -= I_MKV;
            if (r < I_MKV) { p0_transpose_item(w_mkv_1_, DM, 512, 16, WCAT0_, N_IN0P + 512, false, scr, r, lane); continue; } r -= I_MKV;
            if (r < I_OUT) { p0_transpose_item(w_out_0_, DM, DM, 32, WOUT0_, 0, false, scr, r, lane); continue; } r -= I_OUT;
            if (r < I_OUT) { p0_transpose_item(w_out_1_, DM, DM, 32, WOUT1_, 0, false, scr, r, lane); continue; } r -= I_OUT;
            p0_transpose_item(w_in_1_, DM, N_IN1, 112, WIN1_, 0, true, scr, r, lane);
        }
        { const size_t z0 = (size_t)3616 * DM * 2, z1 = (size_t)N_IN0P * DM * 2;
          for (size_t p = z0 + ((size_t)bid * NTHREADS + tid) * 16; p < z1; p += (size_t)G * NTHREADS * 16) *(v4u*)((unsigned char*)WCAT0_ + p) = (v4u){0u, 0u, 0u, 0u}; }
        for (int i = bid * NTHREADS + tid; i < BATCH * 16 * 768; i += G * NTHREADS) KSUM_[i] = 0.f;
        { int m = gw; for (; m + NGW < M; m += 2 * NGW) rms_row2_to_bf16(x_ + (size_t)m * DM, x_ + (size_t)(m + NGW) * DM, norm_0_, ACAT_ + (size_t)m * DM, ACAT_ + (size_t)(m + NGW) * DM, lane);
          if (m < M) rms_row_to_bf16(x_ + (size_t)m * DM, norm_0_, ACAT_ + (size_t)m * DM, nullptr, nullptr, lane); }
        for (int m = gw; m < MROWS; m += NGW) rms_row_to_bf16(mem_ + (size_t)m * DM, mem_norm_0_, ACAT_ + (size_t)(M + m) * DM, mem_norm_1_, ACAT_ + (size_t)(M + MROWS + m) * DM, lane);
        for (int i = bid * NTHREADS + tid; i < M * 32; i += G * NTHREADS) { const int row = i >> 5, f = i & 31;
            const double ang = (double)positions_[row] * (double)ROPE_INVF[f]; double rv = ang * 0.15915494309189535; rv -= __builtin_rint(rv); const float rf = (float)rv;
            RT_[2 * (size_t)i] = __builtin_amdgcn_cosf(rf); RT_[2 * (size_t)i + 1] = __builtin_amdgcn_sinf(rf); }
    }
#endif
#endif
    xcd_barrier(xbar);
    if (G > (1 << 24)) grid.sync();

#ifndef SKIP_P1
    {
        pg8::Gemm g{ACAT_, WCAT0_, M + 2 * MROWS, N_IN0P + 1024, DM}; OrderX S; S.init(128, 15, G, bid, 32);
        EpiIn0 E{QKV_, Zb_, MQ_, MKV_, BA_};
        pg8::gemm_phase<EpiIn0, OrderX, true, true>(lds, g, S, E, wave_s);
    }
#ifdef DUP_GEMMS
    xcd_barrier(xbar);
    {
        pg8::Gemm g{ACAT_, WCAT0_, M + 2 * MROWS, N_IN0P + 1024, DM}; OrderX S; S.init(128, 15, G, bid, 32);
        EpiIn0 E{QKV_, Zb_, MQ_, MKV_, BA_};
        pg8::gemm_phase<EpiIn0, OrderX, true, true>(lds, g, S, E, wave_s);
    }
#endif
#endif
    xcd_barrier(xbar);

#ifndef SKIP_P2
#ifdef DUP_P2
    p2_delta_prep(lds, G, QKV_, BA_, conv_w_, a_log_, dt_bias_, DQG_, DKDT_, DW_, DU_, DA_, GL_, wave_s, DUP_P2);
    xcd_barrier(xbar);
#endif
    p2_delta_prep(lds, G, QKV_, BA_, conv_w_, a_log_, dt_bias_, DQG_, DKDT_, DW_, DU_, DA_, GL_, wave_s);
#endif
    xcd_barrier(xbar);

#ifndef SKIP_P3
    {
        const int nscan = G < 96 ? G : 96;
#ifdef DUP_P3
        if (bid < nscan) { for (int sq = bid; sq < 96; sq += nscan) p3_scan(lds, sq, DQG_, DKDT_, DW_, DU_, DA_, GL_, Zb_, o_norm_, wave_s, false); }
        xcd_barrier(xbar);
#endif
        if (bid < nscan) { for (int sq = bid; sq < 96; sq += nscan) p3_scan(lds, sq, DQG_, DKDT_, DW_, DU_, DA_, GL_, Zb_, o_norm_, wave_s); }
        const int u0 = (G > 96) ? (bid >= 96 ? bid - 96 : 512) : bid, ustep = (G > 96) ? G - 96 : G;
        for (int u = u0; u < 512; u += ustep) mem_attn_unit(u, 0, lds, (char*)lds_raw, wave_s);
    }
#endif
    xcd_barrier(xbar);

#ifndef SKIP_P4
    {
        pg8::Gemm g{Zb_, WOUT0_, M, DM, DM}; OrderX S; S.init(128, 4, G, bid, 0);
        EpiOut E{x_, out_};
        pg8::gemm_phase<EpiOut, OrderX, true, true>(lds, g, S, E, wave_s);
    }
#ifdef DUP_GEMMS
    xcd_barrier(xbar);
    {
        pg8::Gemm g{Zb_, WOUT0_, M, DM, DM}; OrderX S; S.init(128, 4, G, bid, 0);
        EpiOut E{x_, out_};
        pg8::gemm_phase<EpiOut, OrderX, true, true>(lds, g, S, E, wave_s);
    }
#endif
#endif
    xcd_barrier(xbar);

#ifndef SKIP_P5
    { FRESH_IDS(); int m = gw; for (; m + NGW < M; m += 2 * NGW) rms_row2_to_bf16(out_ + (size_t)m * DM, out_ + (size_t)(m + NGW) * DM, norm_1_, ACAT_ + (size_t)m * DM, ACAT_ + (size_t)(m + NGW) * DM, lane);
      if (m < M) rms_row_to_bf16(out_ + (size_t)m * DM, norm_1_, ACAT_ + (size_t)m * DM, nullptr, nullptr, lane); }
#endif
    xcd_barrier(xbar);

#ifndef SKIP_P6
    {
        pg8::Gemm g{ACAT_, WIN1_, M, N_IN1, DM}; OrderX S; S.init(128, 14, G, bid, 0);
        EpiIn1 E{QKV_, Zb_, MQ_, RT_, KSUM_};
        pg8::gemm_phase<EpiIn1, OrderX, true, true>(lds, g, S, E, wave_s);
    }
#ifdef DUP_GEMMS
    xcd_barrier(xbar);
    {
        pg8::Gemm g{ACAT_, WIN1_, M, N_IN1, DM}; OrderX S; S.init(128, 14, G, bid, 0);
        EpiIn1 E{QKV_, Zb_, MQ_, RT_, KSUM_};
        pg8::gemm_phase<EpiIn1, OrderX, true, true>(lds, g, S, E, wave_s);
    }
#endif
#endif
    xcd_barrier(xbar);


#ifndef SKIP_P7
    {
        const int npair = (768 - vcu + G - 1) / G;
#ifdef DUP_P7
        for (int i = 0; i < 2 * npair; ++i) { const int p = vcu + (i >> 1) * G, bh = p >> 3, s = p & 7;
            moba_attn_unit(bh, (i & 1) ? s : 15 - s, lds, (char*)lds_raw, wave_s, true); }
        xcd_barrier(xbar);
#endif
        for (int i = 0; i < 2 * npair; ++i) { const int p = vcu + (i >> 1) * G, bh = p >> 3, s = p & 7;
            moba_attn_unit(bh, (i & 1) ? s : 15 - s, lds, (char*)lds_raw, wave_s); }
        for (int u = vcu; u < 512; u += G) mem_attn_unit(u, 1, lds, (char*)lds_raw, wave_s);
    }
#endif
    xcd_barrier(xbar);

#ifndef SKIP_P8
    {
        pg8::Gemm g{Zb_, WOUT1_, M, DM, DM}; OrderX S; S.init(128, 4, G, bid, 0);
        EpiOut E{out_, out_};
        pg8::gemm_phase<EpiOut, OrderX, true, true>(lds, g, S, E, wave_s);
    }
#endif
    xcd_barrier(xbar);

#ifdef DUP_SYNC
    for (int i_ = 0; i_ < 20; ++i_) xcd_barrier(xbar);
#endif
#ifndef SKIP_P9
    { FRESH_IDS();
    for (int m = gw; m < M; m += 2 * NGW) {
        const bool two = (m + NGW) < M;
        f32x4* xr = (f32x4*)(out_ + (size_t)m * DM) + lane; f32x4* xs = (f32x4*)(out_ + (size_t)(two ? m + NGW : m) * DM) + lane; f32x4 v[4], u[4]; float s = 0.f, s2 = 0.f;
#pragma unroll
        for (int j = 0; j < 4; ++j) { v[j] = xr[64 * j]; u[j] = xs[64 * j]; }
#pragma unroll
        for (int j = 0; j < 4; ++j) { s += (v[j].x * v[j].x + v[j].y * v[j].y) + (v[j].z * v[j].z + v[j].w * v[j].w); s2 += (u[j].x * u[j].x + u[j].y * u[j].y) + (u[j].z * u[j].z + u[j].w * u[j].w); }
        const float rstd = rsqrtf(wave_sum(s) * (1.f / DM) + EPS), rstd2 = rsqrtf(wave_sum(s2) * (1.f / DM) + EPS);
#pragma unroll
        for (int j = 0; j < 4; ++j) { const f32x4 g = ((const f32x4*)final_norm_)[lane + 64 * j]; xr[64 * j] = v[j] * rstd * g; if (two) xs[64 * j] = u[j] * rstd2 * g; }
    } }
#endif
}

extern "C" void kernel_launch(void* const* d_in, const int* in_sizes, int n_in, void* d_out, int out_size, void* d_ws, size_t ws_size, hipStream_t stream) {
    static int grid = 0;
    if (grid == 0) {
        if (n_in != 18 || out_size != M * DM || ws_size < WS_END) { fprintf(stderr, "kernel_launch: unexpected shapes (n_in %d, out %d, ws %zu)\n", n_in, out_size, ws_size); grid = -1; return; }
        int dev = 0, cus = 0, per_cu = 0;
        hipGetDevice(&dev); hipDeviceGetAttribute(&cus, hipDeviceAttributeMultiprocessorCount, dev);
        if (hipFuncSetAttribute((const void*)hybrid_fwd, hipFuncAttributeMaxDynamicSharedMemorySize, LDS_BYTES) != hipSuccess) { fprintf(stderr, "kernel_launch: hipFuncSetAttribute failed\n"); grid = -1; return; }
        if (hipOccupancyMaxActiveBlocksPerMultiprocessor(&per_cu, (const void*)hybrid_fwd, NTHREADS, LDS_BYTES) != hipSuccess || per_cu < 1) { fprintf(stderr, "kernel_launch: occupancy query says %d\n", per_cu); per_cu = 1; }
        (void)hipGetLastError();
        grid = cus * 1;
    }
    if (grid < 0) return;
    if (hipMemsetAsync((char*)d_ws + WS_BAR, 0, 16384, stream) != hipSuccess) { fprintf(stderr, "kernel_launch: memset failed\n"); return; }
    Args a{};
    for (int i = 0; i < 18; ++i) a.in[i] = (const float*)d_in[i];
    a.out = (float*)d_out; a.ws = (unsigned char*)d_ws;
    void* kargs[] = {&a};
    hipError_t e = hipLaunchCooperativeKernel((const void*)hybrid_fwd, dim3(grid), dim3(NTHREADS), kargs, LDS_BYTES, stream);
    if (e != hipSuccess) fprintf(stderr, "kernel_launch: cooperative launch failed: %s (grid %d)\n", hipGetErrorString(e), grid);
}
```

```cpp
#include <hip/hip_runtime.h>
#include <hip/hip_cooperative_groups.h>
#include <hip/hip_bf16.h>
#include <cstdio>
#include <cstdint>
#include <cmath>
namespace pg8 {
#define PG8_LAS __attribute__((address_space(3)))
typedef unsigned short bf16_t;
typedef short bf16x8 __attribute__((ext_vector_type(8)));
typedef float f32x4 __attribute__((ext_vector_type(4)));
typedef unsigned u32x4 __attribute__((ext_vector_type(4)));
constexpr int BM = 256, BK = 64, HALF = 128, HTB = HALF * BK * 2  , STAGE_BYTES = 8 * HTB, NXCD = 8, WGM = 8;

__host__ __device__ __forceinline__ int lds_byte(int r, int c) { const int st = (r >> 4) * 2 + (c >> 5), rr = r & 15, cc = c & 31, ob = rr * 64 + cc * 2; return st * 1024 + (ob ^ (((ob >> 9) & 1) << 5)); }
__host__ __device__ __forceinline__ void stage_rc(int b, int& R, int& C) { const int st = b / 1024, sb = b % 1024, swz = sb ^ (((sb >> 9) & 1) << 5); R = (st >> 1) * 16 + swz / 64; C = (st & 1) * 32 + (swz % 64) / 2; }
__host__ __device__ __forceinline__ int perm32(int rho) { const int n = rho >> 4, i = rho & 15; return 8 * (i >> 2) + 4 * n + (i & 3); }

struct Unit { int pm, pn; };
struct Gemm { const bf16_t* A; const bf16_t* Bt; int M, N, K; };
__device__ __forceinline__ unsigned cvt_pk_bf16(float lo, float hi) { unsigned r; asm volatile("v_cvt_pk_bf16_f32 %0, %1, %2" : "=v"(r) : "v"(lo), "v"(hi)); return r; }
typedef float f32x2 __attribute__((ext_vector_type(2)));
template <class Epi, class Sched, bool ALIGN_EPI = false, bool SP2 = false>
__device__ __forceinline__ void gemm_phase(PG8_LAS unsigned char* lds, const Gemm g, const Sched& S, const Epi& E, const int wave_s) {
    int lane_ = __builtin_amdgcn_mbcnt_hi(~0u, __builtin_amdgcn_mbcnt_lo(~0u, 0u)); asm volatile("" : "+v"(lane_)); const int tid = wave_s * 64 + lane_; const int wid = wave_s, lane = tid & 63, wr = wid >> 2, wc = wid & 3, fr = lane & 15, fq = lane >> 4;
    const int K = g.K, nt = K / BK;
    unsigned voffA[2], voffB[2];
#pragma unroll
    for (int i = 0; i < 2; ++i) { int R, C; stage_rc(tid * 16 + i * 8192, R, C); const int Rb = Epi::PERM ? ((R & ~31) + perm32(R & 31)) : R;
        voffA[i] = (unsigned)(R * K + C) * 2u; voffB[i] = (unsigned)(Rb * K + C) * 2u; }
    const size_t kstep = (size_t)(BK * 2);
    const size_t hstep = (size_t)HALF * K * 2;
    const size_t tstep = 2 * hstep;
    const unsigned ldsw = (unsigned)wid * 1024u;
    const int aoff = lds_byte(wr * 64 + fr, fq * 8), boff = lds_byte(wc * 32 + fr, fq * 8);
#define PG8_SA(b, h) (((b) * 2 + (h)) * HTB)
#define PG8_SB(b, h) ((4 + (b) * 2 + (h)) * HTB)
#define PG8_STAGE(bufoff, gbase, voff) do { _Pragma("unroll") for (int _i = 0; _i < 2; ++_i) \
        __builtin_amdgcn_global_load_lds((const unsigned*)((const char*)(gbase) + (voff)[_i]), (PG8_LAS unsigned*)(lds + (bufoff) + ldsw + _i * 8192), 16, 0, 0); } while (0)
#define PG8_LDA(dst, b, h) do { _Pragma("unroll") for (int m = 0; m < 4; ++m) _Pragma("unroll") for (int k = 0; k < 2; ++k) dst[m][k] = *(const PG8_LAS bf16x8*)(lds + PG8_SA(b, h) + aoff + m * 2048 + k * 1024); } while (0)
#define PG8_LDB(dst, b, h) do { _Pragma("unroll") for (int n = 0; n < 2; ++n) _Pragma("unroll") for (int k = 0; k < 2; ++k) dst[n][k] = *(const PG8_LAS bf16x8*)(lds + PG8_SB(b, h) + boff + n * 2048 + k * 1024); } while (0)
#define PG8_MMA(ai, bj, At, Bt) do { __builtin_amdgcn_s_setprio(1); _Pragma("unroll") for (int m = 0; m < 4; ++m) _Pragma("unroll") for (int n = 0; n < 2; ++n) _Pragma("unroll") for (int k = 0; k < 2; ++k) \
        acc[ai][bj][m][n] = __builtin_amdgcn_mfma_f32_16x16x32_bf16(Bt[n][k], At[m][k], acc[ai][bj][m][n], 0, 0, 0); __builtin_amdgcn_s_setprio(0); } while (0)
#define PG8_WAIT_V(n) asm volatile("s_waitcnt vmcnt(" #n ")" ::: "memory")
#define PG8_WAIT_L(n) asm volatile("s_waitcnt lgkmcnt(" #n ")" ::: "memory")
#define PG8_BAR __builtin_amdgcn_s_barrier()
#define PG8_SCHED __builtin_amdgcn_sched_barrier(0)
    Unit cur, nxt; int ui = 0;
    if (!S.next(0, cur)) return;
    f32x4 acc[2][2][4][2];
#pragma unroll
    for (int a = 0; a < 2; ++a)
#pragma unroll
        for (int b = 0; b < 2; ++b)
#pragma unroll
            for (int m = 0; m < 4; ++m)
#pragma unroll
                for (int n = 0; n < 2; ++n) acc[a][b][m][n] = (f32x4){0.f, 0.f, 0.f, 0.f};
    bf16x8 At[4][2], B0[2][2], B1[2][2];
    const char* cA = (const char*)g.A + (size_t)cur.pm * tstep; const char* cB = (const char*)g.Bt + (size_t)cur.pn * tstep;
    S.a_ready(cur);
    if constexpr (SP2) {
        PG8_STAGE(PG8_SB(0, 0), cB, voffB); PG8_STAGE(PG8_SB(0, 1), cB + hstep, voffB); PG8_STAGE(PG8_SA(0, 0), cA, voffA); PG8_STAGE(PG8_SA(0, 1), cA + hstep, voffA);
        if (wr == 1) PG8_BAR;
        PG8_WAIT_V(2); PG8_BAR;
        PG8_STAGE(PG8_SB(1, 0), cB + kstep, voffB); PG8_STAGE(PG8_SA(1, 0), cA + kstep, voffA); PG8_STAGE(PG8_SB(1, 1), cB + hstep + kstep, voffB);
        PG8_WAIT_V(6); PG8_BAR;
    } else {
        PG8_STAGE(PG8_SB(0, 0), cB, voffB); PG8_STAGE(PG8_SA(0, 0), cA, voffA); PG8_STAGE(PG8_SB(0, 1), cB + hstep, voffB); PG8_STAGE(PG8_SA(0, 1), cA + hstep, voffA);
        if (wr == 1) PG8_BAR;
        PG8_WAIT_V(4); PG8_BAR;
        PG8_STAGE(PG8_SB(1, 0), cB + kstep, voffB); PG8_STAGE(PG8_SA(1, 0), cA + kstep, voffA); PG8_STAGE(PG8_SB(1, 1), cB + hstep + kstep, voffB);
        PG8_WAIT_V(6); PG8_BAR;
    }
    for (;;) {
        const bool has_next = S.next(ui + 1, nxt);
        const char* nA = has_next ? (const char*)g.A + (size_t)nxt.pm * tstep : cA; const char* nB = has_next ? (const char*)g.Bt + (size_t)nxt.pn * tstep : cB;
        for (int t = 0; t < nt; t += 2) {
            const bool last = (t == nt - 2);
            const char* a1 = cA + (size_t)(t + 1) * kstep;
            const char* a2 = last ? nA : cA + (size_t)(t + 2) * kstep; const char* b2 = last ? nB : cB + (size_t)(t + 2) * kstep;
            const char* a3 = a2 + kstep; const char* b3 = b2 + kstep;
            if (last && has_next) S.a_ready(nxt);
            if constexpr (SP2) {
            PG8_LDB(B0, 0, 0); PG8_LDB(B1, 0, 1); PG8_SCHED; PG8_LDA(At, 0, 0); PG8_STAGE(PG8_SA(1, 1), a1 + hstep, voffA);
            PG8_WAIT_V(8); PG8_WAIT_L(0); PG8_BAR; PG8_MMA(0, 0, At, B0); PG8_MMA(0, 1, At, B1); PG8_BAR; PG8_SCHED;
            PG8_LDA(At, 0, 1); PG8_STAGE(PG8_SB(0, 0), b2, voffB); PG8_STAGE(PG8_SB(0, 1), b2 + hstep, voffB); PG8_STAGE(PG8_SA(0, 0), a2, voffA);
            PG8_WAIT_V(8); PG8_WAIT_L(0); PG8_BAR; PG8_MMA(1, 0, At, B0); PG8_MMA(1, 1, At, B1); PG8_BAR; PG8_SCHED;
            PG8_LDB(B0, 1, 0); PG8_LDB(B1, 1, 1); PG8_SCHED; PG8_LDA(At, 1, 0); PG8_STAGE(PG8_SA(0, 1), a2 + hstep, voffA);
            PG8_WAIT_V(8); PG8_WAIT_L(0); PG8_BAR; PG8_MMA(0, 0, At, B0); PG8_MMA(0, 1, At, B1); PG8_BAR; PG8_SCHED;
            PG8_LDA(At, 1, 1); PG8_STAGE(PG8_SB(1, 0), b3, voffB); PG8_STAGE(PG8_SB(1, 1), b3 + hstep, voffB); PG8_STAGE(PG8_SA(1, 0), a3, voffA);
            PG8_WAIT_V(8); PG8_WAIT_L(0); PG8_BAR; PG8_MMA(1, 0, At, B0); PG8_MMA(1, 1, At, B1); PG8_BAR; PG8_SCHED;
            } else {
            PG8_LDB(B0, 0, 0); PG8_SCHED; PG8_LDA(At, 0, 0); PG8_STAGE(PG8_SA(1, 1), a1 + hstep, voffA);
            PG8_WAIT_L(8); PG8_BAR; PG8_WAIT_L(0); PG8_MMA(0, 0, At, B0); PG8_BAR; PG8_SCHED;
            PG8_LDB(B1, 0, 1); PG8_STAGE(PG8_SB(0, 0), b2, voffB);
            PG8_BAR; PG8_WAIT_L(0); PG8_MMA(0, 1, At, B1); PG8_BAR;
            PG8_LDA(At, 0, 1); PG8_STAGE(PG8_SA(0, 0), a2, voffA);
            PG8_BAR; PG8_WAIT_L(0); PG8_MMA(1, 0, At, B0); PG8_BAR; PG8_SCHED;
            PG8_STAGE(PG8_SB(0, 1), b2 + hstep, voffB);
            PG8_WAIT_V(6); PG8_BAR; PG8_MMA(1, 1, At, B1); PG8_BAR;
            PG8_LDB(B0, 1, 0); PG8_SCHED; PG8_LDA(At, 1, 0); PG8_STAGE(PG8_SA(0, 1), a2 + hstep, voffA);
            PG8_WAIT_L(8); PG8_BAR; PG8_WAIT_L(0); PG8_MMA(0, 0, At, B0); PG8_BAR; PG8_SCHED;
            PG8_LDB(B1, 1, 1); PG8_STAGE(PG8_SB(1, 0), b3, voffB);
            PG8_BAR; PG8_WAIT_L(0); PG8_MMA(0, 1, At, B1); PG8_BAR;
            PG8_LDA(At, 1, 1); PG8_STAGE(PG8_SA(1, 0), a3, voffA);
            PG8_BAR; PG8_WAIT_L(0); PG8_MMA(1, 0, At, B0); PG8_BAR; PG8_SCHED;
            PG8_STAGE(PG8_SB(1, 1), b3 + hstep, voffB);
            PG8_WAIT_V(6); PG8_BAR; PG8_MMA(1, 1, At, B1); PG8_BAR;
            }
        }
        if constexpr (ALIGN_EPI) { if (wr == 0) PG8_BAR; }
        if constexpr (!Epi::AFTER_DRAIN) { E(acc, cur, wr, wc, fr, fq); S.done(cur); }
        if (!has_next) break;
#pragma unroll
        for (int a = 0; a < 2; ++a)
#pragma unroll
            for (int b = 0; b < 2; ++b)
#pragma unroll
                for (int m = 0; m < 4; ++m)
#pragma unroll
                    for (int n = 0; n < 2; ++n) acc[a][b][m][n] = (f32x4){0.f, 0.f, 0.f, 0.f};
        cur = nxt; cA = nA; cB = nB; ++ui;
        if constexpr (ALIGN_EPI) { if (wr == 1) PG8_BAR; }
    }
    PG8_WAIT_V(0);
    if constexpr (!ALIGN_EPI) { if (wr == 0) PG8_BAR; }
    PG8_BAR;
    if constexpr (Epi::AFTER_DRAIN) { E.fused(acc, cur, wr, wc, fr, fq, lds, wid, lane); S.done(cur); }
#undef PG8_SA
#undef PG8_SB
#undef PG8_STAGE
#undef PG8_LDA
#undef PG8_LDB
#undef PG8_MMA
#undef PG8_WAIT_V
#undef PG8_WAIT_L
#undef PG8_BAR
#undef PG8_SCHED
}
}
namespace attn_body {
using bf16=__hip_bfloat16;
using bf16x8=__attribute__((ext_vector_type(8)))short;
using s16x4=__attribute__((ext_vector_type(4)))short;
using f32x16=__attribute__((ext_vector_type(16)))float;
using u32x4=__attribute__((ext_vector_type(4)))unsigned;
using f32x4_t=__attribute__((ext_vector_type(4)))float;
__device__ __forceinline__ float bf2f(short v){return __uint_as_float(((unsigned)(unsigned short)v)<<16);}
constexpr int D=64;
constexpr int NW=8,QBLK=32,QB=QBLK*NW,KVBLK=64;
__device__ __forceinline__ int crow(int r,int hi){return (r&3)+8*(r>>2)+4*hi;}
#define SBAR() __builtin_amdgcn_sched_barrier(0)
__device__ __forceinline__ void cmask(f32x16&p0,f32x16&p1,int jb,int qrel,int hi){
  const float NEG=-INFINITY; int kb=64*jb+4*hi;
  #pragma unroll
  for(int r=0;r<16;++r){int kv=kb+(r&3)+8*(r>>2); if(kv>qrel)p0[r]=NEG; if(kv+32>qrel)p1[r]=NEG;}
}

constexpr int NSLOT=3, SLOTB=8192;
constexpr int LDS_K=0, LDS_V=NSLOT*SLOTB, LDS_WS=2*NSLOT*SLOTB, LDS_OST=LDS_WS+NW*64*4, LDS_BYTES=LDS_OST+NW*4096;
constexpr float C2=0.125f*1.4426950408889634f;
__device__ __forceinline__ void glds16(const void*gsrc,unsigned lds_dst){unsigned keep;
  asm volatile("s_mov_b32 %0, m0\n\ts_mov_b32 m0, %2\n\ts_nop 0\n\tglobal_load_lds_dwordx4 %1, off\n\ts_mov_b32 m0, %0":"=&s"(keep):"v"(gsrc),"s"(lds_dst):"memory");}
__device__ __forceinline__ float max3f(float a,float b,float c){float r;asm("v_max3_f32 %0, %1, %2, %3":"=v"(r):"v"(a),"v"(b),"v"(c));return r;}
__device__ __forceinline__ float max2f(float a,float b){float r;asm("v_max_f32_e32 %0, %1, %2":"=v"(r):"v"(a),"v"(b));return r;}
__device__ __forceinline__ float fadd_s(float a,float b){float r;asm("v_add_f32_e32 %0, %1, %2":"=v"(r):"v"(a),"v"(b));return r;}
__device__ __forceinline__ float fsub_s(float a,float b){float r;asm("v_sub_f32_e32 %0, %1, %2":"=v"(r):"v"(a),"v"(b));return r;}
typedef float f32x2_t __attribute__((ext_vector_type(2))); typedef __bf16 bf16x2_t __attribute__((ext_vector_type(2)));
__device__ __forceinline__ unsigned cvtpk_s(float lo,float hi){f32x2_t v={lo,hi};bf16x2_t b=__builtin_convertvector(v,bf16x2_t);return __builtin_bit_cast(unsigned,b);}
#define WAIT_BAR(N) asm volatile("s_waitcnt vmcnt(" #N ") lgkmcnt(0)\n\ts_barrier":::"memory")

__device__ __forceinline__ float wave_max_f(float v){
  #define DPPMX(ctrl) v=__builtin_fmaxf(v,__builtin_bit_cast(float,__builtin_amdgcn_update_dpp(__builtin_bit_cast(int,v),__builtin_bit_cast(int,v),(ctrl),0xf,0xf,false)))
  DPPMX(0xB1); DPPMX(0x4E); DPPMX(0x141); DPPMX(0x140);
  #undef DPPMX
  const int vi=__builtin_bit_cast(int,v);
  return __builtin_fmaxf(__builtin_fmaxf(__builtin_bit_cast(float,__builtin_amdgcn_readlane(vi,0)),__builtin_bit_cast(float,__builtin_amdgcn_readlane(vi,16))),__builtin_fmaxf(__builtin_bit_cast(float,__builtin_amdgcn_readlane(vi,32)),__builtin_bit_cast(float,__builtin_amdgcn_readlane(vi,48))));
}
__device__ __forceinline__ void qkt(f32x16&p0,f32x16&p1,const char*Kslot,const bf16x8*qr,const f32x16&negm,int r32,int hi){
  const char*kb=Kslot+hi*1024+r32*16;
  #pragma unroll
  for(int d0=0;d0<4;++d0){
    const bf16x8 b0=*reinterpret_cast<const bf16x8*>(kb+d0*2048);
    const bf16x8 b1=*reinterpret_cast<const bf16x8*>(kb+d0*2048+512);
    if(d0==0){p0=__builtin_amdgcn_mfma_f32_32x32x16_bf16(b0,qr[0],negm,0,0,0);p1=__builtin_amdgcn_mfma_f32_32x32x16_bf16(b1,qr[0],negm,0,0,0);}
    else{p0=__builtin_amdgcn_mfma_f32_32x32x16_bf16(b0,qr[d0],p0,0,0,0);p1=__builtin_amdgcn_mfma_f32_32x32x16_bf16(b1,qr[d0],p1,0,0,0);}}
}
typedef __attribute__((address_space(3))) const char* lds_cptr;
typedef short v4i16_t __attribute__((ext_vector_type(4)));
__device__ __forceinline__ void kload8(bf16x8*kf,lds_cptr kp){
  kf[0]=*(const __attribute__((address_space(3))) bf16x8*)(kp);      kf[1]=*(const __attribute__((address_space(3))) bf16x8*)(kp+512);
  kf[2]=*(const __attribute__((address_space(3))) bf16x8*)(kp+2048); kf[3]=*(const __attribute__((address_space(3))) bf16x8*)(kp+2560);
  kf[4]=*(const __attribute__((address_space(3))) bf16x8*)(kp+4096); kf[5]=*(const __attribute__((address_space(3))) bf16x8*)(kp+4608);
  kf[6]=*(const __attribute__((address_space(3))) bf16x8*)(kp+6144); kf[7]=*(const __attribute__((address_space(3))) bf16x8*)(kp+6656);
}
__device__ __forceinline__ void kload2(bf16x8*kf,lds_cptr kp,int j){ kf[2*j]=*(const __attribute__((address_space(3))) bf16x8*)(kp+j*2048); kf[2*j+1]=*(const __attribute__((address_space(3))) bf16x8*)(kp+j*2048+512); }
__device__ __forceinline__ s16x4 vtr(lds_cptr p){ return __builtin_bit_cast(s16x4,__builtin_amdgcn_ds_read_tr16_b64_v4i16((__attribute__((address_space(3))) v4i16_t*)p)); }
__device__ __forceinline__ float rowmax(const f32x16&p0,const f32x16&p1){
  float a=max3f(p0[0],p0[1],p1[0]),b=max3f(p0[2],p0[3],p1[1]);a=max3f(a,p1[2],p1[3]);
  #pragma unroll
  for(int r=4;r<16;r+=4){a=max3f(a,p0[r],p0[r+1]);b=max3f(b,p0[r+2],p0[r+3]);a=max3f(a,p1[r],p1[r+1]);b=max3f(b,p1[r+2],p1[r+3]);}
  const float m=max2f(a,b);
  auto rr=__builtin_amdgcn_permlane32_swap(__float_as_uint(m),__float_as_uint(m),false,false);
  return max2f(__uint_as_float(rr[0]),__uint_as_float(rr[1]));
}
__device__ __forceinline__ void pv(f32x16*o,int vb,bf16x8 pa0,bf16x8 pa1,bf16x8 pa2,bf16x8 pa3){
  #pragma unroll
  for(int d0=0;d0<2;++d0){s16x4 lo[4],hi[4];
    #pragma unroll
    for(int ks=0;ks<4;++ks){
      asm volatile("ds_read_b64_tr_b16 %0,%1 offset:%c2":"=&v"(lo[ks]):"v"(vb),"i"(d0*4096+ks*1024):"memory");
      asm volatile("ds_read_b64_tr_b16 %0,%1 offset:%c2":"=&v"(hi[ks]):"v"(vb),"i"(d0*4096+ks*1024+512):"memory");}
    asm volatile("s_waitcnt lgkmcnt(0)":::"memory");SBAR();
    #define PK(k) (bf16x8){lo[k][0],lo[k][1],lo[k][2],lo[k][3],hi[k][0],hi[k][1],hi[k][2],hi[k][3]}
    o[d0]=__builtin_amdgcn_mfma_f32_32x32x16_bf16(pa0,PK(0),o[d0],0,0,0);
    o[d0]=__builtin_amdgcn_mfma_f32_32x32x16_bf16(pa1,PK(1),o[d0],0,0,0);
    o[d0]=__builtin_amdgcn_mfma_f32_32x32x16_bf16(pa2,PK(2),o[d0],0,0,0);
    o[d0]=__builtin_amdgcn_mfma_f32_32x32x16_bf16(pa3,PK(3),o[d0],0,0,0);
    #undef PK
  }
}

#ifndef ATTN_STORE16
#define ATTN_STORE16(p,v) (*(u32x4*)(p)=(v))
#endif
template<int THRL,int MODE,int qp,int kvp,int zp> __device__ __forceinline__ void attn_unit(int NT,const bf16*Qu,const bf16*__restrict__ Kh,const bf16*__restrict__ Vh,bf16*Zu,const float*ksum,int nsel,char*shm,const int wave_s,const bool dry=false,const float*rtq=nullptr){
  int lane=__builtin_amdgcn_mbcnt_hi(~0u,__builtin_amdgcn_mbcnt_lo(~0u,0u)); asm volatile("":"+v"(lane));   const int tid=wave_s*64+lane; (void)tid; const int r32=lane&31,hi=lane>>5; float zf=0.f; asm volatile("":"+v"(zf)); const int wid=wave_s;
  const bf16*Qw=Qu+(long)(wid*QBLK)*qp;
  const unsigned lds0=(unsigned)(uintptr_t)shm;
  float*wsf=(float*)(shm+LDS_WS)+wid*64;
  const bf16*ksrc=Kh+(long)lane*kvp+wid*8;
  const bf16*vsrc=Vh+(long)(16*(wid&3)+(lane>>2))*kvp+(wid>>2)*32+(lane&3)*8;
  const unsigned kdst=lds0+LDS_K+wid*1024, vdst=lds0+LDS_V+wid*1024;
  #define DMA_K(t,slot) glds16(ksrc+(long)(t)*KVBLK*kvp,(unsigned)__builtin_amdgcn_readfirstlane(kdst+(slot)))
  #define DMA_V(t,slot) glds16(vsrc+(long)(t)*KVBLK*kvp,(unsigned)__builtin_amdgcn_readfirstlane(vdst+(slot)))
  const int vb0=(int)(lds0+LDS_V)+((lane>>4)&1)*32+(lane&3)*8+(4*hi+((lane&15)>>2))*64;
  const char*Kbase=shm+LDS_K; bf16x8 kf[8];
  const lds_cptr shm3=(lds_cptr)shm; const lds_cptr kp0=shm3+LDS_K+hi*1024+r32*16; const lds_cptr vp0=shm3+LDS_V+((lane>>4)&1)*32+(lane&3)*8+(4*hi+((lane&15)>>2))*64;
  DMA_K(0,0);DMA_V(0,0);DMA_K(1,SLOTB);
  bf16x8 qr[4];
  #pragma unroll
  for(int d0=0;d0<4;++d0)qr[d0]=*reinterpret_cast<const bf16x8*>(&Qw[(long)r32*qp+d0*16+hi*8]);
  if(MODE==1){ const float*rp_=rtq+(long)(wid*QBLK+r32)*64+8*hi;
    _Pragma("unroll") for(int d0=0;d0<4;++d0){ const f32x4_t t0=*(const f32x4_t*)(rp_+16*d0), t1=*(const f32x4_t*)(rp_+16*d0+4);
      const float a0=bf2f(qr[d0][0]),b0=bf2f(qr[d0][1]),a1=bf2f(qr[d0][2]),b1=bf2f(qr[d0][3]),a2=bf2f(qr[d0][4]),b2=bf2f(qr[d0][5]),a3=bf2f(qr[d0][6]),b3=bf2f(qr[d0][7]);
      u32x4 w_; w_[0]=cvtpk_s((a0*t0[0]-b0*t0[1])*C2,(b0*t0[0]+a0*t0[1])*C2); w_[1]=cvtpk_s((a1*t0[2]-b1*t0[3])*C2,(b1*t0[2]+a1*t0[3])*C2);
      w_[2]=cvtpk_s((a2*t1[0]-b2*t1[1])*C2,(b2*t1[0]+a2*t1[1])*C2); w_[3]=cvtpk_s((a3*t1[2]-b3*t1[3])*C2,(b3*t1[2]+a3*t1[3])*C2); qr[d0]=__builtin_bit_cast(bf16x8,w_); } }
  unsigned selmask=0xffffffffu;
  if(MODE==1){ if(nsel>3){ float v0=-INFINITY,v1=-INFINITY,v2=-INFINITY; int i0=0,i1=0,i2=0;
      for(int j=0;j<nsel;++j){ const float*kp=ksum+(long)j*768+hi*8; float g=0.f;
        _Pragma("unroll") for(int d0=0;d0<4;++d0){ const f32x4_t ka=*(const f32x4_t*)(kp+d0*16), kb=*(const f32x4_t*)(kp+d0*16+4);
          g+=bf2f(qr[d0][0])*ka[0]+bf2f(qr[d0][1])*ka[1]+bf2f(qr[d0][2])*ka[2]+bf2f(qr[d0][3])*ka[3]+bf2f(qr[d0][4])*kb[0]+bf2f(qr[d0][5])*kb[1]+bf2f(qr[d0][6])*kb[2]+bf2f(qr[d0][7])*kb[3]; }
        { auto rr_=__builtin_amdgcn_permlane32_swap(__float_as_uint(g),__float_as_uint(g),false,false); g=__uint_as_float(rr_[0])+__uint_as_float(rr_[1]); }
        if(g>v0){v2=v1;i2=i1;v1=v0;i1=i0;v0=g;i0=j;} else if(g>v1){v2=v1;i2=i1;v1=g;i1=j;} else if(g>v2){v2=g;i2=j;} }
      selmask=(1u<<i0)|(1u<<i1)|(1u<<i2); } }
  float mhat=0.f,l_reg=0.f;f32x16 o[2];_Pragma("unroll") for(int r=0;r<16;++r){o[0][r]=zf;o[1][r]=zf;} const f32x16 negm=f32x16{};
  const int qrel=wid*QBLK+r32;
  #define CMASK(P0,P1,t) do{ if(MODE==1){int jb_=(t)-(NT-4); if(jb_>=0)cmask(P0,P1,jb_,qrel,hi);} }while(0)
  bool resc=false;
  #define START(P0,P1) do{ const float rm=rowmax(P0,P1); resc=false; \
    { const float wm_=wave_max_f(rm); const float dl=(rm==-INFINITY)?((wm_==-INFINITY)?0.f:wm_):rm; mhat=fadd_s(mhat,dl);     \
      _Pragma("unroll") for(int r=0;r<16;++r){P0[r]=fsub_s(P0[r],dl);P1[r]=fsub_s(P1[r],dl);} \
      } \
    _Pragma("unroll") for(int r=0;r<16;++r)P0[r]=__builtin_amdgcn_exp2f(P0[r]); }while(0)
  #define RESC() do{ if(resc){ asm volatile("s_waitcnt lgkmcnt(0)":::"memory"); \
      _Pragma("unroll") for(int d_=0;d_<2;++d_) _Pragma("unroll") for(int r=0;r<16;++r)o[d_][r]*=wsf[crow(r,hi)]; } }while(0)
  f32x16 pA0,pA1,pB0,pB1;
  int sl_prev=0,sl_cur=0,sl_next=SLOTB;
  #define ROT() do{sl_prev=sl_cur;sl_cur=sl_next;sl_next=(sl_next==(NSLOT-1)*SLOTB)?0:sl_next+SLOTB;}while(0)
  DMA_K(2,2*SLOTB);
  WAIT_BAR(3);
  qkt(pA0,pA1,Kbase,qr,negm,r32,hi);asm volatile("s_nop 15\n\ts_nop 7":"+v"(pA0),"+v"(pA1));CMASK(pA0,pA1,0);
  if(MODE==1){ const float ms0=(NT>4&&!(selmask&1u))?INFINITY:0.f; _Pragma("unroll") for(int r=0;r<16;++r){pA0[r]-=ms0;pA1[r]-=ms0;} }
  START(pA0,pA1);
  _Pragma("unroll") for(int r=0;r<16;++r)pA1[r]=__builtin_amdgcn_exp2f(pA1[r]);
  WAIT_BAR(0);
  DMA_K(3,0);DMA_V(1,SLOTB);
  ROT();
  kload8(kf,kp0+sl_cur);
  WAIT_BAR(2);
  s16x4 vlo[8],vhi[8]; u32x4 pw0,pw1,pw2,pw3; f32x16 cin;
  #define PKW(P,B) cvtpk_s(P[B],P[B+1])
  #define PAF(k) __builtin_bit_cast(bf16x8,pw##k)
  #define VFR(i) (bf16x8){vlo[i][0],vlo[i][1],vlo[i][2],vlo[i][3],vhi[i][0],vhi[i][1],vhi[i][2],vhi[i][3]}
  #define PIN(x) asm volatile("":"+v"(x))
  #define MX3(a,b,c) __builtin_fmaxf(__builtin_fmaxf((a),(b)),(c))
  #define GAPA(MF,A0,A1,A2,A3,W0,W1,PW) do{ MF; sacc+=A0; sacc+=A1; sacc+=A2; sacc+=A3; PIN(sacc); W0; W1; PIN(PW); SBAR(); }while(0)
  #define EX(v) __builtin_amdgcn_exp2f(v)
  #define GAPB(MF,X,B) do{ MF; X[B]=EX(X[B]); X[B+1]=EX(X[B+1]); X[B+2]=EX(X[B+2]); X[B+3]=EX(X[B+3]); PIN(X); SBAR(); }while(0)
  #define VRD(i) do{ vlo[i]=vtr(vp_+(((i)>>2)*4096+((i)&3)*1024)); vhi[i]=vtr(vp_+(((i)>>2)*4096+((i)&3)*1024+512)); }while(0)
  #define KRD(G,j) do{ if(G){ kload2(kf,kp0+sl_next,j); SBAR(); } }while(0)
  #define STEP(C0,C1,P0,P1,t,GK,GV,GL) do{ { const float cv_=(MODE==1&&(t)<NT-4&&!((selmask>>((t)>>2))&1u))?-INFINITY:-mhat; _Pragma("unroll") for(int r=0;r<16;++r)cin[r]=cv_; asm volatile("":"+v"(cin)); } SBAR(); \
    const lds_cptr vp_=vp0+sl_prev; \
    VRD(0); SBAR(); float sacc=(P0[0]+P0[1]); \
    GAPA(C0=__builtin_amdgcn_mfma_f32_32x32x16_bf16(kf[0],qr[0],cin,0,0,0), P0[2],P0[3],P0[4],P0[5],     pw0[0]=PKW(P0,0), pw0[1]=PKW(P0,2), pw0); \
    VRD(4); SBAR(); GAPA(C1=__builtin_amdgcn_mfma_f32_32x32x16_bf16(kf[1],qr[0],cin,0,0,0), P0[6],P0[7],P0[8],P0[9],     pw0[2]=PKW(P0,4), pw0[3]=PKW(P0,6), pw0); \
    VRD(1); SBAR(); GAPA(C0=__builtin_amdgcn_mfma_f32_32x32x16_bf16(kf[2],qr[1],C0,0,0,0),   P0[10],P0[11],P0[12],P0[13], pw1[0]=PKW(P0,8), pw1[1]=PKW(P0,10), pw1); \
    VRD(5); SBAR(); GAPA(C1=__builtin_amdgcn_mfma_f32_32x32x16_bf16(kf[3],qr[1],C1,0,0,0),   P0[14],P0[15],P1[0],P1[1],   pw1[2]=PKW(P0,12),pw1[3]=PKW(P0,14), pw1); \
    VRD(2); SBAR(); GAPA(C0=__builtin_amdgcn_mfma_f32_32x32x16_bf16(kf[4],qr[2],C0,0,0,0),   P1[2],P1[3],P1[4],P1[5],     pw2[0]=PKW(P1,0), pw2[1]=PKW(P1,2), pw2); \
    VRD(6); SBAR(); GAPA(C1=__builtin_amdgcn_mfma_f32_32x32x16_bf16(kf[5],qr[2],C1,0,0,0),   P1[6],P1[7],P1[8],P1[9],     pw2[2]=PKW(P1,4), pw2[3]=PKW(P1,6), pw2); \
    VRD(3); SBAR(); GAPA(C0=__builtin_amdgcn_mfma_f32_32x32x16_bf16(kf[6],qr[3],C0,0,0,0),   P1[10],P1[11],P1[12],P1[13], pw3[0]=PKW(P1,8), pw3[1]=PKW(P1,10), pw3); \
    VRD(7); SBAR(); GAPA(C1=__builtin_amdgcn_mfma_f32_32x32x16_bf16(kf[7],qr[3],C1,0,0,0),   P1[14],P1[15],0.f,0.f,       pw3[2]=PKW(P1,12),pw3[3]=PKW(P1,14), pw3); \
    l_reg+=sacc; \
    if(GK){DMA_K((t)+3,sl_cur);} if(GV){DMA_V((t)+1,sl_next);} \
    CMASK(C0,C1,t); \
    { float a=MX3(C0[0],C0[1],C1[0]),b=MX3(C0[2],C0[3],C1[1]); a=MX3(a,C1[2],C1[3]); \
      _Pragma("unroll") for(int r=4;r<16;r+=4){a=MX3(a,C0[r],C0[r+1]);b=MX3(b,C0[r+2],C0[r+3]);a=MX3(a,C1[r],C1[r+1]);b=MX3(b,C1[r+2],C1[r+3]);} \
      float rm=__builtin_fmaxf(a,b); { auto rr=__builtin_amdgcn_permlane32_swap(__float_as_uint(rm),__float_as_uint(rm),false,false); rm=__builtin_fmaxf(__uint_as_float(rr[0]),__uint_as_float(rr[1])); } \
      resc=false; \
      if(__builtin_expect(__any(rm>(float)THRL),0)){ const float dl=__builtin_fmaxf(rm,0.f); mhat+=dl; \
        _Pragma("unroll") for(int r=0;r<16;++r){C0[r]-=dl;C1[r]-=dl;} \
        const float f=__builtin_amdgcn_exp2f(-dl); l_reg*=f; if(hi==0)wsf[r32]=f; resc=true; } } \
    SBAR(); \
    GAPB(o[0]=__builtin_amdgcn_mfma_f32_32x32x16_bf16(PAF(0),VFR(0),o[0],0,0,0), C0,0); \
    GAPB(o[1]=__builtin_amdgcn_mfma_f32_32x32x16_bf16(PAF(0),VFR(4),o[1],0,0,0), C0,4); \
    KRD(GL,0); GAPB(o[0]=__builtin_amdgcn_mfma_f32_32x32x16_bf16(PAF(1),VFR(1),o[0],0,0,0), C0,8); \
    KRD(GL,1); GAPB(o[1]=__builtin_amdgcn_mfma_f32_32x32x16_bf16(PAF(1),VFR(5),o[1],0,0,0), C0,12); \
    KRD(GL,2); GAPB(o[0]=__builtin_amdgcn_mfma_f32_32x32x16_bf16(PAF(2),VFR(2),o[0],0,0,0), C1,0); \
    KRD(GL,3); GAPB(o[1]=__builtin_amdgcn_mfma_f32_32x32x16_bf16(PAF(2),VFR(6),o[1],0,0,0), C1,4); \
    GAPB(o[0]=__builtin_amdgcn_mfma_f32_32x32x16_bf16(PAF(3),VFR(3),o[0],0,0,0), C1,8); \
    GAPB(o[1]=__builtin_amdgcn_mfma_f32_32x32x16_bf16(PAF(3),VFR(7),o[1],0,0,0), C1,12); \
    }while(0)
  int t=1;
  #undef CMASK
  #define CMASK(P0,P1,t) do{ if(MODE==1){int jb_=(t)-(NT-4); if(jb_>=0)cmask(P0,P1,jb_,qrel,hi);} }while(0)
  for(;t+5<NT;t+=2){
    STEP(pB0,pB1,pA0,pA1,t,true,true,true);     WAIT_BAR(2); RESC(); ROT();
    STEP(pA0,pA1,pB0,pB1,t+1,true,true,true);   WAIT_BAR(2); RESC(); ROT();
  }
  #undef CMASK
  #define CMASK(P0,P1,t) do{ if(MODE==1){int jb_=(t)-(NT-4); if(jb_>=0)cmask(P0,P1,jb_,qrel,hi);} }while(0)
  #define ENDW(tt) do{ if((tt)+3<NT){WAIT_BAR(2);} else if((tt)+2<NT){WAIT_BAR(1);} else {WAIT_BAR(0);} }while(0)
  for(;t+1<NT;t+=2){
    STEP(pB0,pB1,pA0,pA1,t,(t+3<NT),(t+1<NT),(t+1<NT));       ENDW(t);   RESC(); ROT();
    STEP(pA0,pA1,pB0,pB1,t+1,(t+4<NT),(t+2<NT),(t+2<NT));     ENDW(t+1); RESC(); ROT();
  }
  STEP(pB0,pB1,pA0,pA1,NT-1,false,false,false); RESC();
  { float sacc=pB0[0]+pB0[1]; _Pragma("unroll") for(int r=2;r<16;++r)sacc+=pB0[r]; _Pragma("unroll") for(int r=0;r<16;++r)sacc+=pB1[r]; l_reg+=sacc;
    pw0=(u32x4){PKW(pB0,0),PKW(pB0,2),PKW(pB0,4),PKW(pB0,6)};pw1=(u32x4){PKW(pB0,8),PKW(pB0,10),PKW(pB0,12),PKW(pB0,14)};pw2=(u32x4){PKW(pB1,0),PKW(pB1,2),PKW(pB1,4),PKW(pB1,6)};pw3=(u32x4){PKW(pB1,8),PKW(pB1,10),PKW(pB1,12),PKW(pB1,14)};
    SBAR(); pv(o,vb0+sl_cur,PAF(0),PAF(1),PAF(2),PAF(3)); }
  #undef PKW
  #undef PAF
  #undef VFR
  #undef PIN
  #undef MX3
  #undef GAPA
  #undef GAPB
  #undef EX
  #undef VRD
  #undef KRD
  #undef STEP
  #undef ENDW
  bf16*Zw=Zu+(long)(wid*QBLK)*zp;
  u32x4 zq[4];
  #pragma unroll
  for(int i=0;i<4;++i)zq[i]=*(const u32x4*)(Zw+(long)(i*8+(lane>>3))*zp+(lane&7)*8);
  {auto rr=__builtin_amdgcn_permlane32_swap(__float_as_uint(l_reg),__float_as_uint(l_reg),false,false);l_reg=__uint_as_float(rr[0])+__uint_as_float(rr[1]);}
  if(hi==0)wsf[32+r32]=l_reg;asm volatile("s_waitcnt lgkmcnt(0)":::"memory");
  float rli[16];
  #pragma unroll
  for(int r=0;r<16;++r)rli[r]=__builtin_amdgcn_rcpf(wsf[32+crow(r,hi)]);
  { bf16*stg=(bf16*)(shm+LDS_OST)+wid*2048;
    #pragma unroll
    for(int r=0;r<16;++r){const int orow=crow(r,hi);
      #pragma unroll
      for(int d0=0;d0<2;++d0)stg[orow*64+d0*32+r32]=__float2bfloat16(o[d0][r]*rli[r]);}
    asm volatile("s_waitcnt lgkmcnt(0)":::"memory");
    #pragma unroll
    for(int i=0;i<4;++i){const int row=i*8+(lane>>3),ch=lane&7; const u32x4 v=*(const u32x4*)(stg+row*64+ch*8); u32x4*zpz=(u32x4*)(Zw+(long)row*zp+ch*8); const u32x4 zz=zq[i]; u32x4 yy;
      _Pragma("unroll") for(int e=0;e<4;++e){ const float o0=__uint_as_float(v[e]<<16),o1=__uint_as_float(v[e]&0xffff0000u),z0=__uint_as_float(zz[e]<<16),z1=__uint_as_float(zz[e]&0xffff0000u);
        yy[e]=cvtpk_s(o0*z0*__builtin_amdgcn_rcpf(1.f+__expf(-z0)),o1*z1*__builtin_amdgcn_rcpf(1.f+__expf(-z1))); }
      if(!dry)*zpz=yy;} }
  asm volatile("s_waitcnt lgkmcnt(0)\n\ts_barrier":::"memory");
  #undef DMA_K
  #undef DMA_V
  #undef CMASK
  #undef START
  #undef RESC
  #undef ROT
}
constexpr int ATTN_LDS_BYTES=LDS_BYTES;
#undef SBAR
#undef WAIT_BAR
}
namespace cg = cooperative_groups;
constexpr int BATCH = 8, SEQ = 4096, DM = 1024, M = BATCH * SEQ;
constexpr int NMEM = 256, MROWS = BATCH * NMEM;
constexpr int N_IN0 = 3608, N_IN0P = 3840, N_IN1 = 3584;
constexpr int NUNIT_D = BATCH * 12 * 64;
constexpr float C2 = 0.125f * 1.4426950408889634f;
constexpr float EPS = 1e-6f;
constexpr int NTHREADS = 512;
constexpr int LDS_BYTES = 161792 + 512;
constexpr size_t MiB = 1u << 20;
constexpr size_t WS_KSUM = 0;
constexpr size_t WS_GL = 512 * 1024;
constexpr size_t WS_WCAT0 = 2 * MiB;
constexpr size_t WS_WOUT0 = 12 * MiB, WS_WIN1 = 14 * MiB, WS_WOUT1 = 21 * MiB;
constexpr size_t WS_ROPE = 24 * MiB;
constexpr size_t WS_ACAT = 32 * MiB;
constexpr size_t WS_MKV = 104 * MiB;
constexpr size_t WS_QKV = 108 * MiB;
constexpr size_t WS_Z = 252 * MiB;
constexpr size_t WS_MQ = 316 * MiB;
constexpr size_t WS_BA = 332 * MiB;
constexpr size_t WS_DW = WS_ACAT;
constexpr size_t WS_DU = 336 * MiB, WS_DA = 384 * MiB;
constexpr size_t WS_PS = 432 * MiB;
constexpr size_t WS_END = 434 * MiB;

#define LAS __attribute__((address_space(3)))
typedef unsigned short bf16;
typedef unsigned v4u __attribute__((ext_vector_type(4)));
typedef unsigned v2u __attribute__((ext_vector_type(2)));
typedef float f32x4 __attribute__((ext_vector_type(4)));
typedef float f32x2v __attribute__((ext_vector_type(2)));
typedef __bf16 bf16x2v __attribute__((ext_vector_type(2)));
typedef short bf16x8 __attribute__((ext_vector_type(8)));
#define LDS_WAIT() asm volatile("s_waitcnt lgkmcnt(0)" ::: "memory")
__device__ __forceinline__ unsigned pk2(float lo, float hi) { f32x2v v = {lo, hi}; bf16x2v b = __builtin_convertvector(v, bf16x2v); return __builtin_bit_cast(unsigned, b); }
__device__ __forceinline__ float bflo(unsigned u) { return __uint_as_float(u << 16); }
__device__ __forceinline__ float bfhi(unsigned u) { return __uint_as_float(u & 0xffff0000u); }
__device__ __forceinline__ float bf1(bf16 u) { return __uint_as_float(((unsigned)u) << 16); }
__device__ __forceinline__ float dppf(float v, const int ctrl_dummy);
#define DPP_ADD(v, ctrl) ((v) + __builtin_bit_cast(float, __builtin_amdgcn_update_dpp(0, __builtin_bit_cast(int, (v)), (ctrl), 0xf, 0xf, true)))
__device__ __forceinline__ float row8_sum(float v) { v = DPP_ADD(v, 0xB1); v = DPP_ADD(v, 0x4E); v = DPP_ADD(v, 0x141); return v; }
__device__ __forceinline__ float row16_sum(float v) { v = row8_sum(v); v = DPP_ADD(v, 0x140); return v; }
__device__ __forceinline__ float wave_sum(float v) {
    v = row16_sum(v); const int vi = __builtin_bit_cast(int, v);
    return (__builtin_bit_cast(float, __builtin_amdgcn_readlane(vi, 0)) + __builtin_bit_cast(float, __builtin_amdgcn_readlane(vi, 16))) + (__builtin_bit_cast(float, __builtin_amdgcn_readlane(vi, 32)) + __builtin_bit_cast(float, __builtin_amdgcn_readlane(vi, 48)));
}
__device__ __forceinline__ float silu_f(float x) { return x * __builtin_amdgcn_rcpf(1.f + __expf(-x)); }
__device__ const float ROPE_INVF[32] = {1.000000000e+00f, 7.498942614e-01f, 5.623413324e-01f, 4.216965139e-01f, 3.162277639e-01f, 2.371373773e-01f, 1.778279394e-01f, 1.333521307e-01f, 1.000000015e-01f, 7.498941571e-02f, 5.623413250e-02f, 4.216965288e-02f, 3.162277490e-02f, 2.371373773e-02f, 1.778279431e-02f, 1.333521493e-02f, 9.999999776e-03f, 7.498941850e-03f, 5.623413250e-03f, 4.216964822e-03f, 3.162277630e-03f, 2.371373586e-03f, 1.778279431e-03f, 1.333521446e-03f, 1.000000047e-03f, 7.498942432e-04f, 5.623413017e-04f, 4.216965172e-04f, 3.162277571e-04f, 2.371373703e-04f, 1.778279402e-04f, 1.333521504e-04f};

struct OrderX {
    int nM, nN, nwg, G, c, nextra;
    __device__ void init(int nM_, int nN_, int G_, int c_, int nextra_) { nM = nM_; nN = nN_; nwg = nM * nN; G = G_; c = c_; nextra = nextra_; }
    __device__ bool next(int i, pg8::Unit& u) const {
        const long L = (long)i * G + c; if (L >= nwg + nextra) return false;
        if (L >= nwg) { const int e = (int)L - nwg, layer = e >> 4; u.pm = 128 + 8 * layer + ((e & 15) >> 1); u.pn = 15 + 2 * layer + (e & 1); return true; }
        int wgid = (int)L; { const int q = nwg / pg8::NXCD, r = nwg % pg8::NXCD, xcd = wgid % pg8::NXCD, off = wgid / pg8::NXCD; wgid = (xcd < r ? xcd * (q + 1) : r * (q + 1) + (xcd - r) * q) + off; }
        const int nig = pg8::WGM * nN, gid = wgid / nig, fm = gid * pg8::WGM, gsz = (nM - fm) < pg8::WGM ? (nM - fm) : pg8::WGM;
        u.pm = fm + ((wgid % nig) % gsz); u.pn = (wgid % nig) / gsz; return true;
    }
    __device__ __forceinline__ void a_ready(const pg8::Unit&) const {}
    __device__ __forceinline__ void done(const pg8::Unit&) const {}
};
struct EpiIn0 {
    static constexpr bool PERM = true, AFTER_DRAIN = false;
    bf16 *QKV, *Z, *MQ, *MKV; float* BA;
    __device__ __forceinline__ void operator()(const f32x4 (&acc)[2][2][4][2], const pg8::Unit& u, int wr, int wc, int fr_in, int fq_in) const {
        int fr = fr_in, fq = fq_in; asm volatile("" : "+v"(fr), "+v"(fq));
        const int pm = u.pm, pn = u.pn; bf16* base = QKV; int ld = 2304, colt = pn * 256, rowt = pm * 256; float sc = 1.f; bool isba = false;
        if (pm < 128) {
            if (pn < 9) {}
            else if (pn < 13) { base = Z; ld = 1024; colt = (pn - 9) * 256; }
            else if (pn == 13) { base = MQ; ld = 256; colt = 0; sc = C2; }
            else isba = true;
        } else { const int layer = (pm - 128) >> 3; base = MKV + (size_t)layer * (MROWS * 512); ld = 512; colt = (pn - 15 - 2 * layer) * 256; rowt = (pm - 128 - 8 * layer) * 256; }
        const int row0 = rowt + wr * 64 + fr, col0 = colt + wc * 32 + 8 * fq;
        if (!isba) {
#pragma unroll
            for (int ai = 0; ai < 2; ++ai)
#pragma unroll
                for (int m = 0; m < 4; ++m) { bf16* rowp = base + (unsigned)((row0 + ai * 128 + m * 16) * ld + col0);
#pragma unroll
                    for (int bj = 0; bj < 2; ++bj) { const f32x4 v0 = acc[ai][bj][m][0] * sc, v1 = acc[ai][bj][m][1] * sc; v4u w; w.x = pk2(v0[0], v0[1]); w.y = pk2(v0[2], v0[3]); w.z = pk2(v1[0], v1[1]); w.w = pk2(v1[2], v1[3]);
                        *(v4u*)(rowp + bj * 128) = w; } }
        } else if (wc == 0) {
#pragma unroll
            for (int ai = 0; ai < 2; ++ai)
#pragma unroll
                for (int m = 0; m < 4; ++m) { float* p = BA + (unsigned)((row0 + ai * 128 + m * 16) * 32 + 8 * fq); *(f32x4*)p = acc[ai][0][m][0]; *(f32x4*)(p + 4) = acc[ai][0][m][1]; }
        }
    }
};
struct EpiIn1 {
    static constexpr bool PERM = true, AFTER_DRAIN = false;
    bf16 *QKV, *Z, *MQ; const float* RT; float* KSUM;
    __device__ __forceinline__ void operator()(const f32x4 (&acc)[2][2][4][2], const pg8::Unit& u, int wr, int wc, int fr_in, int fq_in) const {
        int fr = fr_in, fq = fq_in, pm = u.pm, pn = u.pn; asm volatile("" : "+v"(fr), "+v"(fq), "+s"(pm), "+s"(pn));
        if (pn >= 3 && pn < 6) {
            bf16* base = QKV + (size_t)M * 768; const int colt = (pn - 3) * 256;
            const int row0 = pm * 256 + wr * 64 + fr, col0 = colt + wc * 32 + 8 * fq, i0 = (wc & 1) * 16 + 4 * fq;
#pragma unroll
            for (int bj = 0; bj < 2; ++bj) { float cs[8];
#pragma unroll
                for (int e = 0; e < 8; ++e) cs[e] = 0.f;
#pragma unroll
                for (int ai = 0; ai < 2; ++ai)
#pragma unroll
                    for (int m = 0; m < 4; ++m) { const int row = row0 + ai * 128 + m * 16;
                        const f32x4 t0 = *(const f32x4*)(RT + (unsigned)(row * 64 + 2 * i0)), t1 = *(const f32x4*)(RT + (unsigned)(row * 64 + 2 * i0 + 4));
                        const f32x4 v0 = acc[ai][bj][m][0], v1 = acc[ai][bj][m][1]; float o[8];
                        o[0] = v0[0] * t0[0] - v0[1] * t0[1]; o[1] = v0[1] * t0[0] + v0[0] * t0[1]; o[2] = v0[2] * t0[2] - v0[3] * t0[3]; o[3] = v0[3] * t0[2] + v0[2] * t0[3];
                        o[4] = v1[0] * t1[0] - v1[1] * t1[1]; o[5] = v1[1] * t1[0] + v1[0] * t1[1]; o[6] = v1[2] * t1[2] - v1[3] * t1[3]; o[7] = v1[3] * t1[2] + v1[2] * t1[3];
#pragma unroll
                        for (int e = 0; e < 8; ++e) cs[e] += o[e];
                        v4u w; w.x = pk2(o[0], o[1]); w.y = pk2(o[2], o[3]); w.z = pk2(o[4], o[5]); w.w = pk2(o[6], o[7]);
                        *(v4u*)(base + (unsigned)(row * 768 + col0 + bj * 128)) = w;
                        asm volatile("" ::: "memory"); }
#pragma unroll
                for (int e = 0; e < 8; ++e) { const float sm = row16_sum(cs[e]); if (fr == 0) atomicAdd(KSUM + (unsigned)(pm * 768 + colt + bj * 128 + wc * 32 + 8 * fq + e), sm); }
            }
        } else {
            bf16* base; int ld = 768, colt; float sc = 1.f;
            if (pn < 9) { const int t = pn / 3; base = QKV + (size_t)t * M * 768; colt = (pn - 3 * t) * 256; }
            else if (pn < 13) { base = Z; ld = 1024; colt = (pn - 9) * 256; }
            else { base = MQ; ld = 256; colt = 0; sc = C2; }
            const int row0 = pm * 256 + wr * 64 + fr, col0 = colt + wc * 32 + 8 * fq;
#pragma unroll
            for (int ai = 0; ai < 2; ++ai)
#pragma unroll
                for (int m = 0; m < 4; ++m) { bf16* rowp = base + (unsigned)((row0 + ai * 128 + m * 16) * ld + col0);
#pragma unroll
                    for (int bj = 0; bj < 2; ++bj) { const f32x4 v0 = acc[ai][bj][m][0] * sc, v1 = acc[ai][bj][m][1] * sc; v4u w; w.x = pk2(v0[0], v0[1]); w.y = pk2(v0[2], v0[3]); w.z = pk2(v1[0], v1[1]); w.w = pk2(v1[2], v1[3]);
                        *(v4u*)(rowp + bj * 128) = w; } }
        }
    }
};
__device__ __forceinline__ void p6b_rope(LAS unsigned char* lds, int G, bf16* K, const float* __restrict__ RT, float* KSUM, const int wave_s) {
    int lane_ = __builtin_amdgcn_mbcnt_hi(~0u, __builtin_amdgcn_mbcnt_lo(~0u, 0u)); asm volatile("" : "+v"(lane_)); const int tid = wave_s * 64 + lane_;
    LAS float* red = (LAS float*)lds;
    for (int u = blockIdx.x; u < 256; u += G) {
        const int pm = u >> 1, ch = u & 1;
        float cs[8];
#pragma unroll
        for (int e = 0; e < 8; ++e) cs[e] = 0.f;
        const int cc = tid % 48, rg = tid / 48, col = 384 * ch + 8 * cc, i0 = ((col & 63) >> 1);
        if (tid < 384) {
#pragma unroll 4
            for (int rr = 0; rr < 32; ++rr) { const int row = pm * 256 + rg * 32 + rr; v4u* p = (v4u*)(K + (unsigned)(row * 768 + col)); const v4u w = *p;
                const f32x4 t0 = *(const f32x4*)(RT + (unsigned)(row * 64 + 2 * i0)), t1 = *(const f32x4*)(RT + (unsigned)(row * 64 + 2 * i0 + 4)); float o[8];
                { const float a = bflo(w.x), b = bfhi(w.x); o[0] = a * t0[0] - b * t0[1]; o[1] = b * t0[0] + a * t0[1]; }
                { const float a = bflo(w.y), b = bfhi(w.y); o[2] = a * t0[2] - b * t0[3]; o[3] = b * t0[2] + a * t0[3]; }
                { const float a = bflo(w.z), b = bfhi(w.z); o[4] = a * t1[0] - b * t1[1]; o[5] = b * t1[0] + a * t1[1]; }
                { const float a = bflo(w.w), b = bfhi(w.w); o[6] = a * t1[2] - b * t1[3]; o[7] = b * t1[2] + a * t1[3]; }
#pragma unroll
                for (int e = 0; e < 8; ++e) cs[e] += o[e];
                v4u y; y.x = pk2(o[0], o[1]); y.y = pk2(o[2], o[3]); y.z = pk2(o[4], o[5]); y.w = pk2(o[6], o[7]); *p = y; }
#pragma unroll
            for (int e = 0; e < 8; ++e) red[rg * 384 + cc * 8 + e] = cs[e];
        }
        __syncthreads();
        if (tid < 384) { float s = 0.f;
#pragma unroll
            for (int g8 = 0; g8 < 8; ++g8) s += red[g8 * 384 + tid];
            KSUM[(unsigned)(pm * 768 + 384 * ch + tid)] = s; }
        __syncthreads();
    }
}
template <bool RESID_BF16> struct EpiOutB {
    static constexpr bool PERM = true, AFTER_DRAIN = false;
    const void* resid; bf16* hb;
    __device__ __forceinline__ void operator()(const f32x4 (&acc)[2][2][4][2], const pg8::Unit& u, int wr, int wc, int fr_in, int fq_in) const {
        int fr = fr_in, fq = fq_in, pm = u.pm, pn = u.pn; asm volatile("" : "+v"(fr), "+v"(fq), "+s"(pm), "+s"(pn));
        const int row0 = pm * 256 + wr * 64 + fr, col0 = pn * 256 + wc * 32 + 8 * fq;
#pragma unroll
        for (int ai = 0; ai < 2; ++ai)
#pragma unroll
            for (int m = 0; m < 4; ++m) { const unsigned off = (unsigned)((row0 + ai * 128 + m * 16) * DM + col0);
#pragma unroll
                for (int bj = 0; bj < 2; ++bj) { f32x4 r0, r1;
                    if (RESID_BF16) { const v4u rb = *(const v4u*)((const bf16*)resid + off + bj * 128); r0 = (f32x4){bflo(rb.x), bfhi(rb.x), bflo(rb.y), bfhi(rb.y)}; r1 = (f32x4){bflo(rb.z), bfhi(rb.z), bflo(rb.w), bfhi(rb.w)}; }
                    else { r0 = *(const f32x4*)((const float*)resid + off + bj * 128); r1 = *(const f32x4*)((const float*)resid + off + bj * 128 + 4); }
                    const f32x4 h0 = r0 + acc[ai][bj][m][0], h1 = r1 + acc[ai][bj][m][1]; v4u w; w.x = pk2(h0[0], h0[1]); w.y = pk2(h0[2], h0[3]); w.z = pk2(h1[0], h1[1]); w.w = pk2(h1[2], h1[3]);
                    *(v4u*)(hb + off + bj * 128) = w; } }
    }
};
struct EpiOut {
    static constexpr bool PERM = true, AFTER_DRAIN = false;
    const float* resid; float* out;
    __device__ __forceinline__ void operator()(const f32x4 (&acc)[2][2][4][2], const pg8::Unit& u, int wr, int wc, int fr_in, int fq_in) const {
        int fr = fr_in, fq = fq_in; asm volatile("" : "+v"(fr), "+v"(fq));
        const int row0 = u.pm * 256 + wr * 64 + fr, col0 = u.pn * 256 + wc * 32 + 8 * fq;
#pragma unroll
        for (int ai = 0; ai < 2; ++ai)
#pragma unroll
            for (int m = 0; m < 4; ++m) { const unsigned off = (unsigned)((row0 + ai * 128 + m * 16) * DM + col0);
#pragma unroll
                for (int bj = 0; bj < 2; ++bj) { const f32x4 r0 = *(const f32x4*)(resid + off + bj * 128), r1 = *(const f32x4*)(resid + off + bj * 128 + 4);
                    *(f32x4*)(out + off + bj * 128) = r0 + acc[ai][bj][m][0]; *(f32x4*)(out + off + bj * 128 + 4) = r1 + acc[ai][bj][m][1]; } }
    }
};
struct EpiOutN {
    static constexpr bool PERM = true, AFTER_DRAIN = false;
    const float* resid; float* out; const float* gain; bf16* XN; float* PS;
    __device__ __forceinline__ void operator()(const f32x4 (&acc)[2][2][4][2], const pg8::Unit& u, int wr, int wc, int fr_in, int fq_in) const {
        int fr = fr_in, fq = fq_in; asm volatile("" : "+v"(fr), "+v"(fq));
        const int row0 = u.pm * 256 + wr * 64 + fr, col0 = u.pn * 256 + wc * 32 + 8 * fq;
        f32x4 gv[2][2];
#pragma unroll
        for (int bj = 0; bj < 2; ++bj) { gv[bj][0] = *(const f32x4*)(gain + col0 + bj * 128); gv[bj][1] = *(const f32x4*)(gain + col0 + bj * 128 + 4); }
#pragma unroll
        for (int ai = 0; ai < 2; ++ai)
#pragma unroll
            for (int m = 0; m < 4; ++m) { const int row = row0 + ai * 128 + m * 16; const unsigned off = (unsigned)(row * DM + col0); float ss = 0.f;
#pragma unroll
                for (int bj = 0; bj < 2; ++bj) { const f32x4 r0 = *(const f32x4*)(resid + off + bj * 128), r1 = *(const f32x4*)(resid + off + bj * 128 + 4);
                    const f32x4 h0 = r0 + acc[ai][bj][m][0], h1 = r1 + acc[ai][bj][m][1];
                    *(f32x4*)(out + off + bj * 128) = h0; *(f32x4*)(out + off + bj * 128 + 4) = h1;
                    ss += (h0[0] * h0[0] + h0[1] * h0[1]) + (h0[2] * h0[2] + h0[3] * h0[3]) + (h1[0] * h1[0] + h1[1] * h1[1]) + (h1[2] * h1[2] + h1[3] * h1[3]);
                    const f32x4 y0 = h0 * gv[bj][0], y1 = h1 * gv[bj][1]; v4u w; w.x = pk2(y0[0], y0[1]); w.y = pk2(y0[2], y0[3]); w.z = pk2(y1[0], y1[1]); w.w = pk2(y1[2], y1[3]);
                    *(v4u*)(XN + off + bj * 128) = w; }
                ss += __shfl_xor(ss, 16); ss += __shfl_xor(ss, 32);
                if (fq == 0) PS[(unsigned)(row * 16 + u.pn * 4 + wc)] = ss;
                if (m & 1) asm volatile("" ::: "memory"); }
    }
};

__device__ __forceinline__ int rope_row(int n) { const int d = n & 63; return (n - d) + ((d < 32) ? 2 * d : 2 * (d - 32) + 1); }
__device__ __forceinline__ void p0_transpose_item(const float* W, int K, int N, int nblk, bf16* WT, int row_off, bool ropeperm, LAS float* scr, int item, int lane) {
    const int kb = item / nblk, nb = item % nblk, k0 = 64 * kb, n0 = 32 * nb;
    const int nn = n0 + (lane & 31);
#pragma unroll 8
    for (int i = 0; i < 32; ++i) { const int kk = 2 * i + (lane >> 5); scr[kk * 33 + (lane & 31)] = (nn < N) ? W[(size_t)(k0 + kk) * N + nn] : 0.f; }
    LDS_WAIT(); asm volatile("" ::: "memory");
    const int c = lane & 7;
#pragma unroll
    for (int j = 0; j < 4; ++j) { const int nl = (lane >> 3) + 8 * j; const LAS float* s = scr + (8 * c) * 33 + nl; int n = n0 + nl; if (ropeperm && n < 1536) n = rope_row(n);
        v4u o; o.x = pk2(s[0 * 33], s[1 * 33]); o.y = pk2(s[2 * 33], s[3 * 33]); o.z = pk2(s[4 * 33], s[5 * 33]); o.w = pk2(s[6 * 33], s[7 * 33]);
        *(v4u*)(WT + (size_t)(row_off + n) * K + k0 + 8 * c) = o; }
    LDS_WAIT(); asm volatile("" ::: "memory");
}
__device__ __forceinline__ void rms_row_to_bf16(const float* xrow, const float* g0, bf16* o0, const float* g1, bf16* o1, int lane) {
    const f32x4* xr = (const f32x4*)xrow + lane; f32x4 v[4]; float s = 0.f;
#pragma unroll
    for (int j = 0; j < 4; ++j) { v[j] = xr[64 * j]; s += (v[j].x * v[j].x + v[j].y * v[j].y) + (v[j].z * v[j].z + v[j].w * v[j].w); }
    const float rstd = rsqrtf(wave_sum(s) * (1.f / DM) + EPS);
#pragma unroll
    for (int j = 0; j < 4; ++j) { const f32x4 g = ((const f32x4*)g0)[lane + 64 * j]; const f32x4 y = v[j] * rstd * g; v2u w; w.x = pk2(y.x, y.y); w.y = pk2(y.z, y.w); ((v2u*)o0)[lane + 64 * j] = w; }
    if (g1) {
#pragma unroll
        for (int j = 0; j < 4; ++j) { const f32x4 g = ((const f32x4*)g1)[lane + 64 * j]; const f32x4 y = v[j] * rstd * g; v2u w; w.x = pk2(y.x, y.y); w.y = pk2(y.z, y.w); ((v2u*)o1)[lane + 64 * j] = w; }
    }
}

__device__ __forceinline__ void rms_row2_to_bf16(const float* xa, const float* xb, const float* g0, bf16* oa, bf16* ob, int lane) {
    const f32x4* ra = (const f32x4*)xa + lane; const f32x4* rb = (const f32x4*)xb + lane; f32x4 va[4], vb[4]; float sa = 0.f, sb = 0.f;
#pragma unroll
    for (int j = 0; j < 4; ++j) { va[j] = ra[64 * j]; vb[j] = rb[64 * j]; }
#pragma unroll
    for (int j = 0; j < 4; ++j) { sa += (va[j].x * va[j].x + va[j].y * va[j].y) + (va[j].z * va[j].z + va[j].w * va[j].w); sb += (vb[j].x * vb[j].x + vb[j].y * vb[j].y) + (vb[j].z * vb[j].z + vb[j].w * vb[j].w); }
    const float rsa = rsqrtf(wave_sum(sa) * (1.f / DM) + EPS), rsb = rsqrtf(wave_sum(sb) * (1.f / DM) + EPS);
#pragma unroll
    for (int j = 0; j < 4; ++j) { const f32x4 g = ((const f32x4*)g0)[lane + 64 * j]; const f32x4 ya = va[j] * rsa * g, yb = vb[j] * rsb * g; v2u wa, wb; wa.x = pk2(ya.x, ya.y); wa.y = pk2(ya.z, ya.w); wb.x = pk2(yb.x, yb.y); wb.y = pk2(yb.z, yb.w);
        ((v2u*)oa)[lane + 64 * j] = wa; ((v2u*)ob)[lane + 64 * j] = wb; }
}
template <bool BF16OUT> __device__ __forceinline__ void rms_row2_bf16in(const bf16* xa, const bf16* xb, const float* g0, void* oa, void* ob, int lane) {
    v2u ra[4], rb[4]; f32x4 va[4], vb[4]; float sa = 0.f, sb = 0.f;
#pragma unroll
    for (int j = 0; j < 4; ++j) { ra[j] = ((const v2u*)xa)[lane + 64 * j]; rb[j] = ((const v2u*)xb)[lane + 64 * j]; }
#pragma unroll
    for (int j = 0; j < 4; ++j) { va[j] = (f32x4){bflo(ra[j].x), bfhi(ra[j].x), bflo(ra[j].y), bfhi(ra[j].y)}; vb[j] = (f32x4){bflo(rb[j].x), bfhi(rb[j].x), bflo(rb[j].y), bfhi(rb[j].y)};
        sa += (va[j].x * va[j].x + va[j].y * va[j].y) + (va[j].z * va[j].z + va[j].w * va[j].w); sb += (vb[j].x * vb[j].x + vb[j].y * vb[j].y) + (vb[j].z * vb[j].z + vb[j].w * vb[j].w); }
    const float rsa = rsqrtf(wave_sum(sa) * (1.f / DM) + EPS), rsb = rsqrtf(wave_sum(sb) * (1.f / DM) + EPS);
#pragma unroll
    for (int j = 0; j < 4; ++j) { const f32x4 g = ((const f32x4*)g0)[lane + 64 * j]; const f32x4 ya = va[j] * rsa * g, yb = vb[j] * rsb * g;
        if (BF16OUT) { v2u wa, wb; wa.x = pk2(ya.x, ya.y); wa.y = pk2(ya.z, ya.w); wb.x = pk2(yb.x, yb.y); wb.y = pk2(yb.z, yb.w); ((v2u*)oa)[lane + 64 * j] = wa; ((v2u*)ob)[lane + 64 * j] = wb; }
        else { ((f32x4*)oa)[lane + 64 * j] = ya; ((f32x4*)ob)[lane + 64 * j] = yb; } }
}
__device__ __forceinline__ int dstperm(int k) { return (k & ~31) + 8 * ((k >> 2) & 3) + 4 * ((k >> 4) & 1) + (k & 3); }
constexpr int P2_TEAM_BYTES = 80896;
typedef short bf16x4 __attribute__((ext_vector_type(4)));
__device__ __forceinline__ bf16x4 cvt4(f32x4 v) { v2u w; w.x = pk2(v[0], v[1]); w.y = pk2(v[2], v[3]); return __builtin_bit_cast(bf16x4, w); }
#define LBAR() do { asm volatile("s_waitcnt lgkmcnt(0)" ::: "memory"); __builtin_amdgcn_s_barrier(); asm volatile("" ::: "memory"); } while (0)
__device__ __forceinline__ void p2_delta_prep(LAS unsigned char* lds, int G, const bf16* __restrict__ QKV, const float* __restrict__ BA, const float* __restrict__ conv_w, const float* __restrict__ a_log,
                                              const float* __restrict__ dt_bias, bf16* __restrict__ DQG, bf16* __restrict__ DKDT, bf16* __restrict__ DW, bf16* __restrict__ DU, bf16* __restrict__ DA, float* __restrict__ GL, const int wave_s, const int lim = 4) {
    const int team = wave_s >> 2, wt = wave_s & 3;
    LAS unsigned char* tb = lds + team * P2_TEAM_BYTES;
    LAS bf16* Qs = (LAS bf16*)tb; LAS bf16* Ks = (LAS bf16*)(tb + 9216); LAS bf16* As = (LAS bf16*)(tb + 18432);
    LAS float* RHS = (LAS float*)(tb + 27648); LAS float* Lm = (LAS float*)(tb + 60416); LAS float* gc = (LAS float*)(tb + 76800); LAS float* bt = (LAS float*)(tb + 77056); LAS float* eq = (LAS float*)(tb + 77312); LAS float* ek = (LAS float*)(tb + 77568); LAS float* CW = (LAS float*)(tb + 77824);
    const int nteams = G * 2, per = (NUNIT_D + nteams - 1) / nteams, ubase = ((int)blockIdx.x * 2 + team) * per;
    v4u raw[3][5]; float ba_b = 0.f, ba_a = 0.f;
#define P2_FETCH(uid_) do { const int bh_ = (uid_) >> 6, c_ = (uid_) & 63, b_ = bh_ / 12, h_ = bh_ - 12 * b_; const size_t r0_ = (size_t)b_ * SEQ + (size_t)c_ * 64; \
        _Pragma("unroll") for (int mtx = 0; mtx < 3; ++mtx) _Pragma("unroll") for (int r = 0; r < 5; ++r) { const int s = c_ * 64 + t0 - 3 + r; \
            raw[mtx][r] = *(const v4u*)(QKV + (r0_ + (s >= 0 ? t0 - 3 + r : 0)) * 2304 + mtx * 768 + h_ * 64 + 8 * dg); }     \
        ba_b = BA[(r0_ + lane) * 32 + h_]; ba_a = BA[(r0_ + lane) * 32 + 12 + h_]; } while (0)
    int h_prev = -1; float h_nal = 0.f, h_dtb = 0.f;
    { int lane = __builtin_amdgcn_mbcnt_hi(~0u, __builtin_amdgcn_mbcnt_lo(~0u, 0u)); asm volatile("" : "+v"(lane)); const int tt = wt * 64 + lane, dg = tt & 7, t0 = (tt >> 3) * 2; if (ubase < NUNIT_D) P2_FETCH(ubase); }
    for (int it = 0; it < per; ++it) {
        int lane = __builtin_amdgcn_mbcnt_hi(~0u, __builtin_amdgcn_mbcnt_lo(~0u, 0u)); asm volatile("" : "+v"(lane));
        const int tt = wt * 64 + lane, dg = tt & 7, t0 = (tt >> 3) * 2;
        const int rt_ = tt ^ (team << 7);
        const int uid = ubase + it; const bool act = uid < NUNIT_D;
        const int bh = uid >> 6, b = bh / 12, h = bh - 12 * b;
        if (act && h != h_prev) {
            h_nal = -__expf(a_log[h]); h_dtb = dt_bias[h];
            for (int i = tt; i < 768; i += 256) { const int mtx = i >> 8, tap = (i >> 6) & 3, dd = i & 63; CW[i] = conv_w[tap * 2304 + mtx * 768 + h * 64 + dd]; }
        }
        h_prev = h;
        LBAR();
        if (act) {
            { const float beta = __builtin_amdgcn_rcpf(1.f + __expf(-ba_b)); const float xx = ba_a + h_dtb; const float sp = xx > 20.f ? xx : log1pf(__expf(xx));
              const float g0 = h_nal * sp;
#define DPPF(src, ctrl, rm, bm) __builtin_bit_cast(float, __builtin_amdgcn_update_dpp(0, __builtin_bit_cast(int, (src)), (ctrl), (rm), (bm), false))
              float g = g0 + DPPF(g0, 0x111, 0xf, 0xf); g += DPPF(g0, 0x112, 0xf, 0xf); g += DPPF(g0, 0x113, 0xf, 0xf);
              g += DPPF(g, 0x114, 0xf, 0xe); g += DPPF(g, 0x118, 0xf, 0xc); g += DPPF(g, 0x142, 0xa, 0xf); g += DPPF(g, 0x143, 0xc, 0xf);
#undef DPPF
              const float gl_ = __builtin_bit_cast(float, __builtin_amdgcn_readlane(__builtin_bit_cast(int, g), 63));
              gc[lane] = g; bt[lane] = beta; eq[lane] = __expf(g); ek[lane] = __expf(gl_ - g); }
            { const int c_now = uid & 63;
#pragma unroll
              for (int r = 0; r < 5; ++r) if (c_now * 64 + t0 - 3 + r < 0) {
#pragma unroll
                  for (int mtx = 0; mtx < 3; ++mtx) raw[mtx][r] = (v4u){0u, 0u, 0u, 0u}; } }
            float q[2][8], k[2][8], v[2][8];
#pragma unroll
            for (int mtx = 0; mtx < 3; ++mtx) {
                f32x4 cw[4][2];
#pragma unroll
                for (int tap = 0; tap < 4; ++tap) { cw[tap][0] = *(const LAS f32x4*)(CW + mtx * 256 + tap * 64 + 8 * dg); cw[tap][1] = *(const LAS f32x4*)(CW + mtx * 256 + tap * 64 + 8 * dg + 4); }
#pragma unroll
                for (int tk = 0; tk < 2; ++tk) { float o[8];
#pragma unroll
                    for (int e = 0; e < 8; ++e) o[e] = 0.f;
#pragma unroll
                    for (int tap = 0; tap < 4; ++tap) { const v4u rw = raw[mtx][tk + tap];
                        o[0] += cw[tap][0][0] * bflo(rw.x); o[1] += cw[tap][0][1] * bfhi(rw.x); o[2] += cw[tap][0][2] * bflo(rw.y); o[3] += cw[tap][0][3] * bfhi(rw.y);
                        o[4] += cw[tap][1][0] * bflo(rw.z); o[5] += cw[tap][1][1] * bfhi(rw.z); o[6] += cw[tap][1][2] * bflo(rw.w); o[7] += cw[tap][1][3] * bfhi(rw.w); }
#pragma unroll
                    for (int e = 0; e < 8; ++e) { const float y = silu_f(o[e]); if (mtx == 0) q[tk][e] = y; else if (mtx == 1) k[tk][e] = y; else v[tk][e] = y; } }
            }
#pragma unroll
            for (int tk = 0; tk < 2; ++tk) { float sq = 0.f, sk = 0.f;
#pragma unroll
                for (int e = 0; e < 8; ++e) { sq += q[tk][e] * q[tk][e]; sk += k[tk][e] * k[tk][e]; }
                sq = row8_sum(sq); sk = row8_sum(sk); const float rq = rsqrtf(sq + EPS) * 0.125f, rk = rsqrtf(sk + EPS);
#pragma unroll
                for (int e = 0; e < 8; ++e) { q[tk][e] *= rq; k[tk][e] *= rk; } }
            LDS_WAIT();
#pragma unroll
            for (int tk = 0; tk < 2; ++tk) { const int t = t0 + tk; const float beta = bt[t], eg = eq[t] * beta;
                v4u w; w.x = pk2(q[tk][0], q[tk][1]); w.y = pk2(q[tk][2], q[tk][3]); w.z = pk2(q[tk][4], q[tk][5]); w.w = pk2(q[tk][6], q[tk][7]); *(LAS v4u*)(Qs + t * 72 + 8 * dg) = w;
                w.x = pk2(k[tk][0], k[tk][1]); w.y = pk2(k[tk][2], k[tk][3]); w.z = pk2(k[tk][4], k[tk][5]); w.w = pk2(k[tk][6], k[tk][7]); *(LAS v4u*)(Ks + t * 72 + 8 * dg) = w;
                *(LAS f32x4*)(RHS + t * 128 + 8 * dg) = (f32x4){v[tk][0] * beta, v[tk][1] * beta, v[tk][2] * beta, v[tk][3] * beta};
                *(LAS f32x4*)(RHS + t * 128 + 8 * dg + 4) = (f32x4){v[tk][4] * beta, v[tk][5] * beta, v[tk][6] * beta, v[tk][7] * beta};
                *(LAS f32x4*)(RHS + t * 128 + 64 + 8 * dg) = (f32x4){k[tk][0] * eg, k[tk][1] * eg, k[tk][2] * eg, k[tk][3] * eg};
                *(LAS f32x4*)(RHS + t * 128 + 64 + 8 * dg + 4) = (f32x4){k[tk][4] * eg, k[tk][5] * eg, k[tk][6] * eg, k[tk][7] * eg}; }
        }
        LBAR();
        if (it + 1 < per && uid + 1 < NUNIT_D) P2_FETCH(uid + 1);
        const int l15 = lane & 15, lq = lane >> 4;
        if (act && lim >= 2) {
            bf16x8 ka[2], qa[2];
#pragma unroll
            for (int ks = 0; ks < 2; ++ks) { ka[ks] = *(const LAS bf16x8*)(Ks + (16 * wt + l15) * 72 + 32 * ks + 8 * lq); qa[ks] = *(const LAS bf16x8*)(Qs + (16 * wt + l15) * 72 + 32 * ks + 8 * lq); }
            float gi[4], bi[4];
#pragma unroll
            for (int r = 0; r < 4; ++r) { gi[r] = gc[16 * wt + 4 * lq + r]; bi[r] = bt[16 * wt + 4 * lq + r]; }
#pragma unroll
            for (int ct = 0; ct < 4; ++ct) {
                const bf16x8 kb0 = *(const LAS bf16x8*)(Ks + (16 * ct + l15) * 72 + 8 * lq), kb1 = *(const LAS bf16x8*)(Ks + (16 * ct + l15) * 72 + 32 + 8 * lq);
                f32x4 kk = {0.f, 0.f, 0.f, 0.f}, qk = {0.f, 0.f, 0.f, 0.f};
                kk = __builtin_amdgcn_mfma_f32_16x16x32_bf16(ka[0], kb0, kk, 0, 0, 0); kk = __builtin_amdgcn_mfma_f32_16x16x32_bf16(ka[1], kb1, kk, 0, 0, 0);
                qk = __builtin_amdgcn_mfma_f32_16x16x32_bf16(qa[0], kb0, qk, 0, 0, 0); qk = __builtin_amdgcn_mfma_f32_16x16x32_bf16(qa[1], kb1, qk, 0, 0, 0);
                const int j = 16 * ct + l15; const float gj = gc[j];
#pragma unroll
                for (int r = 0; r < 4; ++r) { const int i = 16 * wt + 4 * lq + r; const float dec = (j <= i) ? __expf(gi[r] - gj) : 0.f;
                    Lm[i * 64 + j] = (j < i) ? bi[r] * kk[r] * dec : 0.f;
                    As[i * 72 + j] = (bf16)(pk2(qk[r] * dec, 0.f) & 0xffffu); }
            }
        }
        LBAR();
        if (act && lim >= 3) {
            if (rt_ < 64) {
                const int bb = rt_ >> 4, cc = rt_ & 15; const LAS float* Lb = Lm + (16 * bb) * 64 + 16 * bb; float t[16]; f32x4 lv[15][4];
#pragma unroll
                for (int r = 1; r < 16; ++r)
#pragma unroll
                    for (int j4 = 0; j4 < (r + 3) / 4; ++j4) lv[r - 1][j4] = *(const LAS f32x4*)(Lb + r * 64 + 4 * j4);
                __builtin_amdgcn_sched_barrier(0);
#pragma unroll
                for (int r = 0; r < 16; ++r) { float a = (r == cc) ? 1.f : 0.f;
#pragma unroll
                    for (int j4 = 0; j4 < (r + 3) / 4; ++j4) { const f32x4 l = lv[r > 0 ? r - 1 : 0][j4];
#pragma unroll
                        for (int e = 0; e < 4; ++e) if (4 * j4 + e < r) a -= l[e] * t[4 * j4 + e]; }
                    t[r] = a; }
                LDS_WAIT(); asm volatile("" ::: "memory");
#pragma unroll
                for (int r = 0; r < 16; ++r) ((LAS float*)Lb)[r * 64 + cc] = t[r];
            } else if (rt_ >= 128) {
                const int t2 = rt_ - 128, rrow = t2 >> 1, half = t2 & 1;
                { const float eg = eq[rrow]; v4u in[4], ou[4];
#pragma unroll
                  for (int i = 0; i < 4; ++i) in[i] = *(const LAS v4u*)(Qs + rrow * 72 + 32 * half + 8 * i);
                  unsigned g4[16];
#pragma unroll
                  for (int kk4 = 0; kk4 < 8; ++kk4) { const unsigned a0 = in[kk4 >> 1][(kk4 & 1) * 2], a1 = in[kk4 >> 1][(kk4 & 1) * 2 + 1]; const int p4 = 2 * (kk4 & 3) + (kk4 >> 2);
                      g4[2 * p4] = pk2(bflo(a0) * eg, bfhi(a0) * eg); g4[2 * p4 + 1] = pk2(bflo(a1) * eg, bfhi(a1) * eg); }
#pragma unroll
                  for (int i = 0; i < 4; ++i) { ou[i] = (v4u){g4[4 * i], g4[4 * i + 1], g4[4 * i + 2], g4[4 * i + 3]}; *(v4u*)(DQG + (size_t)uid * 4096 + rrow * 64 + 32 * half + 8 * i) = ou[i]; } }
                { v4u in[4], ou[4];
#pragma unroll
                  for (int i = 0; i < 4; ++i) in[i] = *(const LAS v4u*)(As + rrow * 72 + 32 * half + 8 * i);
                  unsigned g4[16];
#pragma unroll
                  for (int kk4 = 0; kk4 < 8; ++kk4) { const int p4 = 2 * (kk4 & 3) + (kk4 >> 2); g4[2 * p4] = in[kk4 >> 1][(kk4 & 1) * 2]; g4[2 * p4 + 1] = in[kk4 >> 1][(kk4 & 1) * 2 + 1]; }
#pragma unroll
                  for (int i = 0; i < 4; ++i) { ou[i] = (v4u){g4[4 * i], g4[4 * i + 1], g4[4 * i + 2], g4[4 * i + 3]}; *(v4u*)(DA + (size_t)uid * 4096 + rrow * 64 + 32 * half + 8 * i) = ou[i]; } }
                {
                  unsigned g4[16]; bf16 kv_[32]; f32x4 ev_[8];
#pragma unroll
                  for (int i = 0; i < 32; ++i) kv_[i] = Ks[(32 * half + i) * 72 + rrow];
#pragma unroll
                  for (int i = 0; i < 8; ++i) ev_[i] = *(const LAS f32x4*)(ek + 32 * half + 4 * i);
                  __builtin_amdgcn_sched_barrier(0);
#pragma unroll
                  for (int kk4 = 0; kk4 < 8; ++kk4) { const int p4 = 2 * (kk4 & 3) + (kk4 >> 2); float f[4];
#pragma unroll
                      for (int e = 0; e < 4; ++e) f[e] = bf1(kv_[4 * kk4 + e]) * ev_[kk4][e];
                      g4[2 * p4] = pk2(f[0], f[1]); g4[2 * p4 + 1] = pk2(f[2], f[3]); }
#pragma unroll
                  for (int i = 0; i < 4; ++i) *(v4u*)(DKDT + (size_t)uid * 4096 + rrow * 64 + 32 * half + 8 * i) = (v4u){g4[4 * i], g4[4 * i + 1], g4[4 * i + 2], g4[4 * i + 3]}; }
                if (t2 == 0) GL[uid] = eq[63];
            }
        }
        LBAR();
        if (act && lim >= 4) {
            f32x4 X[2][4]; bf16x4 xb[2][4]; f32x4 racc[4][2], lfr[4][4];
#pragma unroll
            for (int bb = 0; bb < 4; ++bb) {
#pragma unroll
                for (int c2 = 0; c2 < 2; ++c2)
#pragma unroll
                    for (int r = 0; r < 4; ++r) racc[bb][c2][r] = RHS[(16 * bb + 4 * lq + r) * 128 + 32 * wt + 16 * c2 + l15];
#pragma unroll
                for (int j = 0; j < 4; ++j) if (j <= bb) lfr[bb][j] = *(const LAS f32x4*)(Lm + (16 * bb + l15) * 64 + 16 * j + 4 * lq); }
            __builtin_amdgcn_sched_barrier(0);
#pragma unroll
            for (int bb = 0; bb < 4; ++bb) {
                f32x4 acc[2]; acc[0] = racc[bb][0]; acc[1] = racc[bb][1];
#pragma unroll
                for (int j = 0; j < 4; ++j) if (j < bb) { const f32x4 lv = lfr[bb][j]; const bf16x4 la = cvt4(-lv);
#pragma unroll
                    for (int c2 = 0; c2 < 2; ++c2) acc[c2] = __builtin_amdgcn_mfma_f32_16x16x16bf16_1k(la, xb[c2][j], acc[c2], 0, 0, 0); }
                const f32x4 tv = lfr[bb][bb]; const bf16x4 ta = cvt4(tv);
#pragma unroll
                for (int c2 = 0; c2 < 2; ++c2) { const bf16x4 yb = cvt4(acc[c2]); X[c2][bb] = __builtin_amdgcn_mfma_f32_16x16x16bf16_1k(ta, yb, (f32x4){0.f, 0.f, 0.f, 0.f}, 0, 0, 0); xb[c2][bb] = cvt4(X[c2][bb]); }
            }
            if (wt < 2) {
#pragma unroll
                for (int c2 = 0; c2 < 2; ++c2) { bf16* up = DU + (size_t)uid * 4096 + ((2 * wt + c2) * 64 + lane) * 16; v4u w0, w1;
                    w0.x = pk2(X[c2][0][0], X[c2][0][1]); w0.y = pk2(X[c2][0][2], X[c2][0][3]); w0.z = pk2(X[c2][1][0], X[c2][1][1]); w0.w = pk2(X[c2][1][2], X[c2][1][3]);
                    w1.x = pk2(X[c2][2][0], X[c2][2][1]); w1.y = pk2(X[c2][2][2], X[c2][2][3]); w1.z = pk2(X[c2][3][0], X[c2][3][1]); w1.w = pk2(X[c2][3][2], X[c2][3][3]);
                    *(v4u*)up = w0; *(v4u*)(up + 8) = w1; }
            } else {
#pragma unroll
                for (int c2 = 0; c2 < 2; ++c2) { bf16* wp = DW + (size_t)uid * 4096 + dstperm(32 * (wt - 2) + 16 * c2 + l15);
#pragma unroll
                    for (int bb = 0; bb < 4; ++bb)
#pragma unroll
                        for (int r = 0; r < 4; ++r) wp[(16 * bb + 4 * lq + r) * 64] = (bf16)(pk2(X[c2][bb][r], 0.f) & 0xffffu); }
            }
        }
    }
    LBAR();
#undef P2_FETCH
}

constexpr int SC_W = 0, SC_QG = 9216, SC_A = 18432, SC_KDT = 27648, SC_U = 36864, SC_STAGE = 45056, SC_O = 2 * SC_STAGE, SC_OSTRIDE = 68, SC_OBYTES = 64 * SC_OSTRIDE * 4;
__device__ __forceinline__ void p3_scan(LAS unsigned char* lds, int sq, const bf16* __restrict__ DQG, const bf16* __restrict__ DKDT, const bf16* __restrict__ DW, const bf16* __restrict__ DU, const bf16* __restrict__ DA,
                                        const float* __restrict__ GL, bf16* Z, const float* __restrict__ o_norm, const int wave_s, const bool dostore = true) {
    int lane_ = __builtin_amdgcn_mbcnt_hi(~0u, __builtin_amdgcn_mbcnt_lo(~0u, 0u)); asm volatile("" : "+v"(lane_)); const int tid = wave_s * 64 + lane_; const int wid = wave_s, lane = lane_, l15 = lane & 15, lq = lane >> 4;
    const int b = sq / 12, h = sq - 12 * b; const size_t uid0 = (size_t)sq * 64; const size_t row0 = (size_t)b * SEQ;
    const int ht = tid - 256;
#define SC_LOAD(n) do { const size_t ub = (uid0 + (n)) * 8192; \
        _Pragma("unroll") for (int i = 0; i < 2; ++i) { const int p = ht + 256 * i; \
            st[0][i] = *(const v4u*)((const char*)DW + ub + p * 16); st[1][i] = *(const v4u*)((const char*)DQG + ub + p * 16); st[2][i] = *(const v4u*)((const char*)DA + ub + p * 16); \
            st[3][i] = *(const v4u*)((const char*)DKDT + ub + p * 16); st[4][i] = *(const v4u*)((const char*)DU + ub + p * 16); } } while (0)
#define SC_STORE(s) do { LAS unsigned char* sb_ = lds + (s) * SC_STAGE; \
        _Pragma("unroll") for (int i = 0; i < 2; ++i) { const int p = ht + 256 * i; const int ro = (p >> 3) * 144 + (p & 7) * 16; \
            *(LAS v4u*)(sb_ + SC_W + ro) = st[0][i]; *(LAS v4u*)(sb_ + SC_QG + ro) = st[1][i]; *(LAS v4u*)(sb_ + SC_A + ro) = st[2][i]; *(LAS v4u*)(sb_ + SC_KDT + ro) = st[3][i]; \
            *(LAS v4u*)(sb_ + SC_U + p * 16) = st[4][i]; } } while (0)
#define SC_EPI(n) do { const int row_ = ht >> 2, sg_ = ht & 3; bf16* zp_ = Z + (row0 + (size_t)(n) * 64 + row_) * 1024 + h * 64 + sg_ * 16; \
        const v4u z0_ = *(const v4u*)zp_, z1_ = *(const v4u*)(zp_ + 8); const LAS float* op_ = (const LAS float*)(lds + SC_O + ((n) & 1) * SC_OBYTES) + row_ * SC_OSTRIDE + sg_ * 16; \
        f32x4 o_[4]; float ss_ = 0.f; \
        _Pragma("unroll") for (int i = 0; i < 4; ++i) { o_[i] = *(const LAS f32x4*)(op_ + 4 * i); ss_ += (o_[i][0] * o_[i][0] + o_[i][1] * o_[i][1]) + (o_[i][2] * o_[i][2] + o_[i][3] * o_[i][3]); } \
        ss_ = DPP_ADD(ss_, 0xB1); ss_ = DPP_ADD(ss_, 0x4E); const float rstd_ = rsqrtf(ss_ * (1.f / 64.f) + EPS); \
        v4u y0_, y1_; \
        _Pragma("unroll") for (int i = 0; i < 4; ++i) { const unsigned zz_ = (i < 2) ? z0_[2 * i] : z1_[2 * (i - 2)], zw_ = (i < 2) ? z0_[2 * i + 1] : z1_[2 * (i - 2) + 1]; \
            const unsigned a_ = pk2(o_[i][0] * rstd_ * onv[4 * i] * silu_f(bflo(zz_)), o_[i][1] * rstd_ * onv[4 * i + 1] * silu_f(bfhi(zz_))); \
            const unsigned b_ = pk2(o_[i][2] * rstd_ * onv[4 * i + 2] * silu_f(bflo(zw_)), o_[i][3] * rstd_ * onv[4 * i + 3] * silu_f(bfhi(zw_))); \
            if (i < 2) { y0_[2 * i] = a_; y0_[2 * i + 1] = b_; } else { y1_[2 * (i - 2)] = a_; y1_[2 * (i - 2) + 1] = b_; } } \
        if (dostore) { *(v4u*)zp_ = y0_; *(v4u*)(zp_ + 8) = y1_; } } while (0)
    v4u st[5][2]; float onv[16];
    if (wid >= 4) { SC_LOAD(0); SC_STORE(0); SC_LOAD(1);
#pragma unroll
        for (int i = 0; i < 16; ++i) onv[i] = o_norm[(ht & 3) * 16 + i]; }
    LBAR();
    f32x4 S[4];
#pragma unroll
    for (int i = 0; i < 4; ++i) S[i] = (f32x4){0.f, 0.f, 0.f, 0.f};
    float gl_next = GL[uid0];
    for (int n = 0; n < 64; ++n) {
        if (wid >= 4) {
            if (n + 1 < 64) { SC_STORE((n + 1) & 1); if (n + 2 < 64) SC_LOAD(n + 2); }
            if (n > 0) SC_EPI(n - 1);
        } else {
            const LAS unsigned char* sb = lds + (n & 1) * SC_STAGE; const int fo = l15 * 144 + lq * 16;
            const float gl = gl_next; gl_next = GL[uid0 + (n + 1 < 64 ? n + 1 : n)];
            bf16x8 sbv[2], vb[2];
#pragma unroll
            for (int ks = 0; ks < 2; ++ks) { v4u w; w.x = pk2(S[2 * ks][0], S[2 * ks][1]); w.y = pk2(S[2 * ks][2], S[2 * ks][3]); w.z = pk2(S[2 * ks + 1][0], S[2 * ks + 1][1]); w.w = pk2(S[2 * ks + 1][2], S[2 * ks + 1][3]); sbv[ks] = __builtin_bit_cast(bf16x8, w); }
            f32x4 vn[4];
#pragma unroll
            for (int rt = 0; rt < 4; ++rt) { f32x4 a = {0.f, 0.f, 0.f, 0.f};
#pragma unroll
                for (int ks = 0; ks < 2; ++ks) a = __builtin_amdgcn_mfma_f32_16x16x32_bf16(*(const LAS bf16x8*)(sb + SC_W + rt * 2304 + ks * 64 + fo), sbv[ks], a, 0, 0, 0);
                const v2u uu = *(const LAS v2u*)(sb + SC_U + ((wid * 64 + lane) * 16 + rt * 4) * 2);
                vn[rt] = (f32x4){bflo(uu.x), bfhi(uu.x), bflo(uu.y), bfhi(uu.y)} - a; }
#pragma unroll
            for (int ks = 0; ks < 2; ++ks) { v4u w; w.x = pk2(vn[2 * ks][0], vn[2 * ks][1]); w.y = pk2(vn[2 * ks][2], vn[2 * ks][3]); w.z = pk2(vn[2 * ks + 1][0], vn[2 * ks + 1][1]); w.w = pk2(vn[2 * ks + 1][2], vn[2 * ks + 1][3]); vb[ks] = __builtin_bit_cast(bf16x8, w); }
            LAS float* ob = (LAS float*)(lds + SC_O + (n & 1) * SC_OBYTES) + 16 * wid + l15;
#pragma unroll
            for (int rt = 0; rt < 4; ++rt) { f32x4 a = {0.f, 0.f, 0.f, 0.f};
#pragma unroll
                for (int ks = 0; ks < 2; ++ks) { a = __builtin_amdgcn_mfma_f32_16x16x32_bf16(*(const LAS bf16x8*)(sb + SC_QG + rt * 2304 + ks * 64 + fo), sbv[ks], a, 0, 0, 0);
                    a = __builtin_amdgcn_mfma_f32_16x16x32_bf16(*(const LAS bf16x8*)(sb + SC_A + rt * 2304 + ks * 64 + fo), vb[ks], a, 0, 0, 0); }
#pragma unroll
                for (int r = 0; r < 4; ++r) ob[(16 * rt + 4 * lq + r) * SC_OSTRIDE] = a[r]; }
#pragma unroll
            for (int dt = 0; dt < 4; ++dt) { f32x4 a = S[dt] * gl;
#pragma unroll
                for (int ks = 0; ks < 2; ++ks) a = __builtin_amdgcn_mfma_f32_16x16x32_bf16(*(const LAS bf16x8*)(sb + SC_KDT + dt * 2304 + ks * 64 + fo), vb[ks], a, 0, 0, 0);
                S[dt] = a; }
        }
        LBAR();
    }
    if (wid >= 4) SC_EPI(63);
    LBAR();
#undef SC_LOAD
#undef SC_STORE
#undef SC_EPI
}
constexpr int PTR_OFF = 161792;
#define GAS __attribute__((address_space(1)))
__device__ __forceinline__ GAS void* ldp(LAS unsigned char* lds, int k) {
    asm volatile("" ::: "memory");
    const LAS unsigned* t = (const LAS unsigned*)(lds + PTR_OFF) + 2 * k; unsigned lo = t[0], hi = t[1];
    lo = __builtin_amdgcn_readfirstlane(lo); hi = __builtin_amdgcn_readfirstlane(hi);
    return (GAS void*)(((unsigned long long)hi << 32) | lo);
}
#define x_ ((const float*)(GAS const float*)ldp(lds, 0))
#define mem_ ((const float*)(GAS const float*)ldp(lds, 1))
#define positions_ ((const int*)(GAS const int*)ldp(lds, 2))
#define norm_0_ ((const float*)(GAS const float*)ldp(lds, 3))
#define w_in_0_ ((const float*)(GAS const float*)ldp(lds, 4))
#define conv_w_ ((const float*)(GAS const float*)ldp(lds, 5))
#define a_log_ ((const float*)(GAS const float*)ldp(lds, 6))
#define dt_bias_ ((const float*)(GAS const float*)ldp(lds, 7))
#define o_norm_ ((const float*)(GAS const float*)ldp(lds, 8))
#define mem_norm_0_ ((const float*)(GAS const float*)ldp(lds, 9))
#define w_mkv_0_ ((const float*)(GAS const float*)ldp(lds, 10))
#define w_out_0_ ((const float*)(GAS const float*)ldp(lds, 11))
#define norm_1_ ((const float*)(GAS const float*)ldp(lds, 12))
#define w_in_1_ ((const float*)(GAS const float*)ldp(lds, 13))
#define mem_norm_1_ ((const float*)(GAS const float*)ldp(lds, 14))
#define w_mkv_1_ ((const float*)(GAS const float*)ldp(lds, 15))
#define w_out_1_ ((const float*)(GAS const float*)ldp(lds, 16))
#define final_norm_ ((const float*)(GAS const float*)ldp(lds, 17))
#define out_ ((float*)(GAS float*)ldp(lds, 18))
#define KSUM_ ((float*)(GAS float*)((GAS unsigned char*)ldp(lds, 19) + WS_KSUM))
#define GL_ ((float*)(GAS float*)((GAS unsigned char*)ldp(lds, 19) + WS_GL))
#define WCAT0_ ((bf16*)(GAS bf16*)((GAS unsigned char*)ldp(lds, 19) + WS_WCAT0))
#define WOUT0_ ((bf16*)(GAS bf16*)((GAS unsigned char*)ldp(lds, 19) + WS_WOUT0))
#define WIN1_ ((bf16*)(GAS bf16*)((GAS unsigned char*)ldp(lds, 19) + WS_WIN1))
#define WOUT1_ ((bf16*)(GAS bf16*)((GAS unsigned char*)ldp(lds, 19) + WS_WOUT1))
#define RT_ ((float*)(GAS float*)((GAS unsigned char*)ldp(lds, 19) + WS_ROPE))
#define ACAT_ ((bf16*)(GAS bf16*)((GAS unsigned char*)ldp(lds, 19) + WS_ACAT))
#define MKV_ ((bf16*)(GAS bf16*)((GAS unsigned char*)ldp(lds, 19) + WS_MKV))
#define QKV_ ((bf16*)(GAS bf16*)((GAS unsigned char*)ldp(lds, 19) + WS_QKV))
#define Zb_ ((bf16*)(GAS bf16*)((GAS unsigned char*)ldp(lds, 19) + WS_Z))
#define MQ_ ((bf16*)(GAS bf16*)((GAS unsigned char*)ldp(lds, 19) + WS_MQ))
#define BA_ ((float*)(GAS float*)((GAS unsigned char*)ldp(lds, 19) + WS_BA))
#define PS_ ((float*)(GAS float*)((GAS unsigned char*)ldp(lds, 19) + WS_PS))
#define H1B_ ((bf16*)(GAS bf16*)((GAS unsigned char*)ldp(lds, 19) + WS_DU))
#define H2B_ ((bf16*)(GAS bf16*)((GAS unsigned char*)ldp(lds, 19) + WS_ACAT))
#define DW_ ((bf16*)(GAS bf16*)((GAS unsigned char*)ldp(lds, 19) + WS_DW))
#define DU_ ((bf16*)(GAS bf16*)((GAS unsigned char*)ldp(lds, 19) + WS_DU))
#define DA_ ((bf16*)(GAS bf16*)((GAS unsigned char*)ldp(lds, 19) + WS_DA))
#define DQG_ ((bf16*)(GAS bf16*)ldp(lds, 18))
#define DKDT_ ((bf16*)((GAS bf16*)ldp(lds, 18) + (size_t)NUNIT_D * 4096))
#define Q1_ (QKV_)
#define K1_ (QKV_ + (size_t)M * 768)
#define V1_ (QKV_ + (size_t)2 * M * 768)
__device__ __forceinline__ void mem_attn_unit(int u, int layer, LAS unsigned char* lds, char* shm, const int wave_s) {
    const int qb = u & 15, hm = (u >> 4) & 3, b = u >> 6; const size_t r0 = (size_t)b * SEQ + (size_t)qb * 256;
    GAS unsigned char* ws_ = (GAS unsigned char*)ldp(lds, 19);
    const attn_body::bf16* Kh = (const attn_body::bf16*)(GAS attn_body::bf16*)(ws_ + WS_MKV) + (size_t)layer * MROWS * 512 + (size_t)b * NMEM * 512 + hm * 64;
    attn_body::attn_unit<8, 0, 256, 512, 1024>(4, (const attn_body::bf16*)(GAS attn_body::bf16*)(ws_ + WS_MQ) + r0 * 256 + hm * 64, Kh, Kh + 256,
                               (attn_body::bf16*)(GAS attn_body::bf16*)(ws_ + WS_Z) + r0 * 1024 + 768 + hm * 64, nullptr, 0, shm, wave_s);
}
__device__ __forceinline__ void moba_attn_unit(int bh, int qb, LAS unsigned char* lds, char* shm, const int wave_s, const bool dry = false) {
    const int b = bh / 12, h = bh - 12 * b; const size_t r0 = (size_t)b * SEQ + (size_t)qb * 256;
    GAS unsigned char* ws_ = (GAS unsigned char*)ldp(lds, 19);
    const attn_body::bf16* qkv_ = (const attn_body::bf16*)(GAS attn_body::bf16*)(ws_ + WS_QKV);
    attn_body::attn_unit<8, 1, 768, 768, 1024>(4 * (qb + 1), qkv_ + r0 * 768 + h * 64, qkv_ + (size_t)M * 768 + (size_t)b * SEQ * 768 + h * 64, qkv_ + (size_t)2 * M * 768 + (size_t)b * SEQ * 768 + h * 64,
                               (attn_body::bf16*)(GAS attn_body::bf16*)(ws_ + WS_Z) + r0 * 1024 + h * 64, (const float*)(GAS float*)(ws_ + WS_KSUM) + (size_t)b * 16 * 768 + h * 64, qb, shm, wave_s, dry,
                               (const float*)(GAS float*)(ws_ + WS_ROPE) + r0 * 64);
}
#define XB_TMO      128
#define XB_XCNT(j)  (256  + 64 * (j))
#define XB_XSUB(j)  (1280 + 64 * (j))
#define XB_XGEN(j)  (2304 + 64 * (j))
#define XB_TOP      3328
#define XB_TOPGEN   3392
#define XCD_BAR_WORDS 3456
#define XB_SPIN_CAP (1u << 18)

__device__ __forceinline__ unsigned xb_ld(unsigned* p)              { return __hip_atomic_load(p, __ATOMIC_RELAXED, __HIP_MEMORY_SCOPE_AGENT); }
__device__ __forceinline__ unsigned xb_add(unsigned* p, unsigned v) { return __hip_atomic_fetch_add(p, v, __ATOMIC_RELAXED, __HIP_MEMORY_SCOPE_AGENT); }
__device__ __forceinline__ unsigned xb_xcc_id() { return (unsigned)__builtin_amdgcn_s_getreg((3 << 11) | 20) & 0xFu; }
#define XB_SPIN(cond, bar) do { unsigned _sp = 0; while (cond) { __builtin_amdgcn_s_sleep(1); \
    if ((++_sp & 255u) == 0u) { if (xb_ld(&(bar)[XB_TMO])) break; if (_sp > XB_SPIN_CAP) { atomicAdd(&(bar)[XB_TMO], 1u); break; } } } } while (0)

struct XcdBarrier {
    unsigned* bar; unsigned x;
    volatile LAS unsigned* st;
};

__device__ __forceinline__ XcdBarrier xcd_barrier_post(unsigned* bar, volatile LAS unsigned* st) {
    XcdBarrier b; b.bar = bar; b.x = xb_xcc_id(); b.st = st;
    if (threadIdx.x == 0) (void)xb_add(&bar[XB_XCNT(b.x)], 1u);
    return b;
}
__device__ __forceinline__ void xcd_barrier_complete(unsigned* bar, unsigned x, unsigned& nloc, unsigned& nx) {
    const unsigned G = gridDim.x * gridDim.y * gridDim.z;
    unsigned sum, cnt, mine, sp = 0u;
    for (;;) {
        sum = 0u; cnt = 0u; mine = 0u;
#pragma unroll
        for (unsigned j = 0; j < 16; ++j) { const unsigned c = xb_ld(&bar[XB_XCNT(j)]); sum += c; cnt += (c > 0u) ? 1u : 0u; mine = (j == x) ? c : mine; }
        if (sum == G) break;
        __builtin_amdgcn_s_sleep(1);
        if ((++sp & 255u) == 0u) { if (xb_ld(&bar[XB_TMO])) break; if (sp > XB_SPIN_CAP) { atomicAdd(&bar[XB_TMO], 1u); break; } }
    }
    nloc = mine > 0u ? mine : 1u; nx = cnt > 0u ? cnt : 1u;
}

__device__ __forceinline__ void xcd_barrier(const XcdBarrier& b) {
    asm volatile("s_waitcnt vmcnt(0)" ::: "memory");
    __syncthreads();
    if (threadIdx.x == 0) {
        unsigned* bar = b.bar;
        __builtin_amdgcn_s_waitcnt(0);
        unsigned nloc = b.st[0], nx = b.st[1];
        if (nloc == 0u) { xcd_barrier_complete(bar, b.x, nloc, nx); b.st[0] = nloc; b.st[1] = nx; }
        const unsigned old = xb_add(&bar[XB_XSUB(b.x)], 1u);
        const unsigned gen = old / nloc;
        if (old + 1u == (gen + 1u) * nloc) {
            __builtin_amdgcn_fence(__ATOMIC_RELEASE, "agent");
            asm volatile("s_waitcnt vmcnt(0)" ::: "memory");
            const unsigned og = xb_add(&bar[XB_TOP], 1u);
            const unsigned tg = og / nx;
            if (og + 1u == (tg + 1u) * nx) xb_add(&bar[XB_TOPGEN], 1u);
            else XB_SPIN(xb_ld(&bar[XB_TOPGEN]) == tg, bar);
            __builtin_amdgcn_fence(__ATOMIC_ACQUIRE, "agent");
            xb_add(&bar[XB_XGEN(b.x)], 1u);
            asm volatile("s_waitcnt vmcnt(0)" ::: "memory");
        } else {
            XB_SPIN(xb_ld(&bar[XB_XGEN(b.x)]) == gen, bar);
            __builtin_amdgcn_fence(__ATOMIC_ACQUIRE, "agent");
            asm volatile("s_waitcnt vmcnt(0)" ::: "memory");
        }
    }
    __syncthreads();
}

constexpr size_t WS_BAR = 1 * MiB;
struct Args { const float* in[18]; float* out; unsigned char* ws; };
__global__ void __launch_bounds__(NTHREADS, 2) hybrid_fwd(Args args) {
    extern __shared__ __attribute__((aligned(16))) unsigned char lds_raw[];
    cg::grid_group grid = cg::this_grid();
    LAS unsigned char* lds = (LAS unsigned char*)lds_raw;
    const int G = gridDim.x, bid = blockIdx.x;
    const int wave_s = __builtin_amdgcn_readfirstlane((int)threadIdx.x >> 6);
    if (threadIdx.x < 20) { const unsigned long long pv = threadIdx.x < 18 ? (unsigned long long)args.in[threadIdx.x < 18 ? threadIdx.x : 0] : (threadIdx.x == 18 ? (unsigned long long)args.out : (unsigned long long)args.ws);
        ((LAS unsigned long long*)(lds + PTR_OFF))[threadIdx.x] = pv; }
    if (threadIdx.x == 32) { ((LAS unsigned*)(lds + PTR_OFF + 192))[0] = 0u; ((LAS unsigned*)(lds + PTR_OFF + 192))[1] = 0u; }
    __syncthreads();
    const XcdBarrier xbar = xcd_barrier_post((unsigned*)(args.ws + WS_BAR), (volatile LAS unsigned*)(lds + PTR_OFF + 192));
    const int vcu = (G % 8 == 0) ? (bid % 8) * (G / 8) + bid / 8 : bid;
    const int NGW = G * 8;
#define FRESH_IDS() int lane = __builtin_amdgcn_mbcnt_hi(~0u, __builtin_amdgcn_mbcnt_lo(~0u, 0u)); asm volatile("" : "+v"(lane)); const int wave = wave_s, tid = wave_s * 64 + lane; (void)tid; const int gw = vcu * 8 + wave; (void)lane; (void)gw

#ifndef SKIP_P0
    {
        FRESH_IDS();
        LAS float* scr = (LAS float*)(lds + wave * 16384);
        constexpr int I_IN0 = 16 * 113, I_MKV = 16 * 16, I_OUT = 16 * 32, I_IN1 = 16 * 112;
        constexpr int NITEMS = I_IN0 + 2 * I_MKV + 2 * I_OUT + I_IN1;
        for (int it = gw; it < NITEMS; it += NGW) {
            int r = it;
            if (r < I_IN0) { p0_transpose_item(w_in_0_, DM, N_IN0, 113, WCAT0_, 0, false, scr, r, lane); continue; } r -= I_IN0;
            if (r < I_MKV) { p0_transpose_item(w_mkv_0_, DM, 512, 16, WCAT0_, N_IN0P, false, scr, r, lane); continue; } r -= I_MKV;
            if (r < I_MKV) { p0_transpose_item(w_mkv_1_, DM, 512, 16, WCAT0_, N_IN0P + 512, false, scr, r, lane); continue; } r -= I_MKV;
            if (r < I_OUT) { p0_transpose_item(w_out_0_, DM, DM, 32, WOUT0_, 0, false, scr, r, lane); continue; } r -= I_OUT;
            if (r < I_OUT) { p0_transpose_item(w_out_1_, DM, DM, 32, WOUT1_, 0, false, scr, r, lane); continue; } r -= I_OUT;
            p0_transpose_item(w_in_1_, DM, N_IN1, 112, WIN1_, 0, true, scr, r, lane);
        }
        { const size_t z0 = (size_t)3616 * DM * 2, z1 = (size_t)N_IN0P * DM * 2;
          for (size_t p = z0 + ((size_t)bid * NTHREADS + tid) * 16; p < z1; p += (size_t)G * NTHREADS * 16) *(v4u*)((unsigned char*)WCAT0_ + p) = (v4u){0u, 0u, 0u, 0u}; }
        for (int i = bid * NTHREADS + tid; i < BATCH * 16 * 768; i += G * NTHREADS) KSUM_[i] = 0.f;
        { int m = gw; for (; m + NGW < M; m += 2 * NGW) rms_row2_to_bf16(x_ + (size_t)m * DM, x_ + (size_t)(m + NGW) * DM, norm_0_, ACAT_ + (size_t)m * DM, ACAT_ + (size_t)(m + NGW) * DM, lane);
          if (m < M) rms_row_to_bf16(x_ + (size_t)m * DM, norm_0_, ACAT_ + (size_t)m * DM, nullptr, nullptr, lane); }
        for (int m = gw; m < MROWS; m += NGW) rms_row_to_bf16(mem_ + (size_t)m * DM, mem_norm_0_, ACAT_ + (size_t)(M + m) * DM, mem_norm_1_, ACAT_ + (size_t)(M + MROWS + m) * DM, lane);
        for (int i = bid * NTHREADS + tid; i < M * 32; i += G * NTHREADS) { const int row = i >> 5, f = i & 31;
            const double ang = (double)positions_[row] * (double)ROPE_INVF[f]; double rv = ang * 0.15915494309189535; rv -= __builtin_rint(rv); const float rf = (float)rv;
            RT_[2 * (size_t)i] = __builtin_amdgcn_cosf(rf); RT_[2 * (size_t)i + 1] = __builtin_amdgcn_sinf(rf); }
    }
#ifdef DUP_P0
    grid.sync();
    {
        FRESH_IDS();
        LAS float* scr = (LAS float*)(lds + wave * 16384);
        constexpr int I_IN0 = 16 * 113, I_MKV = 16 * 16, I_OUT = 16 * 32, I_IN1 = 16 * 112;
        constexpr int NITEMS = I_IN0 + 2 * I_MKV + 2 * I_OUT + I_IN1;
        for (int it = gw; it < NITEMS; it += NGW) {
            int r = it;
            if (r < I_IN0) { p0_transpose_item(w_in_0_, DM, N_IN0, 113, WCAT0_, 0, false, scr, r, lane); continue; } r -= I_IN0;
            if (r < I_MKV) { p0_transpose_item(w_mkv_0_, DM, 512, 16, WCAT0_, N_IN0P, false, scr, r, lane); continue; } r -= I_MKV;
            if (r < I_MKV) { p0_transpose_item(w_mkv_1_, DM, 512, 16, WCAT0_, N_IN0P + 512, false, scr, r, lane); continue; } r -= I_MKV;
            if (r < I_OUT) { p0_transpose_item(w_out_0_, DM, DM, 32, WOUT0_, 0, false, scr, r, lane); continue; } r -= I_OUT;
            if (r < I_OUT) { p0_transpose_item(w_out_1_, DM, DM, 32, WOUT1_, 0, false, scr, r, lane); continue; } r -= I_OUT;
            p0_transpose_item(w_in_1_, DM, N_IN1, 112, WIN1_, 0, true, scr, r, lane);
        }
        { const size_t z0 = (size_t)3616 * DM * 2, z1 = (size_t)N_IN0P * DM * 2;
          for (size_t p = z0 + ((size_t)bid * NTHREADS + tid) * 16; p < z1; p += (size_t)G * NTHREADS * 16) *(v4u*)((unsigned char*)WCAT0_ + p) = (v4u){0u, 0u, 0u, 0u}; }
        for (int i = bid * NTHREADS + tid; i < BATCH * 16 * 768; i += G * NTHREADS) KSUM_[i] = 0.f;
        { int m = gw; for (; m + NGW < M; m += 2 * NGW) rms_row2_to_bf16(x_ + (size_t)m * DM, x_ + (size_t)(m + NGW) * DM, norm_0_, ACAT_ + (size_t)m * DM, ACAT_ + (size_t)(m + NGW) * DM, lane);
          if (m < M) rms_row_to_bf16(x_ + (size_t)m * DM, norm_0_, ACAT_ + (size_t)m * DM, nullptr, nullptr, lane); }
        for (int m = gw; m < MROWS; m += NGW) rms_row_to_bf16(mem_ + (size_t)m * DM, mem_norm_0_, ACAT_ + (size_t)(M + m) * DM, mem_norm_1_, ACAT_ + (size_t)(M + MROWS + m) * DM, lane);
        for (int i = bid * NTHREADS + tid; i < M * 32; i += G * NTHREADS) { const int row = i >> 5, f = i & 31;
            const double ang = (double)positions_[row] * (double)ROPE_INVF[f]; double rv = ang * 0.15915494309189535; rv -= __builtin_rint(rv); const float rf = (float)rv;
            RT_[2 * (size_t)i] = __builtin_amdgcn_cosf(rf); RT_[2 * (size_t)i + 1] = __builtin_amdgcn_sinf(rf); }
    }
#endif
#endif
    xcd_barrier(xbar);
    if (G > (1 << 24)) grid.sync();

#ifndef SKIP_P1
    {
        pg8::Gemm g{ACAT_, WCAT0_, M + 2 * MROWS, N_IN0P + 1024, DM}; OrderX S; S.init(128, 15, G, bid, 32);
        EpiIn0 E{QKV_, Zb_, MQ_, MKV_, BA_};
        pg8::gemm_phase<EpiIn0, OrderX, true, true>(lds, g, S, E, wave_s);
    }
#ifdef DUP_GEMMS
    xcd_barrier(xbar);
    {
        pg8::Gemm g{ACAT_, WCAT0_, M + 2 * MROWS, N_IN0P + 1024, DM}; OrderX S; S.init(128, 15, G, bid, 32);
        EpiIn0 E{QKV_, Zb_, MQ_, MKV_, BA_};
        pg8::gemm_phase<EpiIn0, OrderX, true, true>(lds, g, S, E, wave_s);
    }
#endif
#endif
    xcd_barrier(xbar);

#ifndef SKIP_P2
#ifdef DUP_P2
    p2_delta_prep(lds, G, QKV_, BA_, conv_w_, a_log_, dt_bias_, DQG_, DKDT_, DW_, DU_, DA_, GL_, wave_s, DUP_P2);
    xcd_barrier(xbar);
#endif
    p2_delta_prep(lds, G, QKV_, BA_, conv_w_, a_log_, dt_bias_, DQG_, DKDT_, DW_, DU_, DA_, GL_, wave_s);
#endif
    xcd_barrier(xbar);

#ifndef SKIP_P3
    {
        const int nscan = G < 96 ? G : 96;
#ifdef DUP_P3
        if (bid < nscan) { for (int sq = bid; sq < 96; sq += nscan) p3_scan(lds, sq, DQG_, DKDT_, DW_, DU_, DA_, GL_, Zb_, o_norm_, wave_s, false); }
        xcd_barrier(xbar);
#endif
        if (bid < nscan) { for (int sq = bid; sq < 96; sq += nscan) p3_scan(lds, sq, DQG_, DKDT_, DW_, DU_, DA_, GL_, Zb_, o_norm_, wave_s); }
        const int u0 = (G > 96) ? (bid >= 96 ? bid - 96 : 512) : bid, ustep = (G > 96) ? G - 96 : G;
        for (int u = u0; u < 512; u += ustep) mem_attn_unit(u, 0, lds, (char*)lds_raw, wave_s);
    }
#endif
    xcd_barrier(xbar);

#ifndef SKIP_P4
    {
        pg8::Gemm g{Zb_, WOUT0_, M, DM, DM}; OrderX S; S.init(128, 4, G, bid, 0);
        EpiOutB<false> E{x_, H1B_};
        pg8::gemm_phase<EpiOutB<false>, OrderX, true, true>(lds, g, S, E, wave_s);
    }
#ifdef DUP_GEMMS
    xcd_barrier(xbar);
    {
        pg8::Gemm g{Zb_, WOUT0_, M, DM, DM}; OrderX S; S.init(128, 4, G, bid, 0);
        EpiOutB<false> E{x_, H1B_};
        pg8::gemm_phase<EpiOutB<false>, OrderX, true, true>(lds, g, S, E, wave_s);
    }
#endif
#endif
    xcd_barrier(xbar);

#ifndef SKIP_P5
    { FRESH_IDS(); int m = gw; for (; m + NGW < M; m += 2 * NGW) rms_row2_bf16in<true>(H1B_ + (size_t)m * DM, H1B_ + (size_t)(m + NGW) * DM, norm_1_, ACAT_ + (size_t)m * DM, ACAT_ + (size_t)(m + NGW) * DM, lane);
      if (m < M) rms_row2_bf16in<true>(H1B_ + (size_t)m * DM, H1B_ + (size_t)m * DM, norm_1_, ACAT_ + (size_t)m * DM, ACAT_ + (size_t)m * DM, lane); }
#endif
    xcd_barrier(xbar);

#ifndef SKIP_P6
    {
        pg8::Gemm g{ACAT_, WIN1_, M, N_IN1, DM}; OrderX S; S.init(128, 14, G, bid, 0);
        EpiIn1 E{QKV_, Zb_, MQ_, RT_, KSUM_};
        pg8::gemm_phase<EpiIn1, OrderX, true, true>(lds, g, S, E, wave_s);
    }
#ifdef DUP_GEMMS
    xcd_barrier(xbar);
    {
        pg8::Gemm g{ACAT_, WIN1_, M, N_IN1, DM}; OrderX S; S.init(128, 14, G, bid, 0);
        EpiIn1 E{QKV_, Zb_, MQ_, RT_, KSUM_};
        pg8::gemm_phase<EpiIn1, OrderX, true, true>(lds, g, S, E, wave_s);
    }
#endif
#endif
    xcd_barrier(xbar);


#ifndef SKIP_P7
    {
        const int npair = (768 - vcu + G - 1) / G;
#ifdef DUP_P7
        for (int i = 0; i < 2 * npair; ++i) { const int p = vcu + (i >> 1) * G, bh = p >> 3, s = p & 7;
            moba_attn_unit(bh, (i & 1) ? s : 15 - s, lds, (char*)lds_raw, wave_s, true); }
        xcd_barrier(xbar);
#endif
        for (int i = 0; i < 2 * npair; ++i) { const int p = vcu + (i >> 1) * G, bh = p >> 3, s = p & 7;
            moba_attn_unit(bh, (i & 1) ? s : 15 - s, lds, (char*)lds_raw, wave_s); }
        for (int u = vcu; u < 512; u += G) mem_attn_unit(u, 1, lds, (char*)lds_raw, wave_s);
    }
#endif
    xcd_barrier(xbar);

#ifndef SKIP_P8
    {
        pg8::Gemm g{Zb_, WOUT1_, M, DM, DM}; OrderX S; S.init(128, 4, G, bid, 0);
        EpiOutB<true> E{H1B_, H2B_};
        pg8::gemm_phase<EpiOutB<true>, OrderX, true, true>(lds, g, S, E, wave_s);
    }
#endif
    xcd_barrier(xbar);

#ifdef DUP_SYNC
    for (int i_ = 0; i_ < 20; ++i_) xcd_barrier(xbar);
#endif
#ifndef SKIP_P9
    { FRESH_IDS(); int m = gw; for (; m + NGW < M; m += 2 * NGW) rms_row2_bf16in<false>(H2B_ + (size_t)m * DM, H2B_ + (size_t)(m + NGW) * DM, final_norm_, out_ + (size_t)m * DM, out_ + (size_t)(m + NGW) * DM, lane);
      if (m < M) rms_row2_bf16in<false>(H2B_ + (size_t)m * DM, H2B_ + (size_t)m * DM, final_norm_, out_ + (size_t)m * DM, out_ + (size_t)m * DM, lane); }
#endif
}

extern "C" void kernel_launch(void* const* d_in, const int* in_sizes, int n_in, void* d_out, int out_size, void* d_ws, size_t ws_size, hipStream_t stream) {
    static int grid = 0;
    if (grid == 0) {
        if (n_in != 18 || out_size != M * DM || ws_size < WS_END) { fprintf(stderr, "kernel_launch: unexpected shapes (n_in %d, out %d, ws %zu)\n", n_in, out_size, ws_size); grid = -1; return; }
        int dev = 0, cus = 0, per_cu = 0;
        hipGetDevice(&dev); hipDeviceGetAttribute(&cus, hipDeviceAttributeMultiprocessorCount, dev);
        if (hipFuncSetAttribute((const void*)hybrid_fwd, hipFuncAttributeMaxDynamicSharedMemorySize, LDS_BYTES) != hipSuccess) { fprintf(stderr, "kernel_launch: hipFuncSetAttribute failed\n"); grid = -1; return; }
        if (hipOccupancyMaxActiveBlocksPerMultiprocessor(&per_cu, (const void*)hybrid_fwd, NTHREADS, LDS_BYTES) != hipSuccess || per_cu < 1) { fprintf(stderr, "kernel_launch: occupancy query says %d\n", per_cu); per_cu = 1; }
        (void)hipGetLastError();
        grid = cus * 1;
    }
    if (grid < 0) return;
    if (hipMemsetAsync((char*)d_ws + WS_BAR, 0, 16384, stream) != hipSuccess) { fprintf(stderr, "kernel_launch: memset failed\n"); return; }
    Args a{};
    for (int i = 0; i < 18; ++i) a.in[i] = (const float*)d_in[i];
    a.out = (float*)d_out; a.ws = (unsigned char*)d_ws;
    void* kargs[] = {&a};
    hipError_t e = hipLaunchCooperativeKernel((const void*)hybrid_fwd, dim3(grid), dim3(NTHREADS), kargs, LDS_BYTES, stream);
    if (e != hipSuccess) fprintf(stderr, "kernel_launch: cooperative launch failed: %s (grid %d)\n", hipGetErrorString(e), grid);
}
```

```cpp
#include <hip/hip_runtime.h>
#include <hip/hip_cooperative_groups.h>
#include <hip/hip_bf16.h>
#include <cstdio>
#include <cstdint>
#include <cmath>
namespace pg8 {
#define PG8_LAS __attribute__((address_space(3)))
typedef unsigned short bf16_t;
typedef short bf16x8 __attribute__((ext_vector_type(8)));
typedef float f32x4 __attribute__((ext_vector_type(4)));
typedef unsigned u32x4 __attribute__((ext_vector_type(4)));
constexpr int BM = 256, BK = 64, HALF = 128, HTB = HALF * BK * 2  , STAGE_BYTES = 8 * HTB, NXCD = 8, WGM = 8;

__host__ __device__ __forceinline__ int lds_byte(int r, int c) { const int st = (r >> 4) * 2 + (c >> 5), rr = r & 15, cc = c & 31, ob = rr * 64 + cc * 2; return st * 1024 + (ob ^ (((ob >> 9) & 1) << 5)); }
__host__ __device__ __forceinline__ void stage_rc(int b, int& R, int& C) { const int st = b / 1024, sb = b % 1024, swz = sb ^ (((sb >> 9) & 1) << 5); R = (st >> 1) * 16 + swz / 64; C = (st & 1) * 32 + (swz % 64) / 2; }
__host__ __device__ __forceinline__ int perm32(int rho) { const int n = rho >> 4, i = rho & 15; return 8 * (i >> 2) + 4 * n + (i & 3); }

struct Unit { int pm, pn; };
struct Gemm { const bf16_t* A; const bf16_t* Bt; int M, N, K; };
__device__ __forceinline__ unsigned cvt_pk_bf16(float lo, float hi) { unsigned r; asm volatile("v_cvt_pk_bf16_f32 %0, %1, %2" : "=v"(r) : "v"(lo), "v"(hi)); return r; }
typedef float f32x2 __attribute__((ext_vector_type(2)));
template <class Epi, class Sched, bool ALIGN_EPI = false, bool SP2 = false>
__device__ __forceinline__ void gemm_phase(PG8_LAS unsigned char* lds, const Gemm g, const Sched& S, const Epi& E, const int wave_s) {
    int lane_ = __builtin_amdgcn_mbcnt_hi(~0u, __builtin_amdgcn_mbcnt_lo(~0u, 0u)); asm volatile("" : "+v"(lane_)); const int tid = wave_s * 64 + lane_; const int wid = wave_s, lane = tid & 63, wr = wid >> 2, wc = wid & 3, fr = lane & 15, fq = lane >> 4;
    const int K = g.K, nt = K / BK;
    unsigned voffA[2], voffB[2];
#pragma unroll
    for (int i = 0; i < 2; ++i) { int R, C; stage_rc(tid * 16 + i * 8192, R, C); const int Rb = Epi::PERM ? ((R & ~31) + perm32(R & 31)) : R;
        voffA[i] = (unsigned)(R * K + C) * 2u; voffB[i] = (unsigned)(Rb * K + C) * 2u; }
    const size_t kstep = (size_t)(BK * 2);
    const size_t hstep = (size_t)HALF * K * 2;
    const size_t tstep = 2 * hstep;
    const unsigned ldsw = (unsigned)wid * 1024u;
    const int aoff = lds_byte(wr * 64 + fr, fq * 8), boff = lds_byte(wc * 32 + fr, fq * 8);
#define PG8_SA(b, h) (((b) * 2 + (h)) * HTB)
#define PG8_SB(b, h) ((4 + (b) * 2 + (h)) * HTB)
#define PG8_STAGE(bufoff, gbase, voff) do { _Pragma("unroll") for (int _i = 0; _i < 2; ++_i) \
        __builtin_amdgcn_global_load_lds((const unsigned*)((const char*)(gbase) + (voff)[_i]), (PG8_LAS unsigned*)(lds + (bufoff) + ldsw + _i * 8192), 16, 0, 0); } while (0)
#define PG8_LDA(dst, b, h) do { _Pragma("unroll") for (int m = 0; m < 4; ++m) _Pragma("unroll") for (int k = 0; k < 2; ++k) dst[m][k] = *(const PG8_LAS bf16x8*)(lds + PG8_SA(b, h) + aoff + m * 2048 + k * 1024); } while (0)
#define PG8_LDB(dst, b, h) do { _Pragma("unroll") for (int n = 0; n < 2; ++n) _Pragma("unroll") for (int k = 0; k < 2; ++k) dst[n][k] = *(const PG8_LAS bf16x8*)(lds + PG8_SB(b, h) + boff + n * 2048 + k * 1024); } while (0)
#define PG8_MMA(ai, bj, At, Bt) do { __builtin_amdgcn_s_setprio(1); _Pragma("unroll") for (int m = 0; m < 4; ++m) _Pragma("unroll") for (int n = 0; n < 2; ++n) _Pragma("unroll") for (int k = 0; k < 2; ++k) \
        acc[ai][bj][m][n] = __builtin_amdgcn_mfma_f32_16x16x32_bf16(Bt[n][k], At[m][k], acc[ai][bj][m][n], 0, 0, 0); __builtin_amdgcn_s_setprio(0); } while (0)
#define PG8_WAIT_V(n) asm volatile("s_waitcnt vmcnt(" #n ")" ::: "memory")
#define PG8_WAIT_L(n) asm volatile("s_waitcnt lgkmcnt(" #n ")" ::: "memory")
#define PG8_BAR __builtin_amdgcn_s_barrier()
#define PG8_SCHED __builtin_amdgcn_sched_barrier(0)
    Unit cur, nxt; int ui = 0;
    if (!S.next(0, cur)) return;
    f32x4 acc[2][2][4][2];
#pragma unroll
    for (int a = 0; a < 2; ++a)
#pragma unroll
        for (int b = 0; b < 2; ++b)
#pragma unroll
            for (int m = 0; m < 4; ++m)
#pragma unroll
                for (int n = 0; n < 2; ++n) acc[a][b][m][n] = (f32x4){0.f, 0.f, 0.f, 0.f};
    bf16x8 At[4][2], B0[2][2], B1[2][2];
    const char* cA = (const char*)g.A + (size_t)cur.pm * tstep; const char* cB = (const char*)g.Bt + (size_t)cur.pn * tstep;
    S.a_ready(cur);
    if constexpr (SP2) {
        PG8_STAGE(PG8_SB(0, 0), cB, voffB); PG8_STAGE(PG8_SB(0, 1), cB + hstep, voffB); PG8_STAGE(PG8_SA(0, 0), cA, voffA); PG8_STAGE(PG8_SA(0, 1), cA + hstep, voffA);
        if (wr == 1) PG8_BAR;
        PG8_WAIT_V(2); PG8_BAR;
        PG8_STAGE(PG8_SB(1, 0), cB + kstep, voffB); PG8_STAGE(PG8_SA(1, 0), cA + kstep, voffA); PG8_STAGE(PG8_SB(1, 1), cB + hstep + kstep, voffB);
        PG8_WAIT_V(6); PG8_BAR;
    } else {
        PG8_STAGE(PG8_SB(0, 0), cB, voffB); PG8_STAGE(PG8_SA(0, 0), cA, voffA); PG8_STAGE(PG8_SB(0, 1), cB + hstep, voffB); PG8_STAGE(PG8_SA(0, 1), cA + hstep, voffA);
        if (wr == 1) PG8_BAR;
        PG8_WAIT_V(4); PG8_BAR;
        PG8_STAGE(PG8_SB(1, 0), cB + kstep, voffB); PG8_STAGE(PG8_SA(1, 0), cA + kstep, voffA); PG8_STAGE(PG8_SB(1, 1), cB + hstep + kstep, voffB);
        PG8_WAIT_V(6); PG8_BAR;
    }
    for (;;) {
        const bool has_next = S.next(ui + 1, nxt);
        const char* nA = has_next ? (const char*)g.A + (size_t)nxt.pm * tstep : cA; const char* nB = has_next ? (const char*)g.Bt + (size_t)nxt.pn * tstep : cB;
        for (int t = 0; t < nt; t += 2) {
            const bool last = (t == nt - 2);
            const char* a1 = cA + (size_t)(t + 1) * kstep;
            const char* a2 = last ? nA : cA + (size_t)(t + 2) * kstep; const char* b2 = last ? nB : cB + (size_t)(t + 2) * kstep;
            const char* a3 = a2 + kstep; const char* b3 = b2 + kstep;
            if (last && has_next) S.a_ready(nxt);
            if constexpr (SP2) {
            PG8_LDB(B0, 0, 0); PG8_LDB(B1, 0, 1); PG8_SCHED; PG8_LDA(At, 0, 0); PG8_STAGE(PG8_SA(1, 1), a1 + hstep, voffA);
            PG8_WAIT_V(8); PG8_WAIT_L(0); PG8_BAR; PG8_MMA(0, 0, At, B0); PG8_MMA(0, 1, At, B1); PG8_BAR; PG8_SCHED;
            PG8_LDA(At, 0, 1); PG8_STAGE(PG8_SB(0, 0), b2, voffB); PG8_STAGE(PG8_SB(0, 1), b2 + hstep, voffB); PG8_STAGE(PG8_SA(0, 0), a2, voffA);
            PG8_WAIT_V(8); PG8_WAIT_L(0); PG8_BAR; PG8_MMA(1, 0, At, B0); PG8_MMA(1, 1, At, B1); PG8_BAR; PG8_SCHED;
            PG8_LDB(B0, 1, 0); PG8_LDB(B1, 1, 1); PG8_SCHED; PG8_LDA(At, 1, 0); PG8_STAGE(PG8_SA(0, 1), a2 + hstep, voffA);
            PG8_WAIT_V(8); PG8_WAIT_L(0); PG8_BAR; PG8_MMA(0, 0, At, B0); PG8_MMA(0, 1, At, B1); PG8_BAR; PG8_SCHED;
            PG8_LDA(At, 1, 1); PG8_STAGE(PG8_SB(1, 0), b3, voffB); PG8_STAGE(PG8_SB(1, 1), b3 + hstep, voffB); PG8_STAGE(PG8_SA(1, 0), a3, voffA);
            PG8_WAIT_V(8); PG8_WAIT_L(0); PG8_BAR; PG8_MMA(1, 0, At, B0); PG8_MMA(1, 1, At, B1); PG8_BAR; PG8_SCHED;
            } else {
            PG8_LDB(B0, 0, 0); PG8_SCHED; PG8_LDA(At, 0, 0); PG8_STAGE(PG8_SA(1, 1), a1 + hstep, voffA);
            PG8_WAIT_L(8); PG8_BAR; PG8_WAIT_L(0); PG8_MMA(0, 0, At, B0); PG8_BAR; PG8_SCHED;
            PG8_LDB(B1, 0, 1); PG8_STAGE(PG8_SB(0, 0), b2, voffB);
            PG8_BAR; PG8_WAIT_L(0); PG8_MMA(0, 1, At, B1); PG8_BAR;
            PG8_LDA(At, 0, 1); PG8_STAGE(PG8_SA(0, 0), a2, voffA);
            PG8_BAR; PG8_WAIT_L(0); PG8_MMA(1, 0, At, B0); PG8_BAR; PG8_SCHED;
            PG8_STAGE(PG8_SB(0, 1), b2 + hstep, voffB);
            PG8_WAIT_V(6); PG8_BAR; PG8_MMA(1, 1, At, B1); PG8_BAR;
            PG8_LDB(B0, 1, 0); PG8_SCHED; PG8_LDA(At, 1, 0); PG8_STAGE(PG8_SA(0, 1), a2 + hstep, voffA);
            PG8_WAIT_L(8); PG8_BAR; PG8_WAIT_L(0); PG8_MMA(0, 0, At, B0); PG8_BAR; PG8_SCHED;
            PG8_LDB(B1, 1, 1); PG8_STAGE(PG8_SB(1, 0), b3, voffB);
            PG8_BAR; PG8_WAIT_L(0); PG8_MMA(0, 1, At, B1); PG8_BAR;
            PG8_LDA(At, 1, 1); PG8_STAGE(PG8_SA(1, 0), a3, voffA);
            PG8_BAR; PG8_WAIT_L(0); PG8_MMA(1, 0, At, B0); PG8_BAR; PG8_SCHED;
            PG8_STAGE(PG8_SB(1, 1), b3 + hstep, voffB);
            PG8_WAIT_V(6); PG8_BAR; PG8_MMA(1, 1, At, B1); PG8_BAR;
            }
        }
        if constexpr (ALIGN_EPI) { if (wr == 0) PG8_BAR; }
        if constexpr (!Epi::AFTER_DRAIN) { E(acc, cur, wr, wc, fr, fq); S.done(cur); }
        if (!has_next) break;
#pragma unroll
        for (int a = 0; a < 2; ++a)
#pragma unroll
            for (int b = 0; b < 2; ++b)
#pragma unroll
                for (int m = 0; m < 4; ++m)
#pragma unroll
                    for (int n = 0; n < 2; ++n) acc[a][b][m][n] = (f32x4){0.f, 0.f, 0.f, 0.f};
        cur = nxt; cA = nA; cB = nB; ++ui;
        if constexpr (ALIGN_EPI) { if (wr == 1) PG8_BAR; }
    }
    PG8_WAIT_V(0);
    if constexpr (!ALIGN_EPI) { if (wr == 0) PG8_BAR; }
    PG8_BAR;
    if constexpr (Epi::AFTER_DRAIN) { E.fused(acc, cur, wr, wc, fr, fq, lds, wid, lane); S.done(cur); }
#undef PG8_SA
#undef PG8_SB
#undef PG8_STAGE
#undef PG8_LDA
#undef PG8_LDB
#undef PG8_MMA
#undef PG8_WAIT_V
#undef PG8_WAIT_L
#undef PG8_BAR
#undef PG8_SCHED
}
}
namespace attn_body {
using bf16=__hip_bfloat16;
using bf16x8=__attribute__((ext_vector_type(8)))short;
using s16x4=__attribute__((ext_vector_type(4)))short;
using f32x16=__attribute__((ext_vector_type(16)))float;
using u32x4=__attribute__((ext_vector_type(4)))unsigned;
using f32x4_t=__attribute__((ext_vector_type(4)))float;
__device__ __forceinline__ float bf2f(short v){return __uint_as_float(((unsigned)(unsigned short)v)<<16);}
constexpr int D=64;
constexpr int NW=8,QBLK=32,QB=QBLK*NW,KVBLK=64;
__device__ __forceinline__ int crow(int r,int hi){return (r&3)+8*(r>>2)+4*hi;}
#define SBAR() __builtin_amdgcn_sched_barrier(0)
__device__ __forceinline__ void cmask(f32x16&p0,f32x16&p1,int jb,int qrel,int hi){
  const float NEG=-INFINITY; int kb=64*jb+4*hi;
  #pragma unroll
  for(int r=0;r<16;++r){int kv=kb+(r&3)+8*(r>>2); if(kv>qrel)p0[r]=NEG; if(kv+32>qrel)p1[r]=NEG;}
}

constexpr int NSLOT=3, SLOTB=8192;
constexpr int LDS_K=0, LDS_V=NSLOT*SLOTB, LDS_WS=2*NSLOT*SLOTB, LDS_OST=LDS_WS+NW*64*4, LDS_BYTES=LDS_OST+NW*4096;
constexpr float C2=0.125f*1.4426950408889634f;
__device__ __forceinline__ void glds16(const void*gsrc,unsigned lds_dst){unsigned keep;
  asm volatile("s_mov_b32 %0, m0\n\ts_mov_b32 m0, %2\n\ts_nop 0\n\tglobal_load_lds_dwordx4 %1, off\n\ts_mov_b32 m0, %0":"=&s"(keep):"v"(gsrc),"s"(lds_dst):"memory");}
__device__ __forceinline__ float max3f(float a,float b,float c){float r;asm("v_max3_f32 %0, %1, %2, %3":"=v"(r):"v"(a),"v"(b),"v"(c));return r;}
__device__ __forceinline__ float max2f(float a,float b){float r;asm("v_max_f32_e32 %0, %1, %2":"=v"(r):"v"(a),"v"(b));return r;}
__device__ __forceinline__ float fadd_s(float a,float b){float r;asm("v_add_f32_e32 %0, %1, %2":"=v"(r):"v"(a),"v"(b));return r;}
__device__ __forceinline__ float fsub_s(float a,float b){float r;asm("v_sub_f32_e32 %0, %1, %2":"=v"(r):"v"(a),"v"(b));return r;}
typedef float f32x2_t __attribute__((ext_vector_type(2))); typedef __bf16 bf16x2_t __attribute__((ext_vector_type(2)));
__device__ __forceinline__ unsigned cvtpk_s(float lo,float hi){f32x2_t v={lo,hi};bf16x2_t b=__builtin_convertvector(v,bf16x2_t);return __builtin_bit_cast(unsigned,b);}
#define WAIT_BAR(N) asm volatile("s_waitcnt vmcnt(" #N ") lgkmcnt(0)\n\ts_barrier":::"memory")

__device__ __forceinline__ float wave_max_f(float v){
  #define DPPMX(ctrl) v=__builtin_fmaxf(v,__builtin_bit_cast(float,__builtin_amdgcn_update_dpp(__builtin_bit_cast(int,v),__builtin_bit_cast(int,v),(ctrl),0xf,0xf,false)))
  DPPMX(0xB1); DPPMX(0x4E); DPPMX(0x141); DPPMX(0x140);
  #undef DPPMX
  const int vi=__builtin_bit_cast(int,v);
  return __builtin_fmaxf(__builtin_fmaxf(__builtin_bit_cast(float,__builtin_amdgcn_readlane(vi,0)),__builtin_bit_cast(float,__builtin_amdgcn_readlane(vi,16))),__builtin_fmaxf(__builtin_bit_cast(float,__builtin_amdgcn_readlane(vi,32)),__builtin_bit_cast(float,__builtin_amdgcn_readlane(vi,48))));
}
__device__ __forceinline__ void qkt(f32x16&p0,f32x16&p1,const char*Kslot,const bf16x8*qr,const f32x16&negm,int r32,int hi){
  const char*kb=Kslot+hi*1024+r32*16;
  #pragma unroll
  for(int d0=0;d0<4;++d0){
    const bf16x8 b0=*reinterpret_cast<const bf16x8*>(kb+d0*2048);
    const bf16x8 b1=*reinterpret_cast<const bf16x8*>(kb+d0*2048+512);
    if(d0==0){p0=__builtin_amdgcn_mfma_f32_32x32x16_bf16(b0,qr[0],negm,0,0,0);p1=__builtin_amdgcn_mfma_f32_32x32x16_bf16(b1,qr[0],negm,0,0,0);}
    else{p0=__builtin_amdgcn_mfma_f32_32x32x16_bf16(b0,qr[d0],p0,0,0,0);p1=__builtin_amdgcn_mfma_f32_32x32x16_bf16(b1,qr[d0],p1,0,0,0);}}
}
typedef __attribute__((address_space(3))) const char* lds_cptr;
typedef short v4i16_t __attribute__((ext_vector_type(4)));
__device__ __forceinline__ void kload8(bf16x8*kf,lds_cptr kp){
  kf[0]=*(const __attribute__((address_space(3))) bf16x8*)(kp);      kf[1]=*(const __attribute__((address_space(3))) bf16x8*)(kp+512);
  kf[2]=*(const __attribute__((address_space(3))) bf16x8*)(kp+2048); kf[3]=*(const __attribute__((address_space(3))) bf16x8*)(kp+2560);
  kf[4]=*(const __attribute__((address_space(3))) bf16x8*)(kp+4096); kf[5]=*(const __attribute__((address_space(3))) bf16x8*)(kp+4608);
  kf[6]=*(const __attribute__((address_space(3))) bf16x8*)(kp+6144); kf[7]=*(const __attribute__((address_space(3))) bf16x8*)(kp+6656);
}
__device__ __forceinline__ void kload2(bf16x8*kf,lds_cptr kp,int j){ kf[2*j]=*(const __attribute__((address_space(3))) bf16x8*)(kp+j*2048); kf[2*j+1]=*(const __attribute__((address_space(3))) bf16x8*)(kp+j*2048+512); }
__device__ __forceinline__ s16x4 vtr(lds_cptr p){ return __builtin_bit_cast(s16x4,__builtin_amdgcn_ds_read_tr16_b64_v4i16((__attribute__((address_space(3))) v4i16_t*)p)); }
__device__ __forceinline__ float rowmax(const f32x16&p0,const f32x16&p1){
  float a=max3f(p0[0],p0[1],p1[0]),b=max3f(p0[2],p0[3],p1[1]);a=max3f(a,p1[2],p1[3]);
  #pragma unroll
  for(int r=4;r<16;r+=4){a=max3f(a,p0[r],p0[r+1]);b=max3f(b,p0[r+2],p0[r+3]);a=max3f(a,p1[r],p1[r+1]);b=max3f(b,p1[r+2],p1[r+3]);}
  const float m=max2f(a,b);
  auto rr=__builtin_amdgcn_permlane32_swap(__float_as_uint(m),__float_as_uint(m),false,false);
  return max2f(__uint_as_float(rr[0]),__uint_as_float(rr[1]));
}
__device__ __forceinline__ void pv(f32x16*o,int vb,bf16x8 pa0,bf16x8 pa1,bf16x8 pa2,bf16x8 pa3){
  #pragma unroll
  for(int d0=0;d0<2;++d0){s16x4 lo[4],hi[4];
    #pragma unroll
    for(int ks=0;ks<4;++ks){
      asm volatile("ds_read_b64_tr_b16 %0,%1 offset:%c2":"=&v"(lo[ks]):"v"(vb),"i"(d0*4096+ks*1024):"memory");
      asm volatile("ds_read_b64_tr_b16 %0,%1 offset:%c2":"=&v"(hi[ks]):"v"(vb),"i"(d0*4096+ks*1024+512):"memory");}
    asm volatile("s_waitcnt lgkmcnt(0)":::"memory");SBAR();
    #define PK(k) (bf16x8){lo[k][0],lo[k][1],lo[k][2],lo[k][3],hi[k][0],hi[k][1],hi[k][2],hi[k][3]}
    o[d0]=__builtin_amdgcn_mfma_f32_32x32x16_bf16(pa0,PK(0),o[d0],0,0,0);
    o[d0]=__builtin_amdgcn_mfma_f32_32x32x16_bf16(pa1,PK(1),o[d0],0,0,0);
    o[d0]=__builtin_amdgcn_mfma_f32_32x32x16_bf16(pa2,PK(2),o[d0],0,0,0);
    o[d0]=__builtin_amdgcn_mfma_f32_32x32x16_bf16(pa3,PK(3),o[d0],0,0,0);
    #undef PK
  }
}

#ifndef ATTN_STORE16
#define ATTN_STORE16(p,v) (*(u32x4*)(p)=(v))
#endif
template<int THRL,int MODE,int qp,int kvp,int zp> __device__ __forceinline__ void attn_unit(int NT,const bf16*Qu,const bf16*__restrict__ Kh,const bf16*__restrict__ Vh,bf16*Zu,const float*ksum,int nsel,char*shm,const int wave_s,const bool dry=false,const float*rtq=nullptr){
  int lane=__builtin_amdgcn_mbcnt_hi(~0u,__builtin_amdgcn_mbcnt_lo(~0u,0u)); asm volatile("":"+v"(lane));   const int tid=wave_s*64+lane; (void)tid; const int r32=lane&31,hi=lane>>5; float zf=0.f; asm volatile("":"+v"(zf)); const int wid=wave_s;
  const bf16*Qw=Qu+(long)(wid*QBLK)*qp;
  const unsigned lds0=(unsigned)(uintptr_t)shm;
  float*wsf=(float*)(shm+LDS_WS)+wid*64;
  const bf16*ksrc=Kh+(long)lane*kvp+wid*8;
  const bf16*vsrc=Vh+(long)(16*(wid&3)+(lane>>2))*kvp+(wid>>2)*32+(lane&3)*8;
  const unsigned kdst=lds0+LDS_K+wid*1024, vdst=lds0+LDS_V+wid*1024;
  #define DMA_K(t,slot) glds16(ksrc+(long)(t)*KVBLK*kvp,(unsigned)__builtin_amdgcn_readfirstlane(kdst+(slot)))
  #define DMA_V(t,slot) glds16(vsrc+(long)(t)*KVBLK*kvp,(unsigned)__builtin_amdgcn_readfirstlane(vdst+(slot)))
  const int vb0=(int)(lds0+LDS_V)+((lane>>4)&1)*32+(lane&3)*8+(4*hi+((lane&15)>>2))*64;
  const char*Kbase=shm+LDS_K; bf16x8 kf[8];
  const lds_cptr shm3=(lds_cptr)shm; const lds_cptr kp0=shm3+LDS_K+hi*1024+r32*16; const lds_cptr vp0=shm3+LDS_V+((lane>>4)&1)*32+(lane&3)*8+(4*hi+((lane&15)>>2))*64;
  DMA_K(0,0);DMA_V(0,0);DMA_K(1,SLOTB);
  bf16x8 qr[4];
  #pragma unroll
  for(int d0=0;d0<4;++d0)qr[d0]=*reinterpret_cast<const bf16x8*>(&Qw[(long)r32*qp+d0*16+hi*8]);
  if(MODE==1){ const float*rp_=rtq+(long)(wid*QBLK+r32)*64+8*hi;
    _Pragma("unroll") for(int d0=0;d0<4;++d0){ const f32x4_t t0=*(const f32x4_t*)(rp_+16*d0), t1=*(const f32x4_t*)(rp_+16*d0+4);
      const float a0=bf2f(qr[d0][0]),b0=bf2f(qr[d0][1]),a1=bf2f(qr[d0][2]),b1=bf2f(qr[d0][3]),a2=bf2f(qr[d0][4]),b2=bf2f(qr[d0][5]),a3=bf2f(qr[d0][6]),b3=bf2f(qr[d0][7]);
      u32x4 w_; w_[0]=cvtpk_s((a0*t0[0]-b0*t0[1])*C2,(b0*t0[0]+a0*t0[1])*C2); w_[1]=cvtpk_s((a1*t0[2]-b1*t0[3])*C2,(b1*t0[2]+a1*t0[3])*C2);
      w_[2]=cvtpk_s((a2*t1[0]-b2*t1[1])*C2,(b2*t1[0]+a2*t1[1])*C2); w_[3]=cvtpk_s((a3*t1[2]-b3*t1[3])*C2,(b3*t1[2]+a3*t1[3])*C2); qr[d0]=__builtin_bit_cast(bf16x8,w_); } }
  unsigned selmask=0xffffffffu;
  if(MODE==1){ if(nsel>3){ float v0=-INFINITY,v1=-INFINITY,v2=-INFINITY; int i0=0,i1=0,i2=0;
      for(int j=0;j<nsel;++j){ const float*kp=ksum+(long)j*768+hi*8; float g=0.f;
        _Pragma("unroll") for(int d0=0;d0<4;++d0){ const f32x4_t ka=*(const f32x4_t*)(kp+d0*16), kb=*(const f32x4_t*)(kp+d0*16+4);
          g+=bf2f(qr[d0][0])*ka[0]+bf2f(qr[d0][1])*ka[1]+bf2f(qr[d0][2])*ka[2]+bf2f(qr[d0][3])*ka[3]+bf2f(qr[d0][4])*kb[0]+bf2f(qr[d0][5])*kb[1]+bf2f(qr[d0][6])*kb[2]+bf2f(qr[d0][7])*kb[3]; }
        { auto rr_=__builtin_amdgcn_permlane32_swap(__float_as_uint(g),__float_as_uint(g),false,false); g=__uint_as_float(rr_[0])+__uint_as_float(rr_[1]); }
        if(g>v0){v2=v1;i2=i1;v1=v0;i1=i0;v0=g;i0=j;} else if(g>v1){v2=v1;i2=i1;v1=g;i1=j;} else if(g>v2){v2=g;i2=j;} }
      selmask=(1u<<i0)|(1u<<i1)|(1u<<i2); } }
  float mhat=0.f,l_reg=0.f;f32x16 o[2];_Pragma("unroll") for(int r=0;r<16;++r){o[0][r]=zf;o[1][r]=zf;} const f32x16 negm=f32x16{};
  const int qrel=wid*QBLK+r32;
  #define CMASK(P0,P1,t) do{ if(MODE==1){int jb_=(t)-(NT-4); if(jb_>=0)cmask(P0,P1,jb_,qrel,hi);} }while(0)
  bool resc=false;
  #define START(P0,P1) do{ const float rm=rowmax(P0,P1); resc=false; \
    { const float wm_=wave_max_f(rm); const float dl=(rm==-INFINITY)?((wm_==-INFINITY)?0.f:wm_):rm; mhat=fadd_s(mhat,dl);     \
      _Pragma("unroll") for(int r=0;r<16;++r){P0[r]=fsub_s(P0[r],dl);P1[r]=fsub_s(P1[r],dl);} \
      } \
    _Pragma("unroll") for(int r=0;r<16;++r)P0[r]=__builtin_amdgcn_exp2f(P0[r]); }while(0)
  #define RESC() do{ if(resc){ asm volatile("s_waitcnt lgkmcnt(0)":::"memory"); \
      _Pragma("unroll") for(int d_=0;d_<2;++d_) _Pragma("unroll") for(int r=0;r<16;++r)o[d_][r]*=wsf[crow(r,hi)]; } }while(0)
  f32x16 pA0,pA1,pB0,pB1;
  int sl_prev=0,sl_cur=0,sl_next=SLOTB;
  #define ROT() do{sl_prev=sl_cur;sl_cur=sl_next;sl_next=(sl_next==(NSLOT-1)*SLOTB)?0:sl_next+SLOTB;}while(0)
  DMA_K(2,2*SLOTB);
  WAIT_BAR(3);
  qkt(pA0,pA1,Kbase,qr,negm,r32,hi);asm volatile("s_nop 15\n\ts_nop 7":"+v"(pA0),"+v"(pA1));CMASK(pA0,pA1,0);
  if(MODE==1){ const float ms0=(NT>4&&!(selmask&1u))?INFINITY:0.f; _Pragma("unroll") for(int r=0;r<16;++r){pA0[r]-=ms0;pA1[r]-=ms0;} }
  START(pA0,pA1);
  _Pragma("unroll") for(int r=0;r<16;++r)pA1[r]=__builtin_amdgcn_exp2f(pA1[r]);
  WAIT_BAR(0);
  DMA_K(3,0);DMA_V(1,SLOTB);
  ROT();
  kload8(kf,kp0+sl_cur);
  WAIT_BAR(2);
  s16x4 vlo[8],vhi[8]; u32x4 pw0,pw1,pw2,pw3; f32x16 cin;
  #define PKW(P,B) cvtpk_s(P[B],P[B+1])
  #define PAF(k) __builtin_bit_cast(bf16x8,pw##k)
  #define VFR(i) (bf16x8){vlo[i][0],vlo[i][1],vlo[i][2],vlo[i][3],vhi[i][0],vhi[i][1],vhi[i][2],vhi[i][3]}
  #define PIN(x) asm volatile("":"+v"(x))
  #define MX3(a,b,c) __builtin_fmaxf(__builtin_fmaxf((a),(b)),(c))
  #define GAPA(MF,A0,A1,A2,A3,W0,W1,PW) do{ MF; sacc+=A0; sacc+=A1; sacc+=A2; sacc+=A3; PIN(sacc); W0; W1; PIN(PW); SBAR(); }while(0)
  #define EX(v) __builtin_amdgcn_exp2f(v)
  #define GAPB(MF,X,B) do{ MF; X[B]=EX(X[B]); X[B+1]=EX(X[B+1]); X[B+2]=EX(X[B+2]); X[B+3]=EX(X[B+3]); PIN(X); SBAR(); }while(0)
  #define VRD(i) do{ vlo[i]=vtr(vp_+(((i)>>2)*4096+((i)&3)*1024)); vhi[i]=vtr(vp_+(((i)>>2)*4096+((i)&3)*1024+512)); }while(0)
  #define KRD(G,j) do{ if(G){ kload2(kf,kp0+sl_next,j); SBAR(); } }while(0)
  #define STEP(C0,C1,P0,P1,t,GK,GV,GL) do{ { const float cv_=(MODE==1&&(t)<NT-4&&!((selmask>>((t)>>2))&1u))?-INFINITY:-mhat; _Pragma("unroll") for(int r=0;r<16;++r)cin[r]=cv_; asm volatile("":"+v"(cin)); } SBAR(); \
    const lds_cptr vp_=vp0+sl_prev; \
    VRD(0); SBAR(); float sacc=(P0[0]+P0[1]); \
    GAPA(C0=__builtin_amdgcn_mfma_f32_32x32x16_bf16(kf[0],qr[0],cin,0,0,0), P0[2],P0[3],P0[4],P0[5],     pw0[0]=PKW(P0,0), pw0[1]=PKW(P0,2), pw0); \
    VRD(4); SBAR(); GAPA(C1=__builtin_amdgcn_mfma_f32_32x32x16_bf16(kf[1],qr[0],cin,0,0,0), P0[6],P0[7],P0[8],P0[9],     pw0[2]=PKW(P0,4), pw0[3]=PKW(P0,6), pw0); \
    VRD(1); SBAR(); GAPA(C0=__builtin_amdgcn_mfma_f32_32x32x16_bf16(kf[2],qr[1],C0,0,0,0),   P0[10],P0[11],P0[12],P0[13], pw1[0]=PKW(P0,8), pw1[1]=PKW(P0,10), pw1); \
    VRD(5); SBAR(); GAPA(C1=__builtin_amdgcn_mfma_f32_32x32x16_bf16(kf[3],qr[1],C1,0,0,0),   P0[14],P0[15],P1[0],P1[1],   pw1[2]=PKW(P0,12),pw1[3]=PKW(P0,14), pw1); \
    VRD(2); SBAR(); GAPA(C0=__builtin_amdgcn_mfma_f32_32x32x16_bf16(kf[4],qr[2],C0,0,0,0),   P1[2],P1[3],P1[4],P1[5],     pw2[0]=PKW(P1,0), pw2[1]=PKW(P1,2), pw2); \
    VRD(6); SBAR(); GAPA(C1=__builtin_amdgcn_mfma_f32_32x32x16_bf16(kf[5],qr[2],C1,0,0,0),   P1[6],P1[7],P1[8],P1[9],     pw2[2]=PKW(P1,4), pw2[3]=PKW(P1,6), pw2); \
    VRD(3); SBAR(); GAPA(C0=__builtin_amdgcn_mfma_f32_32x32x16_bf16(kf[6],qr[3],C0,0,0,0),   P1[10],P1[11],P1[12],P1[13], pw3[0]=PKW(P1,8), pw3[1]=PKW(P1,10), pw3); \
    VRD(7); SBAR(); GAPA(C1=__builtin_amdgcn_mfma_f32_32x32x16_bf16(kf[7],qr[3],C1,0,0,0),   P1[14],P1[15],0.f,0.f,       pw3[2]=PKW(P1,12),pw3[3]=PKW(P1,14), pw3); \
    l_reg+=sacc; \
    if(GK){DMA_K((t)+3,sl_cur);} if(GV){DMA_V((t)+1,sl_next);} \
    CMASK(C0,C1,t); \
    { float a=MX3(C0[0],C0[1],C1[0]),b=MX3(C0[2],C0[3],C1[1]); a=MX3(a,C1[2],C1[3]); \
      _Pragma("unroll") for(int r=4;r<16;r+=4){a=MX3(a,C0[r],C0[r+1]);b=MX3(b,C0[r+2],C0[r+3]);a=MX3(a,C1[r],C1[r+1]);b=MX3(b,C1[r+2],C1[r+3]);} \
      float rm=__builtin_fmaxf(a,b); { auto rr=__builtin_amdgcn_permlane32_swap(__float_as_uint(rm),__float_as_uint(rm),false,false); rm=__builtin_fmaxf(__uint_as_float(rr[0]),__uint_as_float(rr[1])); } \
      resc=false; \
      if(__builtin_expect(__any(rm>(float)THRL),0)){ const float dl=__builtin_fmaxf(rm,0.f); mhat+=dl; \
        _Pragma("unroll") for(int r=0;r<16;++r){C0[r]-=dl;C1[r]-=dl;} \
        const float f=__builtin_amdgcn_exp2f(-dl); l_reg*=f; if(hi==0)wsf[r32]=f; resc=true; } } \
    SBAR(); \
    GAPB(o[0]=__builtin_amdgcn_mfma_f32_32x32x16_bf16(PAF(0),VFR(0),o[0],0,0,0), C0,0); \
    GAPB(o[1]=__builtin_amdgcn_mfma_f32_32x32x16_bf16(PAF(0),VFR(4),o[1],0,0,0), C0,4); \
    KRD(GL,0); GAPB(o[0]=__builtin_amdgcn_mfma_f32_32x32x16_bf16(PAF(1),VFR(1),o[0],0,0,0), C0,8); \
    KRD(GL,1); GAPB(o[1]=__builtin_amdgcn_mfma_f32_32x32x16_bf16(PAF(1),VFR(5),o[1],0,0,0), C0,12); \
    KRD(GL,2); GAPB(o[0]=__builtin_amdgcn_mfma_f32_32x32x16_bf16(PAF(2),VFR(2),o[0],0,0,0), C1,0); \
    KRD(GL,3); GAPB(o[1]=__builtin_amdgcn_mfma_f32_32x32x16_bf16(PAF(2),VFR(6),o[1],0,0,0), C1,4); \
    GAPB(o[0]=__builtin_amdgcn_mfma_f32_32x32x16_bf16(PAF(3),VFR(3),o[0],0,0,0), C1,8); \
    GAPB(o[1]=__builtin_amdgcn_mfma_f32_32x32x16_bf16(PAF(3),VFR(7),o[1],0,0,0), C1,12); \
    }while(0)
  int t=1;
  #undef CMASK
  #define CMASK(P0,P1,t) do{ if(MODE==1){int jb_=(t)-(NT-4); if(jb_>=0)cmask(P0,P1,jb_,qrel,hi);} }while(0)
  for(;t+5<NT;t+=2){
    STEP(pB0,pB1,pA0,pA1,t,true,true,true);     WAIT_BAR(2); RESC(); ROT();
    STEP(pA0,pA1,pB0,pB1,t+1,true,true,true);   WAIT_BAR(2); RESC(); ROT();
  }
  #undef CMASK
  #define CMASK(P0,P1,t) do{ if(MODE==1){int jb_=(t)-(NT-4); if(jb_>=0)cmask(P0,P1,jb_,qrel,hi);} }while(0)
  #define ENDW(tt) do{ if((tt)+3<NT){WAIT_BAR(2);} else if((tt)+2<NT){WAIT_BAR(1);} else {WAIT_BAR(0);} }while(0)
  for(;t+1<NT;t+=2){
    STEP(pB0,pB1,pA0,pA1,t,(t+3<NT),(t+1<NT),(t+1<NT));       ENDW(t);   RESC(); ROT();
    STEP(pA0,pA1,pB0,pB1,t+1,(t+4<NT),(t+2<NT),(t+2<NT));     ENDW(t+1); RESC(); ROT();
  }
  STEP(pB0,pB1,pA0,pA1,NT-1,false,false,false); RESC();
  { float sacc=pB0[0]+pB0[1]; _Pragma("unroll") for(int r=2;r<16;++r)sacc+=pB0[r]; _Pragma("unroll") for(int r=0;r<16;++r)sacc+=pB1[r]; l_reg+=sacc;
    pw0=(u32x4){PKW(pB0,0),PKW(pB0,2),PKW(pB0,4),PKW(pB0,6)};pw1=(u32x4){PKW(pB0,8),PKW(pB0,10),PKW(pB0,12),PKW(pB0,14)};pw2=(u32x4){PKW(pB1,0),PKW(pB1,2),PKW(pB1,4),PKW(pB1,6)};pw3=(u32x4){PKW(pB1,8),PKW(pB1,10),PKW(pB1,12),PKW(pB1,14)};
    SBAR(); pv(o,vb0+sl_cur,PAF(0),PAF(1),PAF(2),PAF(3)); }
  #undef PKW
  #undef PAF
  #undef VFR
  #undef PIN
  #undef MX3
  #undef GAPA
  #undef GAPB
  #undef EX
  #undef VRD
  #undef KRD
  #undef STEP
  #undef ENDW
  bf16*Zw=Zu+(long)(wid*QBLK)*zp;
  u32x4 zq[4];
  #pragma unroll
  for(int i=0;i<4;++i)zq[i]=*(const u32x4*)(Zw+(long)(i*8+(lane>>3))*zp+(lane&7)*8);
  {auto rr=__builtin_amdgcn_permlane32_swap(__float_as_uint(l_reg),__float_as_uint(l_reg),false,false);l_reg=__uint_as_float(rr[0])+__uint_as_float(rr[1]);}
  if(hi==0)wsf[32+r32]=l_reg;asm volatile("s_waitcnt lgkmcnt(0)":::"memory");
  float rli[16];
  #pragma unroll
  for(int r=0;r<16;++r)rli[r]=__builtin_amdgcn_rcpf(wsf[32+crow(r,hi)]);
  { bf16*stg=(bf16*)(shm+LDS_OST)+wid*2048;
    #pragma unroll
    for(int r=0;r<16;++r){const int orow=crow(r,hi);
      #pragma unroll
      for(int d0=0;d0<2;++d0)stg[orow*64+d0*32+r32]=__float2bfloat16(o[d0][r]*rli[r]);}
    asm volatile("s_waitcnt lgkmcnt(0)":::"memory");
    #pragma unroll
    for(int i=0;i<4;++i){const int row=i*8+(lane>>3),ch=lane&7; const u32x4 v=*(const u32x4*)(stg+row*64+ch*8); u32x4*zpz=(u32x4*)(Zw+(long)row*zp+ch*8); const u32x4 zz=zq[i]; u32x4 yy;
      _Pragma("unroll") for(int e=0;e<4;++e){ const float o0=__uint_as_float(v[e]<<16),o1=__uint_as_float(v[e]&0xffff0000u),z0=__uint_as_float(zz[e]<<16),z1=__uint_as_float(zz[e]&0xffff0000u);
        yy[e]=cvtpk_s(o0*z0*__builtin_amdgcn_rcpf(1.f+__expf(-z0)),o1*z1*__builtin_amdgcn_rcpf(1.f+__expf(-z1))); }
      if(!dry)*zpz=yy;} }
  asm volatile("s_waitcnt lgkmcnt(0)\n\ts_barrier":::"memory");
  #undef DMA_K
  #undef DMA_V
  #undef CMASK
  #undef START
  #undef RESC
  #undef ROT
}
constexpr int ATTN_LDS_BYTES=LDS_BYTES;
#undef SBAR
#undef WAIT_BAR
}
namespace cg = cooperative_groups;
constexpr int BATCH = 8, SEQ = 4096, DM = 1024, M = BATCH * SEQ;
constexpr int NMEM = 256, MROWS = BATCH * NMEM;
constexpr int N_IN0 = 3608, N_IN0P = 3840, N_IN1 = 3584;
constexpr int NUNIT_D = BATCH * 12 * 64;
constexpr float C2 = 0.125f * 1.4426950408889634f;
constexpr float EPS = 1e-6f;
constexpr int NTHREADS = 512;
constexpr int LDS_BYTES = 161792 + 512;
constexpr size_t MiB = 1u << 20;
constexpr size_t WS_KSUM = 0;
constexpr size_t WS_GL = 512 * 1024;
constexpr size_t WS_WCAT0 = 2 * MiB;
constexpr size_t WS_WOUT0 = 12 * MiB, WS_WIN1 = 14 * MiB, WS_WOUT1 = 21 * MiB;
constexpr size_t WS_ROPE = 24 * MiB;
constexpr size_t WS_ACAT = 32 * MiB;
constexpr size_t WS_MKV = 104 * MiB;
constexpr size_t WS_QKV = 108 * MiB;
constexpr size_t WS_Z = 252 * MiB;
constexpr size_t WS_MQ = 316 * MiB;
constexpr size_t WS_BA = 332 * MiB;
constexpr size_t WS_DW = WS_ACAT;
constexpr size_t WS_DU = 336 * MiB, WS_DA = 384 * MiB;
constexpr size_t WS_PS = 432 * MiB;
constexpr size_t WS_END = 434 * MiB;

#define LAS __attribute__((address_space(3)))
typedef unsigned short bf16;
typedef unsigned v4u __attribute__((ext_vector_type(4)));
typedef unsigned v2u __attribute__((ext_vector_type(2)));
typedef float f32x4 __attribute__((ext_vector_type(4)));
typedef float f32x2v __attribute__((ext_vector_type(2)));
typedef __bf16 bf16x2v __attribute__((ext_vector_type(2)));
typedef short bf16x8 __attribute__((ext_vector_type(8)));
#define LDS_WAIT() asm volatile("s_waitcnt lgkmcnt(0)" ::: "memory")
__device__ __forceinline__ unsigned pk2(float lo, float hi) { f32x2v v = {lo, hi}; bf16x2v b = __builtin_convertvector(v, bf16x2v); return __builtin_bit_cast(unsigned, b); }
__device__ __forceinline__ float bflo(unsigned u) { return __uint_as_float(u << 16); }
__device__ __forceinline__ float bfhi(unsigned u) { return __uint_as_float(u & 0xffff0000u); }
__device__ __forceinline__ float bf1(bf16 u) { return __uint_as_float(((unsigned)u) << 16); }
__device__ __forceinline__ float dppf(float v, const int ctrl_dummy);
#define DPP_ADD(v, ctrl) ((v) + __builtin_bit_cast(float, __builtin_amdgcn_update_dpp(0, __builtin_bit_cast(int, (v)), (ctrl), 0xf, 0xf, true)))
__device__ __forceinline__ float row8_sum(float v) { v = DPP_ADD(v, 0xB1); v = DPP_ADD(v, 0x4E); v = DPP_ADD(v, 0x141); return v; }
__device__ __forceinline__ float row16_sum(float v) { v = row8_sum(v); v = DPP_ADD(v, 0x140); return v; }
__device__ __forceinline__ float wave_sum(float v) {
    v = row16_sum(v); const int vi = __builtin_bit_cast(int, v);
    return (__builtin_bit_cast(float, __builtin_amdgcn_readlane(vi, 0)) + __builtin_bit_cast(float, __builtin_amdgcn_readlane(vi, 16))) + (__builtin_bit_cast(float, __builtin_amdgcn_readlane(vi, 32)) + __builtin_bit_cast(float, __builtin_amdgcn_readlane(vi, 48)));
}
__device__ __forceinline__ float silu_f(float x) { return x * __builtin_amdgcn_rcpf(1.f + __expf(-x)); }
__device__ const float ROPE_INVF[32] = {1.000000000e+00f, 7.498942614e-01f, 5.623413324e-01f, 4.216965139e-01f, 3.162277639e-01f, 2.371373773e-01f, 1.778279394e-01f, 1.333521307e-01f, 1.000000015e-01f, 7.498941571e-02f, 5.623413250e-02f, 4.216965288e-02f, 3.162277490e-02f, 2.371373773e-02f, 1.778279431e-02f, 1.333521493e-02f, 9.999999776e-03f, 7.498941850e-03f, 5.623413250e-03f, 4.216964822e-03f, 3.162277630e-03f, 2.371373586e-03f, 1.778279431e-03f, 1.333521446e-03f, 1.000000047e-03f, 7.498942432e-04f, 5.623413017e-04f, 4.216965172e-04f, 3.162277571e-04f, 2.371373703e-04f, 1.778279402e-04f, 1.333521504e-04f};

struct OrderX {
    int nM, nN, nwg, G, c, nextra;
    __device__ void init(int nM_, int nN_, int G_, int c_, int nextra_) { nM = nM_; nN = nN_; nwg = nM * nN; G = G_; c = c_; nextra = nextra_; }
    __device__ bool next(int i, pg8::Unit& u) const {
        const long L = (long)i * G + c; if (L >= nwg + nextra) return false;
        if (L >= nwg) { const int e = (int)L - nwg, layer = e >> 4; u.pm = 128 + 8 * layer + ((e & 15) >> 1); u.pn = 15 + 2 * layer + (e & 1); return true; }
        int wgid = (int)L; { const int q = nwg / pg8::NXCD, r = nwg % pg8::NXCD, xcd = wgid % pg8::NXCD, off = wgid / pg8::NXCD; wgid = (xcd < r ? xcd * (q + 1) : r * (q + 1) + (xcd - r) * q) + off; }
        const int nig = pg8::WGM * nN, gid = wgid / nig, fm = gid * pg8::WGM, gsz = (nM - fm) < pg8::WGM ? (nM - fm) : pg8::WGM;
        u.pm = fm + ((wgid % nig) % gsz); u.pn = (wgid % nig) / gsz; return true;
    }
    __device__ __forceinline__ void a_ready(const pg8::Unit&) const {}
    __device__ __forceinline__ void done(const pg8::Unit&) const {}
};
struct EpiIn0 {
    static constexpr bool PERM = true, AFTER_DRAIN = false;
    bf16 *QKV, *Z, *MQ, *MKV; float* BA;
    __device__ __forceinline__ void operator()(const f32x4 (&acc)[2][2][4][2], const pg8::Unit& u, int wr, int wc, int fr_in, int fq_in) const {
        int fr = fr_in, fq = fq_in; asm volatile("" : "+v"(fr), "+v"(fq));
        const int pm = u.pm, pn = u.pn; bf16* base = QKV; int ld = 2304, colt = pn * 256, rowt = pm * 256; float sc = 1.f; bool isba = false;
        if (pm < 128) {
            if (pn < 9) {}
            else if (pn < 13) { base = Z; ld = 1024; colt = (pn - 9) * 256; }
            else if (pn == 13) { base = MQ; ld = 256; colt = 0; sc = C2; }
            else isba = true;
        } else { const int layer = (pm - 128) >> 3; base = MKV + (size_t)layer * (MROWS * 512); ld = 512; colt = (pn - 15 - 2 * layer) * 256; rowt = (pm - 128 - 8 * layer) * 256; }
        const int row0 = rowt + wr * 64 + fr, col0 = colt + wc * 32 + 8 * fq;
        if (!isba) {
#pragma unroll
            for (int ai = 0; ai < 2; ++ai)
#pragma unroll
                for (int m = 0; m < 4; ++m) { bf16* rowp = base + (unsigned)((row0 + ai * 128 + m * 16) * ld + col0);
#pragma unroll
                    for (int bj = 0; bj < 2; ++bj) { const f32x4 v0 = acc[ai][bj][m][0] * sc, v1 = acc[ai][bj][m][1] * sc; v4u w; w.x = pk2(v0[0], v0[1]); w.y = pk2(v0[2], v0[3]); w.z = pk2(v1[0], v1[1]); w.w = pk2(v1[2], v1[3]);
                        *(v4u*)(rowp + bj * 128) = w; } }
        } else if (wc == 0) {
#pragma unroll
            for (int ai = 0; ai < 2; ++ai)
#pragma unroll
                for (int m = 0; m < 4; ++m) { float* p = BA + (unsigned)((row0 + ai * 128 + m * 16) * 32 + 8 * fq); *(f32x4*)p = acc[ai][0][m][0]; *(f32x4*)(p + 4) = acc[ai][0][m][1]; }
        }
    }
};
__device__ __forceinline__ float row_rstd(const float* PS, int row) {
    const f32x4 p = *(const f32x4*)(PS + (unsigned)(row * 4));
    return rsqrtf(((p[0] + p[1]) + (p[2] + p[3])) * (1.f / DM) + EPS);
}
struct EpiIn1 {
    static constexpr bool PERM = true, AFTER_DRAIN = false;
    bf16 *QKV, *Z, *MQ; const float* RT; float* KSUM; const float* PS;
    __device__ __forceinline__ void operator()(const f32x4 (&acc)[2][2][4][2], const pg8::Unit& u, int wr, int wc, int fr_in, int fq_in) const {
        int fr = fr_in, fq = fq_in, pm = u.pm, pn = u.pn; asm volatile("" : "+v"(fr), "+v"(fq), "+s"(pm), "+s"(pn));
        float rsr[2][4];
#pragma unroll
        for (int ai = 0; ai < 2; ++ai)
#pragma unroll
            for (int m = 0; m < 4; ++m) rsr[ai][m] = row_rstd(PS, pm * 256 + wr * 64 + fr + ai * 128 + m * 16);
        if (pn >= 3 && pn < 6) {
            bf16* base = QKV + (size_t)M * 768; const int colt = (pn - 3) * 256;
            const int row0 = pm * 256 + wr * 64 + fr, col0 = colt + wc * 32 + 8 * fq, i0 = (wc & 1) * 16 + 4 * fq;
#pragma unroll
            for (int bj = 0; bj < 2; ++bj) { float cs[8];
#pragma unroll
                for (int e = 0; e < 8; ++e) cs[e] = 0.f;
#pragma unroll
                for (int ai = 0; ai < 2; ++ai)
#pragma unroll
                    for (int m = 0; m < 4; ++m) { const int row = row0 + ai * 128 + m * 16;
                        const f32x4 t0 = *(const f32x4*)(RT + (unsigned)(row * 64 + 2 * i0)), t1 = *(const f32x4*)(RT + (unsigned)(row * 64 + 2 * i0 + 4));
                        const float rs = rsr[ai][m];
                        const f32x4 v0 = acc[ai][bj][m][0] * rs, v1 = acc[ai][bj][m][1] * rs; float o[8];
                        o[0] = v0[0] * t0[0] - v0[1] * t0[1]; o[1] = v0[1] * t0[0] + v0[0] * t0[1]; o[2] = v0[2] * t0[2] - v0[3] * t0[3]; o[3] = v0[3] * t0[2] + v0[2] * t0[3];
                        o[4] = v1[0] * t1[0] - v1[1] * t1[1]; o[5] = v1[1] * t1[0] + v1[0] * t1[1]; o[6] = v1[2] * t1[2] - v1[3] * t1[3]; o[7] = v1[3] * t1[2] + v1[2] * t1[3];
#pragma unroll
                        for (int e = 0; e < 8; ++e) cs[e] += o[e];
                        v4u w; w.x = pk2(o[0], o[1]); w.y = pk2(o[2], o[3]); w.z = pk2(o[4], o[5]); w.w = pk2(o[6], o[7]);
                        *(v4u*)(base + (unsigned)(row * 768 + col0 + bj * 128)) = w;
                        asm volatile("" ::: "memory"); }
#pragma unroll
                for (int e = 0; e < 8; ++e) { const float sm = row16_sum(cs[e]); if (fr == 0) atomicAdd(KSUM + (unsigned)(pm * 768 + colt + bj * 128 + wc * 32 + 8 * fq + e), sm); }
            }
        } else {
            bf16* base; int ld = 768, colt; float sc = 1.f;
            if (pn < 9) { const int t = pn / 3; base = QKV + (size_t)t * M * 768; colt = (pn - 3 * t) * 256; }
            else if (pn < 13) { base = Z; ld = 1024; colt = (pn - 9) * 256; }
            else { base = MQ; ld = 256; colt = 0; sc = C2; }
            const int row0 = pm * 256 + wr * 64 + fr, col0 = colt + wc * 32 + 8 * fq;
#pragma unroll
            for (int ai = 0; ai < 2; ++ai)
#pragma unroll
                for (int m = 0; m < 4; ++m) { const int row = row0 + ai * 128 + m * 16; bf16* rowp = base + (unsigned)(row * ld + col0); const float rs = rsr[ai][m] * sc;
#pragma unroll
                    for (int bj = 0; bj < 2; ++bj) { const f32x4 v0 = acc[ai][bj][m][0] * rs, v1 = acc[ai][bj][m][1] * rs; v4u w; w.x = pk2(v0[0], v0[1]); w.y = pk2(v0[2], v0[3]); w.z = pk2(v1[0], v1[1]); w.w = pk2(v1[2], v1[3]);
                        *(v4u*)(rowp + bj * 128) = w; }
                    if (m & 1) asm volatile("" ::: "memory"); }
        }
    }
};
__device__ __forceinline__ void p6b_rope(LAS unsigned char* lds, int G, bf16* K, const float* __restrict__ RT, float* KSUM, const int wave_s) {
    int lane_ = __builtin_amdgcn_mbcnt_hi(~0u, __builtin_amdgcn_mbcnt_lo(~0u, 0u)); asm volatile("" : "+v"(lane_)); const int tid = wave_s * 64 + lane_;
    LAS float* red = (LAS float*)lds;
    for (int u = blockIdx.x; u < 256; u += G) {
        const int pm = u >> 1, ch = u & 1;
        float cs[8];
#pragma unroll
        for (int e = 0; e < 8; ++e) cs[e] = 0.f;
        const int cc = tid % 48, rg = tid / 48, col = 384 * ch + 8 * cc, i0 = ((col & 63) >> 1);
        if (tid < 384) {
#pragma unroll 4
            for (int rr = 0; rr < 32; ++rr) { const int row = pm * 256 + rg * 32 + rr; v4u* p = (v4u*)(K + (unsigned)(row * 768 + col)); const v4u w = *p;
                const f32x4 t0 = *(const f32x4*)(RT + (unsigned)(row * 64 + 2 * i0)), t1 = *(const f32x4*)(RT + (unsigned)(row * 64 + 2 * i0 + 4)); float o[8];
                { const float a = bflo(w.x), b = bfhi(w.x); o[0] = a * t0[0] - b * t0[1]; o[1] = b * t0[0] + a * t0[1]; }
                { const float a = bflo(w.y), b = bfhi(w.y); o[2] = a * t0[2] - b * t0[3]; o[3] = b * t0[2] + a * t0[3]; }
                { const float a = bflo(w.z), b = bfhi(w.z); o[4] = a * t1[0] - b * t1[1]; o[5] = b * t1[0] + a * t1[1]; }
                { const float a = bflo(w.w), b = bfhi(w.w); o[6] = a * t1[2] - b * t1[3]; o[7] = b * t1[2] + a * t1[3]; }
#pragma unroll
                for (int e = 0; e < 8; ++e) cs[e] += o[e];
                v4u y; y.x = pk2(o[0], o[1]); y.y = pk2(o[2], o[3]); y.z = pk2(o[4], o[5]); y.w = pk2(o[6], o[7]); *p = y; }
#pragma unroll
            for (int e = 0; e < 8; ++e) red[rg * 384 + cc * 8 + e] = cs[e];
        }
        __syncthreads();
        if (tid < 384) { float s = 0.f;
#pragma unroll
            for (int g8 = 0; g8 < 8; ++g8) s += red[g8 * 384 + tid];
            KSUM[(unsigned)(pm * 768 + 384 * ch + tid)] = s; }
        __syncthreads();
    }
}
struct EpiOutG {
    static constexpr bool PERM = true, AFTER_DRAIN = false;
    const float* resid; const float* gain; bf16* XN; float* PS; LAS float* xl;
    __device__ __forceinline__ void operator()(const f32x4 (&acc)[2][2][4][2], const pg8::Unit& u, int wr, int wc_in, int fr_in, int fq_in) const {
        int fr = fr_in, fq = fq_in, wc = wc_in, pm = u.pm, pn = u.pn; asm volatile("" : "+v"(fr), "+v"(fq), "+s"(pm), "+s"(pn), "+s"(wc));
        const int row0 = pm * 256 + wr * 64 + fr, col0 = pn * 256 + wc * 32 + 8 * fq;
        f32x4 gv[2][2];
#pragma unroll
        for (int bj = 0; bj < 2; ++bj) { gv[bj][0] = *(const f32x4*)(gain + col0 + bj * 128); gv[bj][1] = *(const f32x4*)(gain + col0 + bj * 128 + 4); }
#pragma unroll
        for (int ai = 0; ai < 2; ++ai)
#pragma unroll
            for (int m = 0; m < 4; ++m) { const int row = row0 + ai * 128 + m * 16; const unsigned off = (unsigned)(row * DM + col0); float ss = 0.f;
#pragma unroll
                for (int bj = 0; bj < 2; ++bj) { const f32x4 r0 = *(const f32x4*)(resid + off + bj * 128), r1 = *(const f32x4*)(resid + off + bj * 128 + 4);
                    const f32x4 h0 = r0 + acc[ai][bj][m][0], h1 = r1 + acc[ai][bj][m][1];
                    ss += ((h0[0] * h0[0] + h0[1] * h0[1]) + (h0[2] * h0[2] + h0[3] * h0[3])) + ((h1[0] * h1[0] + h1[1] * h1[1]) + (h1[2] * h1[2] + h1[3] * h1[3]));
                    const f32x4 y0 = h0 * gv[bj][0], y1 = h1 * gv[bj][1]; v4u w; w.x = pk2(y0[0], y0[1]); w.y = pk2(y0[2], y0[3]); w.z = pk2(y1[0], y1[1]); w.w = pk2(y1[2], y1[3]);
                    *(v4u*)(XN + off + bj * 128) = w; }
                ss += __shfl_xor(ss, 16); ss += __shfl_xor(ss, 32);
                if (fq == 0) xl[(wr * 4 + wc) * 128 + ai * 64 + m * 16 + fr] = ss;
                if (m & 1) asm volatile("" ::: "memory"); }
        asm volatile("s_waitcnt lgkmcnt(0)\n\ts_barrier" ::: "memory");
        { const int ln = fq * 16 + fr; if (ln < 32) { const int rsl = wc * 32 + ln;
              const float tot = (xl[(wr * 4 + 0) * 128 + rsl] + xl[(wr * 4 + 1) * 128 + rsl]) + (xl[(wr * 4 + 2) * 128 + rsl] + xl[(wr * 4 + 3) * 128 + rsl]);
              const int row = pm * 256 + (rsl >> 6) * 128 + wr * 64 + (rsl & 63); PS[(unsigned)(row * 4 + pn)] = tot; } }
        asm volatile("s_waitcnt lgkmcnt(0)\n\ts_barrier" ::: "memory");
    }
};
struct EpiOutR {
    static constexpr bool PERM = true, AFTER_DRAIN = false;
    const bf16* XN; const float* gain; bf16* hb;
    __device__ __forceinline__ void operator()(const f32x4 (&acc)[2][2][4][2], const pg8::Unit& u, int wr, int wc, int fr_in, int fq_in) const {
        int fr = fr_in, fq = fq_in, pm = u.pm, pn = u.pn; asm volatile("" : "+v"(fr), "+v"(fq), "+s"(pm), "+s"(pn));
        const int row0 = pm * 256 + wr * 64 + fr, col0 = pn * 256 + wc * 32 + 8 * fq;
        f32x4 gi[2][2];
#pragma unroll
        for (int bj = 0; bj < 2; ++bj)
#pragma unroll
            for (int t = 0; t < 2; ++t) { const f32x4 g = *(const f32x4*)(gain + col0 + bj * 128 + 4 * t); gi[bj][t] = (f32x4){__builtin_amdgcn_rcpf(g[0]), __builtin_amdgcn_rcpf(g[1]), __builtin_amdgcn_rcpf(g[2]), __builtin_amdgcn_rcpf(g[3])}; }
#pragma unroll
        for (int ai = 0; ai < 2; ++ai)
#pragma unroll
            for (int m = 0; m < 4; ++m) { const unsigned off = (unsigned)((row0 + ai * 128 + m * 16) * DM + col0);
#pragma unroll
                for (int bj = 0; bj < 2; ++bj) { const v4u rb = *(const v4u*)(XN + off + bj * 128);
                    const f32x4 r0 = (f32x4){bflo(rb.x), bfhi(rb.x), bflo(rb.y), bfhi(rb.y)} * gi[bj][0], r1 = (f32x4){bflo(rb.z), bfhi(rb.z), bflo(rb.w), bfhi(rb.w)} * gi[bj][1];
                    const f32x4 h0 = r0 + acc[ai][bj][m][0], h1 = r1 + acc[ai][bj][m][1]; v4u w; w.x = pk2(h0[0], h0[1]); w.y = pk2(h0[2], h0[3]); w.z = pk2(h1[0], h1[1]); w.w = pk2(h1[2], h1[3]);
                    *(v4u*)(hb + off + bj * 128) = w; } }
    }
};
template <bool RESID_BF16> struct EpiOutB {
    static constexpr bool PERM = true, AFTER_DRAIN = false;
    const void* resid; bf16* hb;
    __device__ __forceinline__ void operator()(const f32x4 (&acc)[2][2][4][2], const pg8::Unit& u, int wr, int wc, int fr_in, int fq_in) const {
        int fr = fr_in, fq = fq_in, pm = u.pm, pn = u.pn; asm volatile("" : "+v"(fr), "+v"(fq), "+s"(pm), "+s"(pn));
        const int row0 = pm * 256 + wr * 64 + fr, col0 = pn * 256 + wc * 32 + 8 * fq;
#pragma unroll
        for (int ai = 0; ai < 2; ++ai)
#pragma unroll
            for (int m = 0; m < 4; ++m) { const unsigned off = (unsigned)((row0 + ai * 128 + m * 16) * DM + col0);
#pragma unroll
                for (int bj = 0; bj < 2; ++bj) { f32x4 r0, r1;
                    if (RESID_BF16) { const v4u rb = *(const v4u*)((const bf16*)resid + off + bj * 128); r0 = (f32x4){bflo(rb.x), bfhi(rb.x), bflo(rb.y), bfhi(rb.y)}; r1 = (f32x4){bflo(rb.z), bfhi(rb.z), bflo(rb.w), bfhi(rb.w)}; }
                    else { r0 = *(const f32x4*)((const float*)resid + off + bj * 128); r1 = *(const f32x4*)((const float*)resid + off + bj * 128 + 4); }
                    const f32x4 h0 = r0 + acc[ai][bj][m][0], h1 = r1 + acc[ai][bj][m][1]; v4u w; w.x = pk2(h0[0], h0[1]); w.y = pk2(h0[2], h0[3]); w.z = pk2(h1[0], h1[1]); w.w = pk2(h1[2], h1[3]);
                    *(v4u*)(hb + off + bj * 128) = w; } }
    }
};
struct EpiOut {
    static constexpr bool PERM = true, AFTER_DRAIN = false;
    const float* resid; float* out;
    __device__ __forceinline__ void operator()(const f32x4 (&acc)[2][2][4][2], const pg8::Unit& u, int wr, int wc, int fr_in, int fq_in) const {
        int fr = fr_in, fq = fq_in; asm volatile("" : "+v"(fr), "+v"(fq));
        const int row0 = u.pm * 256 + wr * 64 + fr, col0 = u.pn * 256 + wc * 32 + 8 * fq;
#pragma unroll
        for (int ai = 0; ai < 2; ++ai)
#pragma unroll
            for (int m = 0; m < 4; ++m) { const unsigned off = (unsigned)((row0 + ai * 128 + m * 16) * DM + col0);
#pragma unroll
                for (int bj = 0; bj < 2; ++bj) { const f32x4 r0 = *(const f32x4*)(resid + off + bj * 128), r1 = *(const f32x4*)(resid + off + bj * 128 + 4);
                    *(f32x4*)(out + off + bj * 128) = r0 + acc[ai][bj][m][0]; *(f32x4*)(out + off + bj * 128 + 4) = r1 + acc[ai][bj][m][1]; } }
    }
};
struct EpiOutN {
    static constexpr bool PERM = true, AFTER_DRAIN = false;
    const float* resid; float* out; const float* gain; bf16* XN; float* PS;
    __device__ __forceinline__ void operator()(const f32x4 (&acc)[2][2][4][2], const pg8::Unit& u, int wr, int wc, int fr_in, int fq_in) const {
        int fr = fr_in, fq = fq_in; asm volatile("" : "+v"(fr), "+v"(fq));
        const int row0 = u.pm * 256 + wr * 64 + fr, col0 = u.pn * 256 + wc * 32 + 8 * fq;
        f32x4 gv[2][2];
#pragma unroll
        for (int bj = 0; bj < 2; ++bj) { gv[bj][0] = *(const f32x4*)(gain + col0 + bj * 128); gv[bj][1] = *(const f32x4*)(gain + col0 + bj * 128 + 4); }
#pragma unroll
        for (int ai = 0; ai < 2; ++ai)
#pragma unroll
            for (int m = 0; m < 4; ++m) { const int row = row0 + ai * 128 + m * 16; const unsigned off = (unsigned)(row * DM + col0); float ss = 0.f;
#pragma unroll
                for (int bj = 0; bj < 2; ++bj) { const f32x4 r0 = *(const f32x4*)(resid + off + bj * 128), r1 = *(const f32x4*)(resid + off + bj * 128 + 4);
                    const f32x4 h0 = r0 + acc[ai][bj][m][0], h1 = r1 + acc[ai][bj][m][1];
                    *(f32x4*)(out + off + bj * 128) = h0; *(f32x4*)(out + off + bj * 128 + 4) = h1;
                    ss += (h0[0] * h0[0] + h0[1] * h0[1]) + (h0[2] * h0[2] + h0[3] * h0[3]) + (h1[0] * h1[0] + h1[1] * h1[1]) + (h1[2] * h1[2] + h1[3] * h1[3]);
                    const f32x4 y0 = h0 * gv[bj][0], y1 = h1 * gv[bj][1]; v4u w; w.x = pk2(y0[0], y0[1]); w.y = pk2(y0[2], y0[3]); w.z = pk2(y1[0], y1[1]); w.w = pk2(y1[2], y1[3]);
                    *(v4u*)(XN + off + bj * 128) = w; }
                ss += __shfl_xor(ss, 16); ss += __shfl_xor(ss, 32);
                if (fq == 0) PS[(unsigned)(row * 16 + u.pn * 4 + wc)] = ss;
                if (m & 1) asm volatile("" ::: "memory"); }
    }
};

__device__ __forceinline__ int rope_row(int n) { const int d = n & 63; return (n - d) + ((d < 32) ? 2 * d : 2 * (d - 32) + 1); }
__device__ __forceinline__ void p0_transpose_item(const float* W, int K, int N, int nblk, bf16* WT, int row_off, bool ropeperm, LAS float* scr, int item, int lane) {
    const int kb = item / nblk, nb = item % nblk, k0 = 64 * kb, n0 = 32 * nb;
    const int nn = n0 + (lane & 31);
#pragma unroll 8
    for (int i = 0; i < 32; ++i) { const int kk = 2 * i + (lane >> 5); scr[kk * 33 + (lane & 31)] = (nn < N) ? W[(size_t)(k0 + kk) * N + nn] : 0.f; }
    LDS_WAIT(); asm volatile("" ::: "memory");
    const int c = lane & 7;
#pragma unroll
    for (int j = 0; j < 4; ++j) { const int nl = (lane >> 3) + 8 * j; const LAS float* s = scr + (8 * c) * 33 + nl; int n = n0 + nl; if (ropeperm && n < 1536) n = rope_row(n);
        v4u o; o.x = pk2(s[0 * 33], s[1 * 33]); o.y = pk2(s[2 * 33], s[3 * 33]); o.z = pk2(s[4 * 33], s[5 * 33]); o.w = pk2(s[6 * 33], s[7 * 33]);
        *(v4u*)(WT + (size_t)(row_off + n) * K + k0 + 8 * c) = o; }
    LDS_WAIT(); asm volatile("" ::: "memory");
}
__device__ __forceinline__ void rms_row_to_bf16(const float* xrow, const float* g0, bf16* o0, const float* g1, bf16* o1, int lane) {
    const f32x4* xr = (const f32x4*)xrow + lane; f32x4 v[4]; float s = 0.f;
#pragma unroll
    for (int j = 0; j < 4; ++j) { v[j] = xr[64 * j]; s += (v[j].x * v[j].x + v[j].y * v[j].y) + (v[j].z * v[j].z + v[j].w * v[j].w); }
    const float rstd = rsqrtf(wave_sum(s) * (1.f / DM) + EPS);
#pragma unroll
    for (int j = 0; j < 4; ++j) { const f32x4 g = ((const f32x4*)g0)[lane + 64 * j]; const f32x4 y = v[j] * rstd * g; v2u w; w.x = pk2(y.x, y.y); w.y = pk2(y.z, y.w); ((v2u*)o0)[lane + 64 * j] = w; }
    if (g1) {
#pragma unroll
        for (int j = 0; j < 4; ++j) { const f32x4 g = ((const f32x4*)g1)[lane + 64 * j]; const f32x4 y = v[j] * rstd * g; v2u w; w.x = pk2(y.x, y.y); w.y = pk2(y.z, y.w); ((v2u*)o1)[lane + 64 * j] = w; }
    }
}

__device__ __forceinline__ void rms_row2_to_bf16(const float* xa, const float* xb, const float* g0, bf16* oa, bf16* ob, int lane) {
    const f32x4* ra = (const f32x4*)xa + lane; const f32x4* rb = (const f32x4*)xb + lane; f32x4 va[4], vb[4]; float sa = 0.f, sb = 0.f;
#pragma unroll
    for (int j = 0; j < 4; ++j) { va[j] = ra[64 * j]; vb[j] = rb[64 * j]; }
#pragma unroll
    for (int j = 0; j < 4; ++j) { sa += (va[j].x * va[j].x + va[j].y * va[j].y) + (va[j].z * va[j].z + va[j].w * va[j].w); sb += (vb[j].x * vb[j].x + vb[j].y * vb[j].y) + (vb[j].z * vb[j].z + vb[j].w * vb[j].w); }
    const float rsa = rsqrtf(wave_sum(sa) * (1.f / DM) + EPS), rsb = rsqrtf(wave_sum(sb) * (1.f / DM) + EPS);
#pragma unroll
    for (int j = 0; j < 4; ++j) { const f32x4 g = ((const f32x4*)g0)[lane + 64 * j]; const f32x4 ya = va[j] * rsa * g, yb = vb[j] * rsb * g; v2u wa, wb; wa.x = pk2(ya.x, ya.y); wa.y = pk2(ya.z, ya.w); wb.x = pk2(yb.x, yb.y); wb.y = pk2(yb.z, yb.w);
        ((v2u*)oa)[lane + 64 * j] = wa; ((v2u*)ob)[lane + 64 * j] = wb; }
}
template <bool BF16OUT> __device__ __forceinline__ void rms_row2_bf16in(const bf16* xa, const bf16* xb, const float* g0, void* oa, void* ob, int lane) {
    v2u ra[4], rb[4]; f32x4 va[4], vb[4]; float sa = 0.f, sb = 0.f;
#pragma unroll
    for (int j = 0; j < 4; ++j) { ra[j] = ((const v2u*)xa)[lane + 64 * j]; rb[j] = ((const v2u*)xb)[lane + 64 * j]; }
#pragma unroll
    for (int j = 0; j < 4; ++j) { va[j] = (f32x4){bflo(ra[j].x), bfhi(ra[j].x), bflo(ra[j].y), bfhi(ra[j].y)}; vb[j] = (f32x4){bflo(rb[j].x), bfhi(rb[j].x), bflo(rb[j].y), bfhi(rb[j].y)};
        sa += (va[j].x * va[j].x + va[j].y * va[j].y) + (va[j].z * va[j].z + va[j].w * va[j].w); sb += (vb[j].x * vb[j].x + vb[j].y * vb[j].y) + (vb[j].z * vb[j].z + vb[j].w * vb[j].w); }
    const float rsa = rsqrtf(wave_sum(sa) * (1.f / DM) + EPS), rsb = rsqrtf(wave_sum(sb) * (1.f / DM) + EPS);
#pragma unroll
    for (int j = 0; j < 4; ++j) { const f32x4 g = ((const f32x4*)g0)[lane + 64 * j]; const f32x4 ya = va[j] * rsa * g, yb = vb[j] * rsb * g;
        if (BF16OUT) { v2u wa, wb; wa.x = pk2(ya.x, ya.y); wa.y = pk2(ya.z, ya.w); wb.x = pk2(yb.x, yb.y); wb.y = pk2(yb.z, yb.w); ((v2u*)oa)[lane + 64 * j] = wa; ((v2u*)ob)[lane + 64 * j] = wb; }
        else { ((f32x4*)oa)[lane + 64 * j] = ya; ((f32x4*)ob)[lane + 64 * j] = yb; } }
}
__device__ __forceinline__ int dstperm(int k) { return (k & ~31) + 8 * ((k >> 2) & 3) + 4 * ((k >> 4) & 1) + (k & 3); }
constexpr int P2_TEAM_BYTES = 80896;
typedef short bf16x4 __attribute__((ext_vector_type(4)));
__device__ __forceinline__ bf16x4 cvt4(f32x4 v) { v2u w; w.x = pk2(v[0], v[1]); w.y = pk2(v[2], v[3]); return __builtin_bit_cast(bf16x4, w); }
#define LBAR() do { asm volatile("s_waitcnt lgkmcnt(0)" ::: "memory"); __builtin_amdgcn_s_barrier(); asm volatile("" ::: "memory"); } while (0)
__device__ __forceinline__ void p2_delta_prep(LAS unsigned char* lds, int G, const bf16* __restrict__ QKV, const float* __restrict__ BA, const float* __restrict__ conv_w, const float* __restrict__ a_log,
                                              const float* __restrict__ dt_bias, bf16* __restrict__ DQG, bf16* __restrict__ DKDT, bf16* __restrict__ DW, bf16* __restrict__ DU, bf16* __restrict__ DA, float* __restrict__ GL, const int wave_s, const int lim = 4) {
    const int team = wave_s >> 2, wt = wave_s & 3;
    LAS unsigned char* tb = lds + team * P2_TEAM_BYTES;
    LAS bf16* Qs = (LAS bf16*)tb; LAS bf16* Ks = (LAS bf16*)(tb + 9216); LAS bf16* As = (LAS bf16*)(tb + 18432);
    LAS float* RHS = (LAS float*)(tb + 27648); LAS float* Lm = (LAS float*)(tb + 60416); LAS float* gc = (LAS float*)(tb + 76800); LAS float* bt = (LAS float*)(tb + 77056); LAS float* eq = (LAS float*)(tb + 77312); LAS float* ek = (LAS float*)(tb + 77568); LAS float* CW = (LAS float*)(tb + 77824);
    const int nteams = G * 2, per = (NUNIT_D + nteams - 1) / nteams, ubase = ((int)blockIdx.x * 2 + team) * per;
    v4u raw[3][5]; float ba_b = 0.f, ba_a = 0.f;
#define P2_FETCH(uid_) do { const int bh_ = (uid_) >> 6, c_ = (uid_) & 63, b_ = bh_ / 12, h_ = bh_ - 12 * b_; const size_t r0_ = (size_t)b_ * SEQ + (size_t)c_ * 64; \
        _Pragma("unroll") for (int mtx = 0; mtx < 3; ++mtx) _Pragma("unroll") for (int r = 0; r < 5; ++r) { const int s = c_ * 64 + t0 - 3 + r; \
            raw[mtx][r] = *(const v4u*)(QKV + (r0_ + (s >= 0 ? t0 - 3 + r : 0)) * 2304 + mtx * 768 + h_ * 64 + 8 * dg); }     \
        ba_b = BA[(r0_ + lane) * 32 + h_]; ba_a = BA[(r0_ + lane) * 32 + 12 + h_]; } while (0)
    int h_prev = -1; float h_nal = 0.f, h_dtb = 0.f;
    { int lane = __builtin_amdgcn_mbcnt_hi(~0u, __builtin_amdgcn_mbcnt_lo(~0u, 0u)); asm volatile("" : "+v"(lane)); const int tt = wt * 64 + lane, dg = tt & 7, t0 = (tt >> 3) * 2; if (ubase < NUNIT_D) P2_FETCH(ubase); }
    for (int it = 0; it < per; ++it) {
        int lane = __builtin_amdgcn_mbcnt_hi(~0u, __builtin_amdgcn_mbcnt_lo(~0u, 0u)); asm volatile("" : "+v"(lane));
        const int tt = wt * 64 + lane, dg = tt & 7, t0 = (tt >> 3) * 2;
        const int rt_ = tt ^ (team << 7);
        const int uid = ubase + it; const bool act = uid < NUNIT_D;
        const int bh = uid >> 6, b = bh / 12, h = bh - 12 * b;
        if (act && h != h_prev) {
            h_nal = -__expf(a_log[h]); h_dtb = dt_bias[h];
            for (int i = tt; i < 768; i += 256) { const int mtx = i >> 8, tap = (i >> 6) & 3, dd = i & 63; CW[i] = conv_w[tap * 2304 + mtx * 768 + h * 64 + dd]; }
        }
        h_prev = h;
        LBAR();
        if (act) {
            { const float beta = __builtin_amdgcn_rcpf(1.f + __expf(-ba_b)); const float xx = ba_a + h_dtb; const float sp = xx > 20.f ? xx : log1pf(__expf(xx));
              const float g0 = h_nal * sp;
#define DPPF(src, ctrl, rm, bm) __builtin_bit_cast(float, __builtin_amdgcn_update_dpp(0, __builtin_bit_cast(int, (src)), (ctrl), (rm), (bm), false))
              float g = g0 + DPPF(g0, 0x111, 0xf, 0xf); g += DPPF(g0, 0x112, 0xf, 0xf); g += DPPF(g0, 0x113, 0xf, 0xf);
              g += DPPF(g, 0x114, 0xf, 0xe); g += DPPF(g, 0x118, 0xf, 0xc); g += DPPF(g, 0x142, 0xa, 0xf); g += DPPF(g, 0x143, 0xc, 0xf);
#undef DPPF
              const float gl_ = __builtin_bit_cast(float, __builtin_amdgcn_readlane(__builtin_bit_cast(int, g), 63));
              gc[lane] = g; bt[lane] = beta; eq[lane] = __expf(g); ek[lane] = __expf(gl_ - g); }
            { const int c_now = uid & 63;
#pragma unroll
              for (int r = 0; r < 5; ++r) if (c_now * 64 + t0 - 3 + r < 0) {
#pragma unroll
                  for (int mtx = 0; mtx < 3; ++mtx) raw[mtx][r] = (v4u){0u, 0u, 0u, 0u}; } }
            float q[2][8], k[2][8], v[2][8];
#pragma unroll
            for (int mtx = 0; mtx < 3; ++mtx) {
                f32x4 cw[4][2];
#pragma unroll
                for (int tap = 0; tap < 4; ++tap) { cw[tap][0] = *(const LAS f32x4*)(CW + mtx * 256 + tap * 64 + 8 * dg); cw[tap][1] = *(const LAS f32x4*)(CW + mtx * 256 + tap * 64 + 8 * dg + 4); }
#pragma unroll
                for (int tk = 0; tk < 2; ++tk) { float o[8];
#pragma unroll
                    for (int e = 0; e < 8; ++e) o[e] = 0.f;
#pragma unroll
                    for (int tap = 0; tap < 4; ++tap) { const v4u rw = raw[mtx][tk + tap];
                        o[0] += cw[tap][0][0] * bflo(rw.x); o[1] += cw[tap][0][1] * bfhi(rw.x); o[2] += cw[tap][0][2] * bflo(rw.y); o[3] += cw[tap][0][3] * bfhi(rw.y);
                        o[4] += cw[tap][1][0] * bflo(rw.z); o[5] += cw[tap][1][1] * bfhi(rw.z); o[6] += cw[tap][1][2] * bflo(rw.w); o[7] += cw[tap][1][3] * bfhi(rw.w); }
#pragma unroll
                    for (int e = 0; e < 8; ++e) { const float y = silu_f(o[e]); if (mtx == 0) q[tk][e] = y; else if (mtx == 1) k[tk][e] = y; else v[tk][e] = y; } }
            }
#pragma unroll
            for (int tk = 0; tk < 2; ++tk) { float sq = 0.f, sk = 0.f;
#pragma unroll
                for (int e = 0; e < 8; ++e) { sq += q[tk][e] * q[tk][e]; sk += k[tk][e] * k[tk][e]; }
                sq = row8_sum(sq); sk = row8_sum(sk); const float rq = rsqrtf(sq + EPS) * 0.125f, rk = rsqrtf(sk + EPS);
#pragma unroll
                for (int e = 0; e < 8; ++e) { q[tk][e] *= rq; k[tk][e] *= rk; } }
            LDS_WAIT();
#pragma unroll
            for (int tk = 0; tk < 2; ++tk) { const int t = t0 + tk; const float beta = bt[t], eg = eq[t] * beta;
                v4u w; w.x = pk2(q[tk][0], q[tk][1]); w.y = pk2(q[tk][2], q[tk][3]); w.z = pk2(q[tk][4], q[tk][5]); w.w = pk2(q[tk][6], q[tk][7]); *(LAS v4u*)(Qs + t * 72 + 8 * dg) = w;
                w.x = pk2(k[tk][0], k[tk][1]); w.y = pk2(k[tk][2], k[tk][3]); w.z = pk2(k[tk][4], k[tk][5]); w.w = pk2(k[tk][6], k[tk][7]); *(LAS v4u*)(Ks + t * 72 + 8 * dg) = w;
                *(LAS f32x4*)(RHS + t * 128 + 8 * dg) = (f32x4){v[tk][0] * beta, v[tk][1] * beta, v[tk][2] * beta, v[tk][3] * beta};
                *(LAS f32x4*)(RHS + t * 128 + 8 * dg + 4) = (f32x4){v[tk][4] * beta, v[tk][5] * beta, v[tk][6] * beta, v[tk][7] * beta};
                *(LAS f32x4*)(RHS + t * 128 + 64 + 8 * dg) = (f32x4){k[tk][0] * eg, k[tk][1] * eg, k[tk][2] * eg, k[tk][3] * eg};
                *(LAS f32x4*)(RHS + t * 128 + 64 + 8 * dg + 4) = (f32x4){k[tk][4] * eg, k[tk][5] * eg, k[tk][6] * eg, k[tk][7] * eg}; }
        }
        LBAR();
        if (it + 1 < per && uid + 1 < NUNIT_D) P2_FETCH(uid + 1);
        const int l15 = lane & 15, lq = lane >> 4;
        if (act && lim >= 2) {
            bf16x8 ka[2], qa[2];
#pragma unroll
            for (int ks = 0; ks < 2; ++ks) { ka[ks] = *(const LAS bf16x8*)(Ks + (16 * wt + l15) * 72 + 32 * ks + 8 * lq); qa[ks] = *(const LAS bf16x8*)(Qs + (16 * wt + l15) * 72 + 32 * ks + 8 * lq); }
            float gi[4], bi[4];
#pragma unroll
            for (int r = 0; r < 4; ++r) { gi[r] = gc[16 * wt + 4 * lq + r]; bi[r] = bt[16 * wt + 4 * lq + r]; }
#pragma unroll
            for (int ct = 0; ct < 4; ++ct) {
                const bf16x8 kb0 = *(const LAS bf16x8*)(Ks + (16 * ct + l15) * 72 + 8 * lq), kb1 = *(const LAS bf16x8*)(Ks + (16 * ct + l15) * 72 + 32 + 8 * lq);
                f32x4 kk = {0.f, 0.f, 0.f, 0.f}, qk = {0.f, 0.f, 0.f, 0.f};
                kk = __builtin_amdgcn_mfma_f32_16x16x32_bf16(ka[0], kb0, kk, 0, 0, 0); kk = __builtin_amdgcn_mfma_f32_16x16x32_bf16(ka[1], kb1, kk, 0, 0, 0);
                qk = __builtin_amdgcn_mfma_f32_16x16x32_bf16(qa[0], kb0, qk, 0, 0, 0); qk = __builtin_amdgcn_mfma_f32_16x16x32_bf16(qa[1], kb1, qk, 0, 0, 0);
                const int j = 16 * ct + l15; const float gj = gc[j];
#pragma unroll
                for (int r = 0; r < 4; ++r) { const int i = 16 * wt + 4 * lq + r; const float dec = (j <= i) ? __expf(gi[r] - gj) : 0.f;
                    Lm[i * 64 + j] = (j < i) ? bi[r] * kk[r] * dec : 0.f;
                    As[i * 72 + j] = (bf16)(pk2(qk[r] * dec, 0.f) & 0xffffu); }
            }
        }
        LBAR();
        if (act && lim >= 3) {
            if (rt_ < 64) {
                const int bb = rt_ >> 4, cc = rt_ & 15; const LAS float* Lb = Lm + (16 * bb) * 64 + 16 * bb; float t[16]; f32x4 lv[15][4];
#pragma unroll
                for (int r = 1; r < 16; ++r)
#pragma unroll
                    for (int j4 = 0; j4 < (r + 3) / 4; ++j4) lv[r - 1][j4] = *(const LAS f32x4*)(Lb + r * 64 + 4 * j4);
                __builtin_amdgcn_sched_barrier(0);
#pragma unroll
                for (int r = 0; r < 16; ++r) { float a = (r == cc) ? 1.f : 0.f;
#pragma unroll
                    for (int j4 = 0; j4 < (r + 3) / 4; ++j4) { const f32x4 l = lv[r > 0 ? r - 1 : 0][j4];
#pragma unroll
                        for (int e = 0; e < 4; ++e) if (4 * j4 + e < r) a -= l[e] * t[4 * j4 + e]; }
                    t[r] = a; }
                LDS_WAIT(); asm volatile("" ::: "memory");
#pragma unroll
                for (int r = 0; r < 16; ++r) ((LAS float*)Lb)[r * 64 + cc] = t[r];
            } else if (rt_ >= 128) {
                const int t2 = rt_ - 128, rrow = t2 >> 1, half = t2 & 1;
                { const float eg = eq[rrow]; v4u in[4], ou[4];
#pragma unroll
                  for (int i = 0; i < 4; ++i) in[i] = *(const LAS v4u*)(Qs + rrow * 72 + 32 * half + 8 * i);
                  unsigned g4[16];
#pragma unroll
                  for (int kk4 = 0; kk4 < 8; ++kk4) { const unsigned a0 = in[kk4 >> 1][(kk4 & 1) * 2], a1 = in[kk4 >> 1][(kk4 & 1) * 2 + 1]; const int p4 = 2 * (kk4 & 3) + (kk4 >> 2);
                      g4[2 * p4] = pk2(bflo(a0) * eg, bfhi(a0) * eg); g4[2 * p4 + 1] = pk2(bflo(a1) * eg, bfhi(a1) * eg); }
#pragma unroll
                  for (int i = 0; i < 4; ++i) { ou[i] = (v4u){g4[4 * i], g4[4 * i + 1], g4[4 * i + 2], g4[4 * i + 3]}; *(v4u*)(DQG + (size_t)uid * 4096 + rrow * 64 + 32 * half + 8 * i) = ou[i]; } }
                { v4u in[4], ou[4];
#pragma unroll
                  for (int i = 0; i < 4; ++i) in[i] = *(const LAS v4u*)(As + rrow * 72 + 32 * half + 8 * i);
                  unsigned g4[16];
#pragma unroll
                  for (int kk4 = 0; kk4 < 8; ++kk4) { const int p4 = 2 * (kk4 & 3) + (kk4 >> 2); g4[2 * p4] = in[kk4 >> 1][(kk4 & 1) * 2]; g4[2 * p4 + 1] = in[kk4 >> 1][(kk4 & 1) * 2 + 1]; }
#pragma unroll
                  for (int i = 0; i < 4; ++i) { ou[i] = (v4u){g4[4 * i], g4[4 * i + 1], g4[4 * i + 2], g4[4 * i + 3]}; *(v4u*)(DA + (size_t)uid * 4096 + rrow * 64 + 32 * half + 8 * i) = ou[i]; } }
                {
                  unsigned g4[16]; bf16 kv_[32]; f32x4 ev_[8];
#pragma unroll
                  for (int i = 0; i < 32; ++i) kv_[i] = Ks[(32 * half + i) * 72 + rrow];
#pragma unroll
                  for (int i = 0; i < 8; ++i) ev_[i] = *(const LAS f32x4*)(ek + 32 * half + 4 * i);
                  __builtin_amdgcn_sched_barrier(0);
#pragma unroll
                  for (int kk4 = 0; kk4 < 8; ++kk4) { const int p4 = 2 * (kk4 & 3) + (kk4 >> 2); float f[4];
#pragma unroll
                      for (int e = 0; e < 4; ++e) f[e] = bf1(kv_[4 * kk4 + e]) * ev_[kk4][e];
                      g4[2 * p4] = pk2(f[0], f[1]); g4[2 * p4 + 1] = pk2(f[2], f[3]); }
#pragma unroll
                  for (int i = 0; i < 4; ++i) *(v4u*)(DKDT + (size_t)uid * 4096 + rrow * 64 + 32 * half + 8 * i) = (v4u){g4[4 * i], g4[4 * i + 1], g4[4 * i + 2], g4[4 * i + 3]}; }
                if (t2 == 0) GL[uid] = eq[63];
            }
        }
        LBAR();
        if (act && lim >= 4) {
            f32x4 X[2][4]; bf16x4 xb[2][4]; f32x4 racc[4][2], lfr[4][4];
#pragma unroll
            for (int bb = 0; bb < 4; ++bb) {
#pragma unroll
                for (int c2 = 0; c2 < 2; ++c2)
#pragma unroll
                    for (int r = 0; r < 4; ++r) racc[bb][c2][r] = RHS[(16 * bb + 4 * lq + r) * 128 + 32 * wt + 16 * c2 + l15];
#pragma unroll
                for (int j = 0; j < 4; ++j) if (j <= bb) lfr[bb][j] = *(const LAS f32x4*)(Lm + (16 * bb + l15) * 64 + 16 * j + 4 * lq); }
            __builtin_amdgcn_sched_barrier(0);
#pragma unroll
            for (int bb = 0; bb < 4; ++bb) {
                f32x4 acc[2]; acc[0] = racc[bb][0]; acc[1] = racc[bb][1];
#pragma unroll
                for (int j = 0; j < 4; ++j) if (j < bb) { const f32x4 lv = lfr[bb][j]; const bf16x4 la = cvt4(-lv);
#pragma unroll
                    for (int c2 = 0; c2 < 2; ++c2) acc[c2] = __builtin_amdgcn_mfma_f32_16x16x16bf16_1k(la, xb[c2][j], acc[c2], 0, 0, 0); }
                const f32x4 tv = lfr[bb][bb]; const bf16x4 ta = cvt4(tv);
#pragma unroll
                for (int c2 = 0; c2 < 2; ++c2) { const bf16x4 yb = cvt4(acc[c2]); X[c2][bb] = __builtin_amdgcn_mfma_f32_16x16x16bf16_1k(ta, yb, (f32x4){0.f, 0.f, 0.f, 0.f}, 0, 0, 0); xb[c2][bb] = cvt4(X[c2][bb]); }
            }
            if (wt < 2) {
#pragma unroll
                for (int c2 = 0; c2 < 2; ++c2) { bf16* up = DU + (size_t)uid * 4096 + ((2 * wt + c2) * 64 + lane) * 16; v4u w0, w1;
                    w0.x = pk2(X[c2][0][0], X[c2][0][1]); w0.y = pk2(X[c2][0][2], X[c2][0][3]); w0.z = pk2(X[c2][1][0], X[c2][1][1]); w0.w = pk2(X[c2][1][2], X[c2][1][3]);
                    w1.x = pk2(X[c2][2][0], X[c2][2][1]); w1.y = pk2(X[c2][2][2], X[c2][2][3]); w1.z = pk2(X[c2][3][0], X[c2][3][1]); w1.w = pk2(X[c2][3][2], X[c2][3][3]);
                    *(v4u*)up = w0; *(v4u*)(up + 8) = w1; }
            } else {
#pragma unroll
                for (int c2 = 0; c2 < 2; ++c2) { bf16* wp = DW + (size_t)uid * 4096 + dstperm(32 * (wt - 2) + 16 * c2 + l15);
#pragma unroll
                    for (int bb = 0; bb < 4; ++bb)
#pragma unroll
                        for (int r = 0; r < 4; ++r) wp[(16 * bb + 4 * lq + r) * 64] = (bf16)(pk2(X[c2][bb][r], 0.f) & 0xffffu); }
            }
        }
    }
    LBAR();
#undef P2_FETCH
}

constexpr int SC_W = 0, SC_QG = 9216, SC_A = 18432, SC_KDT = 27648, SC_U = 36864, SC_STAGE = 45056, SC_O = 2 * SC_STAGE, SC_OSTRIDE = 68, SC_OBYTES = 64 * SC_OSTRIDE * 4;
__device__ __forceinline__ void p3_scan(LAS unsigned char* lds, int sq, const bf16* __restrict__ DQG, const bf16* __restrict__ DKDT, const bf16* __restrict__ DW, const bf16* __restrict__ DU, const bf16* __restrict__ DA,
                                        const float* __restrict__ GL, bf16* Z, const float* __restrict__ o_norm, const int wave_s, const bool dostore = true) {
    int lane_ = __builtin_amdgcn_mbcnt_hi(~0u, __builtin_amdgcn_mbcnt_lo(~0u, 0u)); asm volatile("" : "+v"(lane_)); const int tid = wave_s * 64 + lane_; const int wid = wave_s, lane = lane_, l15 = lane & 15, lq = lane >> 4;
    const int b = sq / 12, h = sq - 12 * b; const size_t uid0 = (size_t)sq * 64; const size_t row0 = (size_t)b * SEQ;
    const int ht = tid - 256;
#define SC_LOAD(n) do { const size_t ub = (uid0 + (n)) * 8192; \
        _Pragma("unroll") for (int i = 0; i < 2; ++i) { const int p = ht + 256 * i; \
            st[0][i] = *(const v4u*)((const char*)DW + ub + p * 16); st[1][i] = *(const v4u*)((const char*)DQG + ub + p * 16); st[2][i] = *(const v4u*)((const char*)DA + ub + p * 16); \
            st[3][i] = *(const v4u*)((const char*)DKDT + ub + p * 16); st[4][i] = *(const v4u*)((const char*)DU + ub + p * 16); } } while (0)
#define SC_STORE(s) do { LAS unsigned char* sb_ = lds + (s) * SC_STAGE; \
        _Pragma("unroll") for (int i = 0; i < 2; ++i) { const int p = ht + 256 * i; const int ro = (p >> 3) * 144 + (p & 7) * 16; \
            *(LAS v4u*)(sb_ + SC_W + ro) = st[0][i]; *(LAS v4u*)(sb_ + SC_QG + ro) = st[1][i]; *(LAS v4u*)(sb_ + SC_A + ro) = st[2][i]; *(LAS v4u*)(sb_ + SC_KDT + ro) = st[3][i]; \
            *(LAS v4u*)(sb_ + SC_U + p * 16) = st[4][i]; } } while (0)
#define SC_EPI(n) do { const int row_ = ht >> 2, sg_ = ht & 3; bf16* zp_ = Z + (row0 + (size_t)(n) * 64 + row_) * 1024 + h * 64 + sg_ * 16; \
        const v4u z0_ = *(const v4u*)zp_, z1_ = *(const v4u*)(zp_ + 8); const LAS float* op_ = (const LAS float*)(lds + SC_O + ((n) & 1) * SC_OBYTES) + row_ * SC_OSTRIDE + sg_ * 16; \
        f32x4 o_[4]; float ss_ = 0.f; \
        _Pragma("unroll") for (int i = 0; i < 4; ++i) { o_[i] = *(const LAS f32x4*)(op_ + 4 * i); ss_ += (o_[i][0] * o_[i][0] + o_[i][1] * o_[i][1]) + (o_[i][2] * o_[i][2] + o_[i][3] * o_[i][3]); } \
        ss_ = DPP_ADD(ss_, 0xB1); ss_ = DPP_ADD(ss_, 0x4E); const float rstd_ = rsqrtf(ss_ * (1.f / 64.f) + EPS); \
        v4u y0_, y1_; \
        _Pragma("unroll") for (int i = 0; i < 4; ++i) { const unsigned zz_ = (i < 2) ? z0_[2 * i] : z1_[2 * (i - 2)], zw_ = (i < 2) ? z0_[2 * i + 1] : z1_[2 * (i - 2) + 1]; \
            const unsigned a_ = pk2(o_[i][0] * rstd_ * onv[4 * i] * silu_f(bflo(zz_)), o_[i][1] * rstd_ * onv[4 * i + 1] * silu_f(bfhi(zz_))); \
            const unsigned b_ = pk2(o_[i][2] * rstd_ * onv[4 * i + 2] * silu_f(bflo(zw_)), o_[i][3] * rstd_ * onv[4 * i + 3] * silu_f(bfhi(zw_))); \
            if (i < 2) { y0_[2 * i] = a_; y0_[2 * i + 1] = b_; } else { y1_[2 * (i - 2)] = a_; y1_[2 * (i - 2) + 1] = b_; } } \
        if (dostore) { *(v4u*)zp_ = y0_; *(v4u*)(zp_ + 8) = y1_; } } while (0)
    v4u st[5][2]; float onv[16];
    if (wid >= 4) { SC_LOAD(0); SC_STORE(0); SC_LOAD(1);
#pragma unroll
        for (int i = 0; i < 16; ++i) onv[i] = o_norm[(ht & 3) * 16 + i]; }
    LBAR();
    f32x4 S[4];
#pragma unroll
    for (int i = 0; i < 4; ++i) S[i] = (f32x4){0.f, 0.f, 0.f, 0.f};
    float gl_next = GL[uid0];
    for (int n = 0; n < 64; ++n) {
        if (wid >= 4) {
            if (n + 1 < 64) { SC_STORE((n + 1) & 1); if (n + 2 < 64) SC_LOAD(n + 2); }
            if (n > 0) SC_EPI(n - 1);
        } else {
            const LAS unsigned char* sb = lds + (n & 1) * SC_STAGE; const int fo = l15 * 144 + lq * 16;
            const float gl = gl_next; gl_next = GL[uid0 + (n + 1 < 64 ? n + 1 : n)];
            bf16x8 sbv[2], vb[2];
#pragma unroll
            for (int ks = 0; ks < 2; ++ks) { v4u w; w.x = pk2(S[2 * ks][0], S[2 * ks][1]); w.y = pk2(S[2 * ks][2], S[2 * ks][3]); w.z = pk2(S[2 * ks + 1][0], S[2 * ks + 1][1]); w.w = pk2(S[2 * ks + 1][2], S[2 * ks + 1][3]); sbv[ks] = __builtin_bit_cast(bf16x8, w); }
            f32x4 vn[4];
#pragma unroll
            for (int rt = 0; rt < 4; ++rt) { f32x4 a = {0.f, 0.f, 0.f, 0.f};
#pragma unroll
                for (int ks = 0; ks < 2; ++ks) a = __builtin_amdgcn_mfma_f32_16x16x32_bf16(*(const LAS bf16x8*)(sb + SC_W + rt * 2304 + ks * 64 + fo), sbv[ks], a, 0, 0, 0);
                const v2u uu = *(const LAS v2u*)(sb + SC_U + ((wid * 64 + lane) * 16 + rt * 4) * 2);
                vn[rt] = (f32x4){bflo(uu.x), bfhi(uu.x), bflo(uu.y), bfhi(uu.y)} - a; }
#pragma unroll
            for (int ks = 0; ks < 2; ++ks) { v4u w; w.x = pk2(vn[2 * ks][0], vn[2 * ks][1]); w.y = pk2(vn[2 * ks][2], vn[2 * ks][3]); w.z = pk2(vn[2 * ks + 1][0], vn[2 * ks + 1][1]); w.w = pk2(vn[2 * ks + 1][2], vn[2 * ks + 1][3]); vb[ks] = __builtin_bit_cast(bf16x8, w); }
            LAS float* ob = (LAS float*)(lds + SC_O + (n & 1) * SC_OBYTES) + 16 * wid + l15;
#pragma unroll
            for (int rt = 0; rt < 4; ++rt) { f32x4 a = {0.f, 0.f, 0.f, 0.f};
#pragma unroll
                for (int ks = 0; ks < 2; ++ks) { a = __builtin_amdgcn_mfma_f32_16x16x32_bf16(*(const LAS bf16x8*)(sb + SC_QG + rt * 2304 + ks * 64 + fo), sbv[ks], a, 0, 0, 0);
                    a = __builtin_amdgcn_mfma_f32_16x16x32_bf16(*(const LAS bf16x8*)(sb + SC_A + rt * 2304 + ks * 64 + fo), vb[ks], a, 0, 0, 0); }
#pragma unroll
                for (int r = 0; r < 4; ++r) ob[(16 * rt + 4 * lq + r) * SC_OSTRIDE] = a[r]; }
#pragma unroll
            for (int dt = 0; dt < 4; ++dt) { f32x4 a = S[dt] * gl;
#pragma unroll
                for (int ks = 0; ks < 2; ++ks) a = __builtin_amdgcn_mfma_f32_16x16x32_bf16(*(const LAS bf16x8*)(sb + SC_KDT + dt * 2304 + ks * 64 + fo), vb[ks], a, 0, 0, 0);
                S[dt] = a; }
        }
        LBAR();
    }
    if (wid >= 4) SC_EPI(63);
    LBAR();
#undef SC_LOAD
#undef SC_STORE
#undef SC_EPI
}
constexpr int PTR_OFF = 161792;
#define GAS __attribute__((address_space(1)))
__device__ __forceinline__ GAS void* ldp(LAS unsigned char* lds, int k) {
    asm volatile("" ::: "memory");
    const LAS unsigned* t = (const LAS unsigned*)(lds + PTR_OFF) + 2 * k; unsigned lo = t[0], hi = t[1];
    lo = __builtin_amdgcn_readfirstlane(lo); hi = __builtin_amdgcn_readfirstlane(hi);
    return (GAS void*)(((unsigned long long)hi << 32) | lo);
}
#define x_ ((const float*)(GAS const float*)ldp(lds, 0))
#define mem_ ((const float*)(GAS const float*)ldp(lds, 1))
#define positions_ ((const int*)(GAS const int*)ldp(lds, 2))
#define norm_0_ ((const float*)(GAS const float*)ldp(lds, 3))
#define w_in_0_ ((const float*)(GAS const float*)ldp(lds, 4))
#define conv_w_ ((const float*)(GAS const float*)ldp(lds, 5))
#define a_log_ ((const float*)(GAS const float*)ldp(lds, 6))
#define dt_bias_ ((const float*)(GAS const float*)ldp(lds, 7))
#define o_norm_ ((const float*)(GAS const float*)ldp(lds, 8))
#define mem_norm_0_ ((const float*)(GAS const float*)ldp(lds, 9))
#define w_mkv_0_ ((const float*)(GAS const float*)ldp(lds, 10))
#define w_out_0_ ((const float*)(GAS const float*)ldp(lds, 11))
#define norm_1_ ((const float*)(GAS const float*)ldp(lds, 12))
#define w_in_1_ ((const float*)(GAS const float*)ldp(lds, 13))
#define mem_norm_1_ ((const float*)(GAS const float*)ldp(lds, 14))
#define w_mkv_1_ ((const float*)(GAS const float*)ldp(lds, 15))
#define w_out_1_ ((const float*)(GAS const float*)ldp(lds, 16))
#define final_norm_ ((const float*)(GAS const float*)ldp(lds, 17))
#define out_ ((float*)(GAS float*)ldp(lds, 18))
#define KSUM_ ((float*)(GAS float*)((GAS unsigned char*)ldp(lds, 19) + WS_KSUM))
#define GL_ ((float*)(GAS float*)((GAS unsigned char*)ldp(lds, 19) + WS_GL))
#define WCAT0_ ((bf16*)(GAS bf16*)((GAS unsigned char*)ldp(lds, 19) + WS_WCAT0))
#define WOUT0_ ((bf16*)(GAS bf16*)((GAS unsigned char*)ldp(lds, 19) + WS_WOUT0))
#define WIN1_ ((bf16*)(GAS bf16*)((GAS unsigned char*)ldp(lds, 19) + WS_WIN1))
#define WOUT1_ ((bf16*)(GAS bf16*)((GAS unsigned char*)ldp(lds, 19) + WS_WOUT1))
#define RT_ ((float*)(GAS float*)((GAS unsigned char*)ldp(lds, 19) + WS_ROPE))
#define ACAT_ ((bf16*)(GAS bf16*)((GAS unsigned char*)ldp(lds, 19) + WS_ACAT))
#define MKV_ ((bf16*)(GAS bf16*)((GAS unsigned char*)ldp(lds, 19) + WS_MKV))
#define QKV_ ((bf16*)(GAS bf16*)((GAS unsigned char*)ldp(lds, 19) + WS_QKV))
#define Zb_ ((bf16*)(GAS bf16*)((GAS unsigned char*)ldp(lds, 19) + WS_Z))
#define MQ_ ((bf16*)(GAS bf16*)((GAS unsigned char*)ldp(lds, 19) + WS_MQ))
#define BA_ ((float*)(GAS float*)((GAS unsigned char*)ldp(lds, 19) + WS_BA))
#define PS_ ((float*)(GAS float*)((GAS unsigned char*)ldp(lds, 19) + WS_PS))
#define H1B_ ((bf16*)(GAS bf16*)((GAS unsigned char*)ldp(lds, 19) + WS_DU))
#define H2B_ ((bf16*)(GAS bf16*)((GAS unsigned char*)ldp(lds, 19) + WS_DU))
#define DW_ ((bf16*)(GAS bf16*)((GAS unsigned char*)ldp(lds, 19) + WS_DW))
#define DU_ ((bf16*)(GAS bf16*)((GAS unsigned char*)ldp(lds, 19) + WS_DU))
#define DA_ ((bf16*)(GAS bf16*)((GAS unsigned char*)ldp(lds, 19) + WS_DA))
#define DQG_ ((bf16*)(GAS bf16*)ldp(lds, 18))
#define DKDT_ ((bf16*)((GAS bf16*)ldp(lds, 18) + (size_t)NUNIT_D * 4096))
#define Q1_ (QKV_)
#define K1_ (QKV_ + (size_t)M * 768)
#define V1_ (QKV_ + (size_t)2 * M * 768)
__device__ __forceinline__ void mem_attn_unit(int u, int layer, LAS unsigned char* lds, char* shm, const int wave_s) {
    const int qb = u & 15, hm = (u >> 4) & 3, b = u >> 6; const size_t r0 = (size_t)b * SEQ + (size_t)qb * 256;
    GAS unsigned char* ws_ = (GAS unsigned char*)ldp(lds, 19);
    const attn_body::bf16* Kh = (const attn_body::bf16*)(GAS attn_body::bf16*)(ws_ + WS_MKV) + (size_t)layer * MROWS * 512 + (size_t)b * NMEM * 512 + hm * 64;
    attn_body::attn_unit<8, 0, 256, 512, 1024>(4, (const attn_body::bf16*)(GAS attn_body::bf16*)(ws_ + WS_MQ) + r0 * 256 + hm * 64, Kh, Kh + 256,
                               (attn_body::bf16*)(GAS attn_body::bf16*)(ws_ + WS_Z) + r0 * 1024 + 768 + hm * 64, nullptr, 0, shm, wave_s);
}
__device__ __forceinline__ void moba_attn_unit(int bh, int qb, LAS unsigned char* lds, char* shm, const int wave_s, const bool dry = false) {
    const int b = bh / 12, h = bh - 12 * b; const size_t r0 = (size_t)b * SEQ + (size_t)qb * 256;
    GAS unsigned char* ws_ = (GAS unsigned char*)ldp(lds, 19);
    const attn_body::bf16* qkv_ = (const attn_body::bf16*)(GAS attn_body::bf16*)(ws_ + WS_QKV);
    attn_body::attn_unit<8, 1, 768, 768, 1024>(4 * (qb + 1), qkv_ + r0 * 768 + h * 64, qkv_ + (size_t)M * 768 + (size_t)b * SEQ * 768 + h * 64, qkv_ + (size_t)2 * M * 768 + (size_t)b * SEQ * 768 + h * 64,
                               (attn_body::bf16*)(GAS attn_body::bf16*)(ws_ + WS_Z) + r0 * 1024 + h * 64, (const float*)(GAS float*)(ws_ + WS_KSUM) + (size_t)b * 16 * 768 + h * 64, qb, shm, wave_s, dry,
                               (const float*)(GAS float*)(ws_ + WS_ROPE) + r0 * 64);
}
#define XB_TMO      128
#define XB_XCNT(j)  (256  + 64 * (j))
#define XB_XSUB(j)  (1280 + 64 * (j))
#define XB_XGEN(j)  (2304 + 64 * (j))
#define XB_TOP      3328
#define XB_TOPGEN   3392
#define XCD_BAR_WORDS 3456
#define XB_SPIN_CAP (1u << 18)

__device__ __forceinline__ unsigned xb_ld(unsigned* p)              { return __hip_atomic_load(p, __ATOMIC_RELAXED, __HIP_MEMORY_SCOPE_AGENT); }
__device__ __forceinline__ unsigned xb_add(unsigned* p, unsigned v) { return __hip_atomic_fetch_add(p, v, __ATOMIC_RELAXED, __HIP_MEMORY_SCOPE_AGENT); }
__device__ __forceinline__ unsigned xb_xcc_id() { return (unsigned)__builtin_amdgcn_s_getreg((3 << 11) | 20) & 0xFu; }
#define XB_SPIN(cond, bar) do { unsigned _sp = 0; while (cond) { __builtin_amdgcn_s_sleep(1); \
    if ((++_sp & 255u) == 0u) { if (xb_ld(&(bar)[XB_TMO])) break; if (_sp > XB_SPIN_CAP) { atomicAdd(&(bar)[XB_TMO], 1u); break; } } } } while (0)

struct XcdBarrier {
    unsigned* bar; unsigned x;
    volatile LAS unsigned* st;
};

__device__ __forceinline__ XcdBarrier xcd_barrier_post(unsigned* bar, volatile LAS unsigned* st) {
    XcdBarrier b; b.bar = bar; b.x = xb_xcc_id(); b.st = st;
    if (threadIdx.x == 0) (void)xb_add(&bar[XB_XCNT(b.x)], 1u);
    return b;
}
__device__ __forceinline__ void xcd_barrier_complete(unsigned* bar, unsigned x, unsigned& nloc, unsigned& nx) {
    const unsigned G = gridDim.x * gridDim.y * gridDim.z;
    unsigned sum, cnt, mine, sp = 0u;
    for (;;) {
        sum = 0u; cnt = 0u; mine = 0u;
#pragma unroll
        for (unsigned j = 0; j < 16; ++j) { const unsigned c = xb_ld(&bar[XB_XCNT(j)]); sum += c; cnt += (c > 0u) ? 1u : 0u; mine = (j == x) ? c : mine; }
        if (sum == G) break;
        __builtin_amdgcn_s_sleep(1);
        if ((++sp & 255u) == 0u) { if (xb_ld(&bar[XB_TMO])) break; if (sp > XB_SPIN_CAP) { atomicAdd(&bar[XB_TMO], 1u); break; } }
    }
    nloc = mine > 0u ? mine : 1u; nx = cnt > 0u ? cnt : 1u;
}

__device__ __forceinline__ void xcd_barrier(const XcdBarrier& b) {
    asm volatile("s_waitcnt vmcnt(0)" ::: "memory");
    __syncthreads();
    if (threadIdx.x == 0) {
        unsigned* bar = b.bar;
        __builtin_amdgcn_s_waitcnt(0);
        unsigned nloc = b.st[0], nx = b.st[1];
        if (nloc == 0u) { xcd_barrier_complete(bar, b.x, nloc, nx); b.st[0] = nloc; b.st[1] = nx; }
        const unsigned old = xb_add(&bar[XB_XSUB(b.x)], 1u);
        const unsigned gen = old / nloc;
        if (old + 1u == (gen + 1u) * nloc) {
            __builtin_amdgcn_fence(__ATOMIC_RELEASE, "agent");
            asm volatile("s_waitcnt vmcnt(0)" ::: "memory");
            const unsigned og = xb_add(&bar[XB_TOP], 1u);
            const unsigned tg = og / nx;
            if (og + 1u == (tg + 1u) * nx) xb_add(&bar[XB_TOPGEN], 1u);
            else XB_SPIN(xb_ld(&bar[XB_TOPGEN]) == tg, bar);
            __builtin_amdgcn_fence(__ATOMIC_ACQUIRE, "agent");
            xb_add(&bar[XB_XGEN(b.x)], 1u);
            asm volatile("s_waitcnt vmcnt(0)" ::: "memory");
        } else {
            XB_SPIN(xb_ld(&bar[XB_XGEN(b.x)]) == gen, bar);
            __builtin_amdgcn_fence(__ATOMIC_ACQUIRE, "agent");
            asm volatile("s_waitcnt vmcnt(0)" ::: "memory");
        }
    }
    __syncthreads();
}

constexpr size_t WS_BAR = 1 * MiB;
struct Args { const float* in[18]; float* out; unsigned char* ws; };
__global__ void __launch_bounds__(NTHREADS, 2) hybrid_fwd(Args args) {
    extern __shared__ __attribute__((aligned(16))) unsigned char lds_raw[];
    cg::grid_group grid = cg::this_grid();
    LAS unsigned char* lds = (LAS unsigned char*)lds_raw;
    const int G = gridDim.x, bid = blockIdx.x;
    const int wave_s = __builtin_amdgcn_readfirstlane((int)threadIdx.x >> 6);
    if (threadIdx.x < 20) { const unsigned long long pv = threadIdx.x < 18 ? (unsigned long long)args.in[threadIdx.x < 18 ? threadIdx.x : 0] : (threadIdx.x == 18 ? (unsigned long long)args.out : (unsigned long long)args.ws);
        ((LAS unsigned long long*)(lds + PTR_OFF))[threadIdx.x] = pv; }
    if (threadIdx.x == 32) { ((LAS unsigned*)(lds + PTR_OFF + 192))[0] = 0u; ((LAS unsigned*)(lds + PTR_OFF + 192))[1] = 0u; }
    __syncthreads();
    const XcdBarrier xbar = xcd_barrier_post((unsigned*)(args.ws + WS_BAR), (volatile LAS unsigned*)(lds + PTR_OFF + 192));
    const int vcu = (G % 8 == 0) ? (bid % 8) * (G / 8) + bid / 8 : bid;
    const int NGW = G * 8;
#define FRESH_IDS() int lane = __builtin_amdgcn_mbcnt_hi(~0u, __builtin_amdgcn_mbcnt_lo(~0u, 0u)); asm volatile("" : "+v"(lane)); const int wave = wave_s, tid = wave_s * 64 + lane; (void)tid; const int gw = vcu * 8 + wave; (void)lane; (void)gw

#ifndef SKIP_P0
    {
        FRESH_IDS();
        LAS float* scr = (LAS float*)(lds + wave * 16384);
        constexpr int I_IN0 = 16 * 113, I_MKV = 16 * 16, I_OUT = 16 * 32, I_IN1 = 16 * 112;
        constexpr int NITEMS = I_IN0 + 2 * I_MKV + 2 * I_OUT + I_IN1;
        for (int it = gw; it < NITEMS; it += NGW) {
            int r = it;
            if (r < I_IN0) { p0_transpose_item(w_in_0_, DM, N_IN0, 113, WCAT0_, 0, false, scr, r, lane); continue; } r -= I_IN0;
            if (r < I_MKV) { p0_transpose_item(w_mkv_0_, DM, 512, 16, WCAT0_, N_IN0P, false, scr, r, lane); continue; } r -= I_MKV;
            if (r < I_MKV) { p0_transpose_item(w_mkv_1_, DM, 512, 16, WCAT0_, N_IN0P + 512, false, scr, r, lane); continue; } r -= I_MKV;
            if (r < I_OUT) { p0_transpose_item(w_out_0_, DM, DM, 32, WOUT0_, 0, false, scr, r, lane); continue; } r -= I_OUT;
            if (r < I_OUT) { p0_transpose_item(w_out_1_, DM, DM, 32, WOUT1_, 0, false, scr, r, lane); continue; } r -= I_OUT;
            p0_transpose_item(w_in_1_, DM, N_IN1, 112, WIN1_, 0, true, scr, r, lane);
        }
        { const size_t z0 = (size_t)3616 * DM * 2, z1 = (size_t)N_IN0P * DM * 2;
          for (size_t p = z0 + ((size_t)bid * NTHREADS + tid) * 16; p < z1; p += (size_t)G * NTHREADS * 16) *(v4u*)((unsigned char*)WCAT0_ + p) = (v4u){0u, 0u, 0u, 0u}; }
        for (int i = bid * NTHREADS + tid; i < BATCH * 16 * 768; i += G * NTHREADS) KSUM_[i] = 0.f;
        { int m = gw; for (; m + NGW < M; m += 2 * NGW) rms_row2_to_bf16(x_ + (size_t)m * DM, x_ + (size_t)(m + NGW) * DM, norm_0_, ACAT_ + (size_t)m * DM, ACAT_ + (size_t)(m + NGW) * DM, lane);
          if (m < M) rms_row_to_bf16(x_ + (size_t)m * DM, norm_0_, ACAT_ + (size_t)m * DM, nullptr, nullptr, lane); }
        for (int m = gw; m < MROWS; m += NGW) rms_row_to_bf16(mem_ + (size_t)m * DM, mem_norm_0_, ACAT_ + (size_t)(M + m) * DM, mem_norm_1_, ACAT_ + (size_t)(M + MROWS + m) * DM, lane);
        for (int i = bid * NTHREADS + tid; i < M * 32; i += G * NTHREADS) { const int row = i >> 5, f = i & 31;
            const double ang = (double)positions_[row] * (double)ROPE_INVF[f]; double rv = ang * 0.15915494309189535; rv -= __builtin_rint(rv); const float rf = (float)rv;
            RT_[2 * (size_t)i] = __builtin_amdgcn_cosf(rf); RT_[2 * (size_t)i + 1] = __builtin_amdgcn_sinf(rf); }
    }
#ifdef DUP_P0
    grid.sync();
    {
        FRESH_IDS();
        LAS float* scr = (LAS float*)(lds + wave * 16384);
        constexpr int I_IN0 = 16 * 113, I_MKV = 16 * 16, I_OUT = 16 * 32, I_IN1 = 16 * 112;
        constexpr int NITEMS = I_IN0 + 2 * I_MKV + 2 * I_OUT + I_IN1;
        for (int it = gw; it < NITEMS; it += NGW) {
            int r = it;
            if (r < I_IN0) { p0_transpose_item(w_in_0_, DM, N_IN0, 113, WCAT0_, 0, false, scr, r, lane); continue; } r -= I_IN0;
            if (r < I_MKV) { p0_transpose_item(w_mkv_0_, DM, 512, 16, WCAT0_, N_IN0P, false, scr, r, lane); continue; } r -= I_MKV;
            if (r < I_MKV) { p0_transpose_item(w_mkv_1_, DM, 512, 16, WCAT0_, N_IN0P + 512, false, scr, r, lane); continue; } r -= I_MKV;
            if (r < I_OUT) { p0_transpose_item(w_out_0_, DM, DM, 32, WOUT0_, 0, false, scr, r, lane); continue; } r -= I_OUT;
            if (r < I_OUT) { p0_transpose_item(w_out_1_, DM, DM, 32, WOUT1_, 0, false, scr, r, lane); continue; } r -= I_OUT;
            p0_transpose_item(w_in_1_, DM, N_IN1, 112, WIN1_, 0, true, scr, r, lane);
        }
        { const size_t z0 = (size_t)3616 * DM * 2, z1 = (size_t)N_IN0P * DM * 2;
          for (size_t p = z0 + ((size_t)bid * NTHREADS + tid) * 16; p < z1; p += (size_t)G * NTHREADS * 16) *(v4u*)((unsigned char*)WCAT0_ + p) = (v4u){0u, 0u, 0u, 0u}; }
        for (int i = bid * NTHREADS + tid; i < BATCH * 16 * 768; i += G * NTHREADS) KSUM_[i] = 0.f;
        { int m = gw; for (; m + NGW < M; m += 2 * NGW) rms_row2_to_bf16(x_ + (size_t)m * DM, x_ + (size_t)(m + NGW) * DM, norm_0_, ACAT_ + (size_t)m * DM, ACAT_ + (size_t)(m + NGW) * DM, lane);
          if (m < M) rms_row_to_bf16(x_ + (size_t)m * DM, norm_0_, ACAT_ + (size_t)m * DM, nullptr, nullptr, lane); }
        for (int m = gw; m < MROWS; m += NGW) rms_row_to_bf16(mem_ + (size_t)m * DM, mem_norm_0_, ACAT_ + (size_t)(M + m) * DM, mem_norm_1_, ACAT_ + (size_t)(M + MROWS + m) * DM, lane);
        for (int i = bid * NTHREADS + tid; i < M * 32; i += G * NTHREADS) { const int row = i >> 5, f = i & 31;
            const double ang = (double)positions_[row] * (double)ROPE_INVF[f]; double rv = ang * 0.15915494309189535; rv -= __builtin_rint(rv); const float rf = (float)rv;
            RT_[2 * (size_t)i] = __builtin_amdgcn_cosf(rf); RT_[2 * (size_t)i + 1] = __builtin_amdgcn_sinf(rf); }
    }
#endif
#endif
    xcd_barrier(xbar);
    if (G > (1 << 24)) grid.sync();

#ifndef SKIP_P1
    {
        pg8::Gemm g{ACAT_, WCAT0_, M + 2 * MROWS, N_IN0P + 1024, DM}; OrderX S; S.init(128, 15, G, bid, 32);
        EpiIn0 E{QKV_, Zb_, MQ_, MKV_, BA_};
        pg8::gemm_phase<EpiIn0, OrderX, true, true>(lds, g, S, E, wave_s);
    }
#ifdef DUP_GEMMS
    xcd_barrier(xbar);
    {
        pg8::Gemm g{ACAT_, WCAT0_, M + 2 * MROWS, N_IN0P + 1024, DM}; OrderX S; S.init(128, 15, G, bid, 32);
        EpiIn0 E{QKV_, Zb_, MQ_, MKV_, BA_};
        pg8::gemm_phase<EpiIn0, OrderX, true, true>(lds, g, S, E, wave_s);
    }
#endif
#endif
    xcd_barrier(xbar);

#ifndef SKIP_P2
#ifdef DUP_P2
    p2_delta_prep(lds, G, QKV_, BA_, conv_w_, a_log_, dt_bias_, DQG_, DKDT_, DW_, DU_, DA_, GL_, wave_s, DUP_P2);
    xcd_barrier(xbar);
#endif
    p2_delta_prep(lds, G, QKV_, BA_, conv_w_, a_log_, dt_bias_, DQG_, DKDT_, DW_, DU_, DA_, GL_, wave_s);
#endif
    xcd_barrier(xbar);

#ifndef SKIP_P3
    {
        const int nscan = G < 96 ? G : 96;
#ifdef DUP_P3
        if (bid < nscan) { for (int sq = bid; sq < 96; sq += nscan) p3_scan(lds, sq, DQG_, DKDT_, DW_, DU_, DA_, GL_, Zb_, o_norm_, wave_s, false); }
        xcd_barrier(xbar);
#endif
        if (bid < nscan) { for (int sq = bid; sq < 96; sq += nscan) p3_scan(lds, sq, DQG_, DKDT_, DW_, DU_, DA_, GL_, Zb_, o_norm_, wave_s); }
        const int u0 = (G > 96) ? (bid >= 96 ? bid - 96 : 512) : bid, ustep = (G > 96) ? G - 96 : G;
        for (int u = u0; u < 512; u += ustep) mem_attn_unit(u, 0, lds, (char*)lds_raw, wave_s);
    }
#endif
    xcd_barrier(xbar);

#ifndef SKIP_P4
    {
        pg8::Gemm g{Zb_, WOUT0_, M, DM, DM}; OrderX S; S.init(128, 4, G, bid, 0);
        EpiOutG E{x_, norm_1_, ACAT_, PS_, (LAS float*)(lds + 131072)};
        pg8::gemm_phase<EpiOutG, OrderX, true, true>(lds, g, S, E, wave_s);
    }
#ifdef DUP_GEMMS
    xcd_barrier(xbar);
    {
        pg8::Gemm g{Zb_, WOUT0_, M, DM, DM}; OrderX S; S.init(128, 4, G, bid, 0);
        EpiOutG E{x_, norm_1_, ACAT_, PS_, (LAS float*)(lds + 131072)};
        pg8::gemm_phase<EpiOutG, OrderX, true, true>(lds, g, S, E, wave_s);
    }
#endif
#endif
    xcd_barrier(xbar);


#ifndef SKIP_P6
    {
        pg8::Gemm g{ACAT_, WIN1_, M, N_IN1, DM}; OrderX S; S.init(128, 14, G, bid, 0);
        EpiIn1 E{QKV_, Zb_, MQ_, RT_, KSUM_, PS_};
        pg8::gemm_phase<EpiIn1, OrderX, true, true>(lds, g, S, E, wave_s);
    }
#ifdef DUP_GEMMS
    xcd_barrier(xbar);
    {
        pg8::Gemm g{ACAT_, WIN1_, M, N_IN1, DM}; OrderX S; S.init(128, 14, G, bid, 0);
        EpiIn1 E{QKV_, Zb_, MQ_, RT_, KSUM_, PS_};
        pg8::gemm_phase<EpiIn1, OrderX, true, true>(lds, g, S, E, wave_s);
    }
#endif
#endif
    xcd_barrier(xbar);


#ifndef SKIP_P7
    {
        const int npair = (768 - vcu + G - 1) / G;
#ifdef DUP_P7
        for (int i = 0; i < 2 * npair; ++i) { const int p = vcu + (i >> 1) * G, bh = p >> 3, s = p & 7;
            moba_attn_unit(bh, (i & 1) ? s : 15 - s, lds, (char*)lds_raw, wave_s, true); }
        xcd_barrier(xbar);
#endif
        for (int i = 0; i < 2 * npair; ++i) { const int p = vcu + (i >> 1) * G, bh = p >> 3, s = p & 7;
            moba_attn_unit(bh, (i & 1) ? s : 15 - s, lds, (char*)lds_raw, wave_s); }
        for (int u = vcu; u < 512; u += G) mem_attn_unit(u, 1, lds, (char*)lds_raw, wave_s);
    }
#endif
    xcd_barrier(xbar);

#ifndef SKIP_P8
    {
        pg8::Gemm g{Zb_, WOUT1_, M, DM, DM}; OrderX S; S.init(128, 4, G, bid, 0);
        EpiOutR E{ACAT_, norm_1_, H2B_};
        pg8::gemm_phase<EpiOutR, OrderX, true, true>(lds, g, S, E, wave_s);
    }
#endif
    xcd_barrier(xbar);

#ifdef DUP_SYNC
    for (int i_ = 0; i_ < 20; ++i_) xcd_barrier(xbar);
#endif
#ifndef SKIP_P9
    { FRESH_IDS(); int m = gw; for (; m + NGW < M; m += 2 * NGW) rms_row2_bf16in<false>(H2B_ + (size_t)m * DM, H2B_ + (size_t)(m + NGW) * DM, final_norm_, out_ + (size_t)m * DM, out_ + (size_t)(m + NGW) * DM, lane);
      if (m < M) rms_row2_bf16in<false>(H2B_ + (size_t)m * DM, H2B_ + (size_t)m * DM, final_norm_, out_ + (size_t)m * DM, out_ + (size_t)m * DM, lane); }
#endif
}

extern "C" void kernel_launch(void* const* d_in, const int* in_sizes, int n_in, void* d_out, int out_size, void* d_ws, size_t ws_size, hipStream_t stream) {
    static int grid = 0;
    if (grid == 0) {
        if (n_in != 18 || out_size != M * DM || ws_size < WS_END) { fprintf(stderr, "kernel_launch: unexpected shapes (n_in %d, out %d, ws %zu)\n", n_in, out_size, ws_size); grid = -1; return; }
        int dev = 0, cus = 0, per_cu = 0;
        hipGetDevice(&dev); hipDeviceGetAttribute(&cus, hipDeviceAttributeMultiprocessorCount, dev);
        if (hipFuncSetAttribute((const void*)hybrid_fwd, hipFuncAttributeMaxDynamicSharedMemorySize, LDS_BYTES) != hipSuccess) { fprintf(stderr, "kernel_launch: hipFuncSetAttribute failed\n"); grid = -1; return; }
        if (hipOccupancyMaxActiveBlocksPerMultiprocessor(&per_cu, (const void*)hybrid_fwd, NTHREADS, LDS_BYTES) != hipSuccess || per_cu < 1) { fprintf(stderr, "kernel_launch: occupancy query says %d\n", per_cu); per_cu = 1; }
        (void)hipGetLastError();
        grid = cus * 1;
    }
    if (grid < 0) return;
    if (hipMemsetAsync((char*)d_ws + WS_BAR, 0, 16384, stream) != hipSuccess) { fprintf(stderr, "kernel_launch: memset failed\n"); return; }
    Args a{};
    for (int i = 0; i < 18; ++i) a.in[i] = (const float*)d_in[i];
    a.out = (float*)d_out; a.ws = (unsigned char*)d_ws;
    void* kargs[] = {&a};
    hipError_t e = hipLaunchCooperativeKernel((const void*)hybrid_fwd, dim3(grid), dim3(NTHREADS), kargs, LDS_BYTES, stream);
    if (e != hipSuccess) fprintf(stderr, "kernel_launch: cooperative launch failed: %s (grid %d)\n", hipGetErrorString(e), grid);
}
```

```cpp
#include <hip/hip_runtime.h>
#include <hip/hip_cooperative_groups.h>
#include <hip/hip_bf16.h>
#include <cstdio>
#include <cstdint>
#include <cmath>
namespace pg8 {
#define PG8_LAS __attribute__((address_space(3)))
typedef unsigned short bf16_t;
typedef short bf16x8 __attribute__((ext_vector_type(8)));
typedef float f32x4 __attribute__((ext_vector_type(4)));
typedef unsigned u32x4 __attribute__((ext_vector_type(4)));
constexpr int BM = 256, BK = 64, HALF = 128, HTB = HALF * BK * 2  , STAGE_BYTES = 8 * HTB, NXCD = 8, WGM = 8;

__host__ __device__ __forceinline__ int lds_byte(int r, int c) { const int st = (r >> 4) * 2 + (c >> 5), rr = r & 15, cc = c & 31, ob = rr * 64 + cc * 2; return st * 1024 + (ob ^ (((ob >> 9) & 1) << 5)); }
__host__ __device__ __forceinline__ void stage_rc(int b, int& R, int& C) { const int st = b / 1024, sb = b % 1024, swz = sb ^ (((sb >> 9) & 1) << 5); R = (st >> 1) * 16 + swz / 64; C = (st & 1) * 32 + (swz % 64) / 2; }
__host__ __device__ __forceinline__ int perm32(int rho) { const int n = rho >> 4, i = rho & 15; return 8 * (i >> 2) + 4 * n + (i & 3); }

struct Unit { int pm, pn; };
struct Gemm { const bf16_t* A; const bf16_t* Bt; int M, N, K; };
__device__ __forceinline__ unsigned cvt_pk_bf16(float lo, float hi) { unsigned r; asm volatile("v_cvt_pk_bf16_f32 %0, %1, %2" : "=v"(r) : "v"(lo), "v"(hi)); return r; }
typedef float f32x2 __attribute__((ext_vector_type(2)));
template <class Epi, class Sched, bool ALIGN_EPI = false, bool SP2 = false>
__device__ __forceinline__ void gemm_phase(PG8_LAS unsigned char* lds, const Gemm g, const Sched& S, const Epi& E, const int wave_s) {
    int lane_ = __builtin_amdgcn_mbcnt_hi(~0u, __builtin_amdgcn_mbcnt_lo(~0u, 0u)); asm volatile("" : "+v"(lane_)); const int tid = wave_s * 64 + lane_; const int wid = wave_s, lane = tid & 63, wr = wid >> 2, wc = wid & 3, fr = lane & 15, fq = lane >> 4;
    const int K = g.K, nt = K / BK;
    unsigned voffA[2], voffB[2];
#pragma unroll
    for (int i = 0; i < 2; ++i) { int R, C; stage_rc(tid * 16 + i * 8192, R, C); const int Rb = Epi::PERM ? ((R & ~31) + perm32(R & 31)) : R;
        voffA[i] = (unsigned)(R * K + C) * 2u; voffB[i] = (unsigned)(Rb * K + C) * 2u; }
    const size_t kstep = (size_t)(BK * 2);
    const size_t hstep = (size_t)HALF * K * 2;
    const size_t tstep = 2 * hstep;
    const unsigned ldsw = (unsigned)wid * 1024u;
    const int aoff = lds_byte(wr * 64 + fr, fq * 8), boff = lds_byte(wc * 32 + fr, fq * 8);
#define PG8_SA(b, h) (((b) * 2 + (h)) * HTB)
#define PG8_SB(b, h) ((4 + (b) * 2 + (h)) * HTB)
#define PG8_STAGE(bufoff, gbase, voff) do { _Pragma("unroll") for (int _i = 0; _i < 2; ++_i) \
        __builtin_amdgcn_global_load_lds((const unsigned*)((const char*)(gbase) + (voff)[_i]), (PG8_LAS unsigned*)(lds + (bufoff) + ldsw + _i * 8192), 16, 0, 0); } while (0)
#define PG8_LDA(dst, b, h) do { _Pragma("unroll") for (int m = 0; m < 4; ++m) _Pragma("unroll") for (int k = 0; k < 2; ++k) dst[m][k] = *(const PG8_LAS bf16x8*)(lds + PG8_SA(b, h) + aoff + m * 2048 + k * 1024); } while (0)
#define PG8_LDB(dst, b, h) do { _Pragma("unroll") for (int n = 0; n < 2; ++n) _Pragma("unroll") for (int k = 0; k < 2; ++k) dst[n][k] = *(const PG8_LAS bf16x8*)(lds + PG8_SB(b, h) + boff + n * 2048 + k * 1024); } while (0)
#define PG8_MMA(ai, bj, At, Bt) do { __builtin_amdgcn_s_setprio(1); _Pragma("unroll") for (int m = 0; m < 4; ++m) _Pragma("unroll") for (int n = 0; n < 2; ++n) _Pragma("unroll") for (int k = 0; k < 2; ++k) \
        acc[ai][bj][m][n] = __builtin_amdgcn_mfma_f32_16x16x32_bf16(Bt[n][k], At[m][k], acc[ai][bj][m][n], 0, 0, 0); __builtin_amdgcn_s_setprio(0); } while (0)
#define PG8_WAIT_V(n) asm volatile("s_waitcnt vmcnt(" #n ")" ::: "memory")
#define PG8_WAIT_L(n) asm volatile("s_waitcnt lgkmcnt(" #n ")" ::: "memory")
#define PG8_BAR __builtin_amdgcn_s_barrier()
#define PG8_SCHED __builtin_amdgcn_sched_barrier(0)
    Unit cur, nxt; int ui = 0;
    if (!S.next(0, cur)) return;
    f32x4 acc[2][2][4][2];
#pragma unroll
    for (int a = 0; a < 2; ++a)
#pragma unroll
        for (int b = 0; b < 2; ++b)
#pragma unroll
            for (int m = 0; m < 4; ++m)
#pragma unroll
                for (int n = 0; n < 2; ++n) acc[a][b][m][n] = (f32x4){0.f, 0.f, 0.f, 0.f};
    bf16x8 At[4][2], B0[2][2], B1[2][2];
    const char* cA = (const char*)g.A + (size_t)cur.pm * tstep; const char* cB = (const char*)g.Bt + (size_t)cur.pn * tstep;
    S.a_ready(cur);
    if constexpr (SP2) {
        PG8_STAGE(PG8_SB(0, 0), cB, voffB); PG8_STAGE(PG8_SB(0, 1), cB + hstep, voffB); PG8_STAGE(PG8_SA(0, 0), cA, voffA); PG8_STAGE(PG8_SA(0, 1), cA + hstep, voffA);
        if (wr == 1) PG8_BAR;
        PG8_WAIT_V(2); PG8_BAR;
        PG8_STAGE(PG8_SB(1, 0), cB + kstep, voffB); PG8_STAGE(PG8_SA(1, 0), cA + kstep, voffA); PG8_STAGE(PG8_SB(1, 1), cB + hstep + kstep, voffB);
        PG8_WAIT_V(6); PG8_BAR;
    } else {
        PG8_STAGE(PG8_SB(0, 0), cB, voffB); PG8_STAGE(PG8_SA(0, 0), cA, voffA); PG8_STAGE(PG8_SB(0, 1), cB + hstep, voffB); PG8_STAGE(PG8_SA(0, 1), cA + hstep, voffA);
        if (wr == 1) PG8_BAR;
        PG8_WAIT_V(4); PG8_BAR;
        PG8_STAGE(PG8_SB(1, 0), cB + kstep, voffB); PG8_STAGE(PG8_SA(1, 0), cA + kstep, voffA); PG8_STAGE(PG8_SB(1, 1), cB + hstep + kstep, voffB);
        PG8_WAIT_V(6); PG8_BAR;
    }
    for (;;) {
        const bool has_next = S.next(ui + 1, nxt);
        const char* nA = has_next ? (const char*)g.A + (size_t)nxt.pm * tstep : cA; const char* nB = has_next ? (const char*)g.Bt + (size_t)nxt.pn * tstep : cB;
        for (int t = 0; t < nt; t += 2) {
            const bool last = (t == nt - 2);
            const char* a1 = cA + (size_t)(t + 1) * kstep;
            const char* a2 = last ? nA : cA + (size_t)(t + 2) * kstep; const char* b2 = last ? nB : cB + (size_t)(t + 2) * kstep;
            const char* a3 = a2 + kstep; const char* b3 = b2 + kstep;
            if (last && has_next) S.a_ready(nxt);
            if constexpr (SP2) {
            PG8_LDB(B0, 0, 0); PG8_LDB(B1, 0, 1); PG8_SCHED; PG8_LDA(At, 0, 0); PG8_STAGE(PG8_SA(1, 1), a1 + hstep, voffA);
            PG8_WAIT_V(8); PG8_WAIT_L(0); PG8_BAR; PG8_MMA(0, 0, At, B0); PG8_MMA(0, 1, At, B1); PG8_BAR; PG8_SCHED;
            PG8_LDA(At, 0, 1); PG8_STAGE(PG8_SB(0, 0), b2, voffB); PG8_STAGE(PG8_SB(0, 1), b2 + hstep, voffB); PG8_STAGE(PG8_SA(0, 0), a2, voffA);
            PG8_WAIT_V(8); PG8_WAIT_L(0); PG8_BAR; PG8_MMA(1, 0, At, B0); PG8_MMA(1, 1, At, B1); PG8_BAR; PG8_SCHED;
            PG8_LDB(B0, 1, 0); PG8_LDB(B1, 1, 1); PG8_SCHED; PG8_LDA(At, 1, 0); PG8_STAGE(PG8_SA(0, 1), a2 + hstep, voffA);
            PG8_WAIT_V(8); PG8_WAIT_L(0); PG8_BAR; PG8_MMA(0, 0, At, B0); PG8_MMA(0, 1, At, B1); PG8_BAR; PG8_SCHED;
            PG8_LDA(At, 1, 1); PG8_STAGE(PG8_SB(1, 0), b3, voffB); PG8_STAGE(PG8_SB(1, 1), b3 + hstep, voffB); PG8_STAGE(PG8_SA(1, 0), a3, voffA);
            PG8_WAIT_V(8); PG8_WAIT_L(0); PG8_BAR; PG8_MMA(1, 0, At, B0); PG8_MMA(1, 1, At, B1); PG8_BAR; PG8_SCHED;
            } else {
            PG8_LDB(B0, 0, 0); PG8_SCHED; PG8_LDA(At, 0, 0); PG8_STAGE(PG8_SA(1, 1), a1 + hstep, voffA);
            PG8_WAIT_L(8); PG8_BAR; PG8_WAIT_L(0); PG8_MMA(0, 0, At, B0); PG8_BAR; PG8_SCHED;
            PG8_LDB(B1, 0, 1); PG8_STAGE(PG8_SB(0, 0), b2, voffB);
            PG8_BAR; PG8_WAIT_L(0); PG8_MMA(0, 1, At, B1); PG8_BAR;
            PG8_LDA(At, 0, 1); PG8_STAGE(PG8_SA(0, 0), a2, voffA);
            PG8_BAR; PG8_WAIT_L(0); PG8_MMA(1, 0, At, B0); PG8_BAR; PG8_SCHED;
            PG8_STAGE(PG8_SB(0, 1), b2 + hstep, voffB);
            PG8_WAIT_V(6); PG8_BAR; PG8_MMA(1, 1, At, B1); PG8_BAR;
            PG8_LDB(B0, 1, 0); PG8_SCHED; PG8_LDA(At, 1, 0); PG8_STAGE(PG8_SA(0, 1), a2 + hstep, voffA);
            PG8_WAIT_L(8); PG8_BAR; PG8_WAIT_L(0); PG8_MMA(0, 0, At, B0); PG8_BAR; PG8_SCHED;
            PG8_LDB(B1, 1, 1); PG8_STAGE(PG8_SB(1, 0), b3, voffB);
            PG8_BAR; PG8_WAIT_L(0); PG8_MMA(0, 1, At, B1); PG8_BAR;
            PG8_LDA(At, 1, 1); PG8_STAGE(PG8_SA(1, 0), a3, voffA);
            PG8_BAR; PG8_WAIT_L(0); PG8_MMA(1, 0, At, B0); PG8_BAR; PG8_SCHED;
            PG8_STAGE(PG8_SB(1, 1), b3 + hstep, voffB);
            PG8_WAIT_V(6); PG8_BAR; PG8_MMA(1, 1, At, B1); PG8_BAR;
            }
        }
        if constexpr (ALIGN_EPI) { if (wr == 0) PG8_BAR; }
        if constexpr (!Epi::AFTER_DRAIN) { E(acc, cur, wr, wc, fr, fq); S.done(cur); }
        if (!has_next) break;
#pragma unroll
        for (int a = 0; a < 2; ++a)
#pragma unroll
            for (int b = 0; b < 2; ++b)
#pragma unroll
                for (int m = 0; m < 4; ++m)
#pragma unroll
                    for (int n = 0; n < 2; ++n) acc[a][b][m][n] = (f32x4){0.f, 0.f, 0.f, 0.f};
        cur = nxt; cA = nA; cB = nB; ++ui;
        if constexpr (ALIGN_EPI) { if (wr == 1) PG8_BAR; }
    }
    PG8_WAIT_V(0);
    if constexpr (!ALIGN_EPI) { if (wr == 0) PG8_BAR; }
    PG8_BAR;
    if constexpr (Epi::AFTER_DRAIN) { E.fused(acc, cur, wr, wc, fr, fq, lds, wid, lane); S.done(cur); }
#undef PG8_SA
#undef PG8_SB
#undef PG8_STAGE
#undef PG8_LDA
#undef PG8_LDB
#undef PG8_MMA
#undef PG8_WAIT_V
#undef PG8_WAIT_L
#undef PG8_BAR
#undef PG8_SCHED
}
}
namespace attn_body {
using bf16=__hip_bfloat16;
using bf16x8=__attribute__((ext_vector_type(8)))short;
using s16x4=__attribute__((ext_vector_type(4)))short;
using f32x16=__attribute__((ext_vector_type(16)))float;
using u32x4=__attribute__((ext_vector_type(4)))unsigned;
using f32x4_t=__attribute__((ext_vector_type(4)))float;
__device__ __forceinline__ float bf2f(short v){return __uint_as_float(((unsigned)(unsigned short)v)<<16);}
constexpr int D=64;
constexpr int NW=8,QBLK=32,QB=QBLK*NW,KVBLK=64;
__device__ __forceinline__ int crow(int r,int hi){return (r&3)+8*(r>>2)+4*hi;}
#define SBAR() __builtin_amdgcn_sched_barrier(0)
__device__ __forceinline__ void cmask(f32x16&p0,f32x16&p1,int jb,int qrel,int hi){
  const float NEG=-INFINITY; int kb=64*jb+4*hi;
  #pragma unroll
  for(int r=0;r<16;++r){int kv=kb+(r&3)+8*(r>>2); if(kv>qrel)p0[r]=NEG; if(kv+32>qrel)p1[r]=NEG;}
}

constexpr int NSLOT=3, SLOTB=8192;
constexpr int LDS_K=0, LDS_V=NSLOT*SLOTB, LDS_WS=2*NSLOT*SLOTB, LDS_OST=LDS_WS+NW*64*4, LDS_BYTES=LDS_OST+NW*4096;
constexpr float C2=0.125f*1.4426950408889634f;
__device__ __forceinline__ void glds16(const void*gsrc,unsigned lds_dst){unsigned keep;
  asm volatile("s_mov_b32 %0, m0\n\ts_mov_b32 m0, %2\n\ts_nop 0\n\tglobal_load_lds_dwordx4 %1, off\n\ts_mov_b32 m0, %0":"=&s"(keep):"v"(gsrc),"s"(lds_dst):"memory");}
__device__ __forceinline__ float max3f(float a,float b,float c){float r;asm("v_max3_f32 %0, %1, %2, %3":"=v"(r):"v"(a),"v"(b),"v"(c));return r;}
__device__ __forceinline__ float max2f(float a,float b){float r;asm("v_max_f32_e32 %0, %1, %2":"=v"(r):"v"(a),"v"(b));return r;}
__device__ __forceinline__ float fadd_s(float a,float b){float r;asm("v_add_f32_e32 %0, %1, %2":"=v"(r):"v"(a),"v"(b));return r;}
__device__ __forceinline__ float fsub_s(float a,float b){float r;asm("v_sub_f32_e32 %0, %1, %2":"=v"(r):"v"(a),"v"(b));return r;}
typedef float f32x2_t __attribute__((ext_vector_type(2))); typedef __bf16 bf16x2_t __attribute__((ext_vector_type(2)));
__device__ __forceinline__ unsigned cvtpk_s(float lo,float hi){f32x2_t v={lo,hi};bf16x2_t b=__builtin_convertvector(v,bf16x2_t);return __builtin_bit_cast(unsigned,b);}
#define WAIT_BAR(N) asm volatile("s_waitcnt vmcnt(" #N ") lgkmcnt(0)\n\ts_barrier":::"memory")

__device__ __forceinline__ float wave_max_f(float v){
  #define DPPMX(ctrl) v=__builtin_fmaxf(v,__builtin_bit_cast(float,__builtin_amdgcn_update_dpp(__builtin_bit_cast(int,v),__builtin_bit_cast(int,v),(ctrl),0xf,0xf,false)))
  DPPMX(0xB1); DPPMX(0x4E); DPPMX(0x141); DPPMX(0x140);
  #undef DPPMX
  const int vi=__builtin_bit_cast(int,v);
  return __builtin_fmaxf(__builtin_fmaxf(__builtin_bit_cast(float,__builtin_amdgcn_readlane(vi,0)),__builtin_bit_cast(float,__builtin_amdgcn_readlane(vi,16))),__builtin_fmaxf(__builtin_bit_cast(float,__builtin_amdgcn_readlane(vi,32)),__builtin_bit_cast(float,__builtin_amdgcn_readlane(vi,48))));
}
__device__ __forceinline__ void qkt(f32x16&p0,f32x16&p1,const char*Kslot,const bf16x8*qr,const f32x16&negm,int r32,int hi){
  const char*kb=Kslot+hi*1024+r32*16;
  #pragma unroll
  for(int d0=0;d0<4;++d0){
    const bf16x8 b0=*reinterpret_cast<const bf16x8*>(kb+d0*2048);
    const bf16x8 b1=*reinterpret_cast<const bf16x8*>(kb+d0*2048+512);
    if(d0==0){p0=__builtin_amdgcn_mfma_f32_32x32x16_bf16(b0,qr[0],negm,0,0,0);p1=__builtin_amdgcn_mfma_f32_32x32x16_bf16(b1,qr[0],negm,0,0,0);}
    else{p0=__builtin_amdgcn_mfma_f32_32x32x16_bf16(b0,qr[d0],p0,0,0,0);p1=__builtin_amdgcn_mfma_f32_32x32x16_bf16(b1,qr[d0],p1,0,0,0);}}
}
typedef __attribute__((address_space(3))) const char* lds_cptr;
typedef short v4i16_t __attribute__((ext_vector_type(4)));
__device__ __forceinline__ void kload8(bf16x8*kf,lds_cptr kp){
  kf[0]=*(const __attribute__((address_space(3))) bf16x8*)(kp);      kf[1]=*(const __attribute__((address_space(3))) bf16x8*)(kp+512);
  kf[2]=*(const __attribute__((address_space(3))) bf16x8*)(kp+2048); kf[3]=*(const __attribute__((address_space(3))) bf16x8*)(kp+2560);
  kf[4]=*(const __attribute__((address_space(3))) bf16x8*)(kp+4096); kf[5]=*(const __attribute__((address_space(3))) bf16x8*)(kp+4608);
  kf[6]=*(const __attribute__((address_space(3))) bf16x8*)(kp+6144); kf[7]=*(const __attribute__((address_space(3))) bf16x8*)(kp+6656);
}
__device__ __forceinline__ void kload2(bf16x8*kf,lds_cptr kp,int j){ kf[2*j]=*(const __attribute__((address_space(3))) bf16x8*)(kp+j*2048); kf[2*j+1]=*(const __attribute__((address_space(3))) bf16x8*)(kp+j*2048+512); }
__device__ __forceinline__ s16x4 vtr(lds_cptr p){ return __builtin_bit_cast(s16x4,__builtin_amdgcn_ds_read_tr16_b64_v4i16((__attribute__((address_space(3))) v4i16_t*)p)); }
__device__ __forceinline__ float rowmax(const f32x16&p0,const f32x16&p1){
  float a=max3f(p0[0],p0[1],p1[0]),b=max3f(p0[2],p0[3],p1[1]);a=max3f(a,p1[2],p1[3]);
  #pragma unroll
  for(int r=4;r<16;r+=4){a=max3f(a,p0[r],p0[r+1]);b=max3f(b,p0[r+2],p0[r+3]);a=max3f(a,p1[r],p1[r+1]);b=max3f(b,p1[r+2],p1[r+3]);}
  const float m=max2f(a,b);
  auto rr=__builtin_amdgcn_permlane32_swap(__float_as_uint(m),__float_as_uint(m),false,false);
  return max2f(__uint_as_float(rr[0]),__uint_as_float(rr[1]));
}
__device__ __forceinline__ void pv(f32x16*o,int vb,bf16x8 pa0,bf16x8 pa1,bf16x8 pa2,bf16x8 pa3){
  #pragma unroll
  for(int d0=0;d0<2;++d0){s16x4 lo[4],hi[4];
    #pragma unroll
    for(int ks=0;ks<4;++ks){
      asm volatile("ds_read_b64_tr_b16 %0,%1 offset:%c2":"=&v"(lo[ks]):"v"(vb),"i"(d0*4096+ks*1024):"memory");
      asm volatile("ds_read_b64_tr_b16 %0,%1 offset:%c2":"=&v"(hi[ks]):"v"(vb),"i"(d0*4096+ks*1024+512):"memory");}
    asm volatile("s_waitcnt lgkmcnt(0)":::"memory");SBAR();
    #define PK(k) (bf16x8){lo[k][0],lo[k][1],lo[k][2],lo[k][3],hi[k][0],hi[k][1],hi[k][2],hi[k][3]}
    o[d0]=__builtin_amdgcn_mfma_f32_32x32x16_bf16(pa0,PK(0),o[d0],0,0,0);
    o[d0]=__builtin_amdgcn_mfma_f32_32x32x16_bf16(pa1,PK(1),o[d0],0,0,0);
    o[d0]=__builtin_amdgcn_mfma_f32_32x32x16_bf16(pa2,PK(2),o[d0],0,0,0);
    o[d0]=__builtin_amdgcn_mfma_f32_32x32x16_bf16(pa3,PK(3),o[d0],0,0,0);
    #undef PK
  }
}

#ifndef ATTN_STORE16
#define ATTN_STORE16(p,v) (*(u32x4*)(p)=(v))
#endif
template<int THRL,int MODE,int qp,int kvp,int zp> __device__ __forceinline__ void attn_unit(int NT,const bf16*Qu,const bf16*__restrict__ Kh,const bf16*__restrict__ Vh,bf16*Zu,const float*ksum,int nsel,char*shm,const int wave_s,const bool dry=false,const float*rtq=nullptr){
  int lane=__builtin_amdgcn_mbcnt_hi(~0u,__builtin_amdgcn_mbcnt_lo(~0u,0u)); asm volatile("":"+v"(lane));   const int tid=wave_s*64+lane; (void)tid; const int r32=lane&31,hi=lane>>5; float zf=0.f; asm volatile("":"+v"(zf)); const int wid=wave_s;
  const bf16*Qw=Qu+(long)(wid*QBLK)*qp;
  const unsigned lds0=(unsigned)(uintptr_t)shm;
  float*wsf=(float*)(shm+LDS_WS)+wid*64;
  const bf16*ksrc=Kh+(long)lane*kvp+wid*8;
  const bf16*vsrc=Vh+(long)(16*(wid&3)+(lane>>2))*kvp+(wid>>2)*32+(lane&3)*8;
  const unsigned kdst=lds0+LDS_K+wid*1024, vdst=lds0+LDS_V+wid*1024;
  #define DMA_K(t,slot) glds16(ksrc+(long)(t)*KVBLK*kvp,(unsigned)__builtin_amdgcn_readfirstlane(kdst+(slot)))
  #define DMA_V(t,slot) glds16(vsrc+(long)(t)*KVBLK*kvp,(unsigned)__builtin_amdgcn_readfirstlane(vdst+(slot)))
  const int vb0=(int)(lds0+LDS_V)+((lane>>4)&1)*32+(lane&3)*8+(4*hi+((lane&15)>>2))*64;
  const char*Kbase=shm+LDS_K; bf16x8 kf[8];
  const lds_cptr shm3=(lds_cptr)shm; const lds_cptr kp0=shm3+LDS_K+hi*1024+r32*16; const lds_cptr vp0=shm3+LDS_V+((lane>>4)&1)*32+(lane&3)*8+(4*hi+((lane&15)>>2))*64;
  DMA_K(0,0);DMA_V(0,0);DMA_K(1,SLOTB);
  bf16x8 qr[4];
  #pragma unroll
  for(int d0=0;d0<4;++d0)qr[d0]=*reinterpret_cast<const bf16x8*>(&Qw[(long)r32*qp+d0*16+hi*8]);
  if(MODE==1){ const float*rp_=rtq+(long)(wid*QBLK+r32)*64+8*hi;
    _Pragma("unroll") for(int d0=0;d0<4;++d0){ const f32x4_t t0=*(const f32x4_t*)(rp_+16*d0), t1=*(const f32x4_t*)(rp_+16*d0+4);
      const float a0=bf2f(qr[d0][0]),b0=bf2f(qr[d0][1]),a1=bf2f(qr[d0][2]),b1=bf2f(qr[d0][3]),a2=bf2f(qr[d0][4]),b2=bf2f(qr[d0][5]),a3=bf2f(qr[d0][6]),b3=bf2f(qr[d0][7]);
      u32x4 w_; w_[0]=cvtpk_s((a0*t0[0]-b0*t0[1])*C2,(b0*t0[0]+a0*t0[1])*C2); w_[1]=cvtpk_s((a1*t0[2]-b1*t0[3])*C2,(b1*t0[2]+a1*t0[3])*C2);
      w_[2]=cvtpk_s((a2*t1[0]-b2*t1[1])*C2,(b2*t1[0]+a2*t1[1])*C2); w_[3]=cvtpk_s((a3*t1[2]-b3*t1[3])*C2,(b3*t1[2]+a3*t1[3])*C2); qr[d0]=__builtin_bit_cast(bf16x8,w_); } }
  unsigned selmask=0xffffffffu;
  if(MODE==1){ if(nsel>3){ float v0=-INFINITY,v1=-INFINITY,v2=-INFINITY; int i0=0,i1=0,i2=0;
      for(int j=0;j<nsel;++j){ const float*kp=ksum+(long)j*768+hi*8; float g=0.f;
        _Pragma("unroll") for(int d0=0;d0<4;++d0){ const f32x4_t ka=*(const f32x4_t*)(kp+d0*16), kb=*(const f32x4_t*)(kp+d0*16+4);
          g+=bf2f(qr[d0][0])*ka[0]+bf2f(qr[d0][1])*ka[1]+bf2f(qr[d0][2])*ka[2]+bf2f(qr[d0][3])*ka[3]+bf2f(qr[d0][4])*kb[0]+bf2f(qr[d0][5])*kb[1]+bf2f(qr[d0][6])*kb[2]+bf2f(qr[d0][7])*kb[3]; }
        { auto rr_=__builtin_amdgcn_permlane32_swap(__float_as_uint(g),__float_as_uint(g),false,false); g=__uint_as_float(rr_[0])+__uint_as_float(rr_[1]); }
        if(g>v0){v2=v1;i2=i1;v1=v0;i1=i0;v0=g;i0=j;} else if(g>v1){v2=v1;i2=i1;v1=g;i1=j;} else if(g>v2){v2=g;i2=j;} }
      selmask=(1u<<i0)|(1u<<i1)|(1u<<i2); } }
  float mhat=0.f,l_reg=0.f;f32x16 o[2];_Pragma("unroll") for(int r=0;r<16;++r){o[0][r]=zf;o[1][r]=zf;} const f32x16 negm=f32x16{};
  const int qrel=wid*QBLK+r32;
  #define CMASK(P0,P1,t) do{ if(MODE==1){int jb_=(t)-(NT-4); if(jb_>=0)cmask(P0,P1,jb_,qrel,hi);} }while(0)
  bool resc=false;
  #define START(P0,P1) do{ const float rm=rowmax(P0,P1); resc=false; \
    { const float wm_=wave_max_f(rm); const float dl=(rm==-INFINITY)?((wm_==-INFINITY)?0.f:wm_):rm; mhat=fadd_s(mhat,dl);     \
      _Pragma("unroll") for(int r=0;r<16;++r){P0[r]=fsub_s(P0[r],dl);P1[r]=fsub_s(P1[r],dl);} \
      } \
    _Pragma("unroll") for(int r=0;r<16;++r)P0[r]=__builtin_amdgcn_exp2f(P0[r]); }while(0)
  #define RESC() do{ if(resc){ asm volatile("s_waitcnt lgkmcnt(0)":::"memory"); \
      _Pragma("unroll") for(int d_=0;d_<2;++d_) _Pragma("unroll") for(int r=0;r<16;++r)o[d_][r]*=wsf[crow(r,hi)]; } }while(0)
  f32x16 pA0,pA1,pB0,pB1;
  int sl_prev=0,sl_cur=0,sl_next=SLOTB;
  #define ROT() do{sl_prev=sl_cur;sl_cur=sl_next;sl_next=(sl_next==(NSLOT-1)*SLOTB)?0:sl_next+SLOTB;}while(0)
  DMA_K(2,2*SLOTB);
  WAIT_BAR(3);
  qkt(pA0,pA1,Kbase,qr,negm,r32,hi);asm volatile("s_nop 15\n\ts_nop 7":"+v"(pA0),"+v"(pA1));CMASK(pA0,pA1,0);
  if(MODE==1){ const float ms0=(NT>4&&!(selmask&1u))?INFINITY:0.f; _Pragma("unroll") for(int r=0;r<16;++r){pA0[r]-=ms0;pA1[r]-=ms0;} }
  START(pA0,pA1);
  _Pragma("unroll") for(int r=0;r<16;++r)pA1[r]=__builtin_amdgcn_exp2f(pA1[r]);
  WAIT_BAR(0);
  DMA_K(3,0);DMA_V(1,SLOTB);
  ROT();
  kload8(kf,kp0+sl_cur);
  WAIT_BAR(2);
  s16x4 vlo[8],vhi[8]; u32x4 pw0,pw1,pw2,pw3; f32x16 cin;
  #define PKW(P,B) cvtpk_s(P[B],P[B+1])
  #define PAF(k) __builtin_bit_cast(bf16x8,pw##k)
  #define VFR(i) (bf16x8){vlo[i][0],vlo[i][1],vlo[i][2],vlo[i][3],vhi[i][0],vhi[i][1],vhi[i][2],vhi[i][3]}
  #define PIN(x) asm volatile("":"+v"(x))
  #define MX3(a,b,c) __builtin_fmaxf(__builtin_fmaxf((a),(b)),(c))
  #define GAPA(MF,A0,A1,A2,A3,W0,W1,PW) do{ MF; sacc+=A0; sacc+=A1; sacc+=A2; sacc+=A3; PIN(sacc); W0; W1; PIN(PW); SBAR(); }while(0)
  #define EX(v) __builtin_amdgcn_exp2f(v)
  #define GAPB(MF,X,B) do{ MF; X[B]=EX(X[B]); X[B+1]=EX(X[B+1]); X[B+2]=EX(X[B+2]); X[B+3]=EX(X[B+3]); PIN(X); SBAR(); }while(0)
  #define VRD(i) do{ vlo[i]=vtr(vp_+(((i)>>2)*4096+((i)&3)*1024)); vhi[i]=vtr(vp_+(((i)>>2)*4096+((i)&3)*1024+512)); }while(0)
  #define KRD(G,j) do{ if(G){ kload2(kf,kp0+sl_next,j); SBAR(); } }while(0)
  #define STEP(C0,C1,P0,P1,t,GK,GV,GL) do{ { const float cv_=(MODE==1&&(t)<NT-4&&!((selmask>>((t)>>2))&1u))?-INFINITY:-mhat; _Pragma("unroll") for(int r=0;r<16;++r)cin[r]=cv_; asm volatile("":"+v"(cin)); } SBAR(); \
    const lds_cptr vp_=vp0+sl_prev; \
    VRD(0); SBAR(); float sacc=(P0[0]+P0[1]); \
    GAPA(C0=__builtin_amdgcn_mfma_f32_32x32x16_bf16(kf[0],qr[0],cin,0,0,0), P0[2],P0[3],P0[4],P0[5],     pw0[0]=PKW(P0,0), pw0[1]=PKW(P0,2), pw0); \
    VRD(4); SBAR(); GAPA(C1=__builtin_amdgcn_mfma_f32_32x32x16_bf16(kf[1],qr[0],cin,0,0,0), P0[6],P0[7],P0[8],P0[9],     pw0[2]=PKW(P0,4), pw0[3]=PKW(P0,6), pw0); \
    VRD(1); SBAR(); GAPA(C0=__builtin_amdgcn_mfma_f32_32x32x16_bf16(kf[2],qr[1],C0,0,0,0),   P0[10],P0[11],P0[12],P0[13], pw1[0]=PKW(P0,8), pw1[1]=PKW(P0,10), pw1); \
    VRD(5); SBAR(); GAPA(C1=__builtin_amdgcn_mfma_f32_32x32x16_bf16(kf[3],qr[1],C1,0,0,0),   P0[14],P0[15],P1[0],P1[1],   pw1[2]=PKW(P0,12),pw1[3]=PKW(P0,14), pw1); \
    VRD(2); SBAR(); GAPA(C0=__builtin_amdgcn_mfma_f32_32x32x16_bf16(kf[4],qr[2],C0,0,0,0),   P1[2],P1[3],P1[4],P1[5],     pw2[0]=PKW(P1,0), pw2[1]=PKW(P1,2), pw2); \
    VRD(6); SBAR(); GAPA(C1=__builtin_amdgcn_mfma_f32_32x32x16_bf16(kf[5],qr[2],C1,0,0,0),   P1[6],P1[7],P1[8],P1[9],     pw2[2]=PKW(P1,4), pw2[3]=PKW(P1,6), pw2); \
    VRD(3); SBAR(); GAPA(C0=__builtin_amdgcn_mfma_f32_32x32x16_bf16(kf[6],qr[3],C0,0,0,0),   P1[10],P1[11],P1[12],P1[13], pw3[0]=PKW(P1,8), pw3[1]=PKW(P1,10), pw3); \
    VRD(7); SBAR(); GAPA(C1=__builtin_amdgcn_mfma_f32_32x32x16_bf16(kf[7],qr[3],C1,0,0,0),   P1[14],P1[15],0.f,0.f,       pw3[2]=PKW(P1,12),pw3[3]=PKW(P1,14), pw3); \
    l_reg+=sacc; \
    if(GK){DMA_K((t)+3,sl_cur);} if(GV){DMA_V((t)+1,sl_next);} \
    CMASK(C0,C1,t); \
    { float a=MX3(C0[0],C0[1],C1[0]),b=MX3(C0[2],C0[3],C1[1]); a=MX3(a,C1[2],C1[3]); \
      _Pragma("unroll") for(int r=4;r<16;r+=4){a=MX3(a,C0[r],C0[r+1]);b=MX3(b,C0[r+2],C0[r+3]);a=MX3(a,C1[r],C1[r+1]);b=MX3(b,C1[r+2],C1[r+3]);} \
      float rm=__builtin_fmaxf(a,b); { auto rr=__builtin_amdgcn_permlane32_swap(__float_as_uint(rm),__float_as_uint(rm),false,false); rm=__builtin_fmaxf(__uint_as_float(rr[0]),__uint_as_float(rr[1])); } \
      resc=false; \
      if(__builtin_expect(__any(rm>(float)THRL),0)){ const float dl=__builtin_fmaxf(rm,0.f); mhat+=dl; \
        _Pragma("unroll") for(int r=0;r<16;++r){C0[r]-=dl;C1[r]-=dl;} \
        const float f=__builtin_amdgcn_exp2f(-dl); l_reg*=f; if(hi==0)wsf[r32]=f; resc=true; } } \
    SBAR(); \
    GAPB(o[0]=__builtin_amdgcn_mfma_f32_32x32x16_bf16(PAF(0),VFR(0),o[0],0,0,0), C0,0); \
    GAPB(o[1]=__builtin_amdgcn_mfma_f32_32x32x16_bf16(PAF(0),VFR(4),o[1],0,0,0), C0,4); \
    KRD(GL,0); GAPB(o[0]=__builtin_amdgcn_mfma_f32_32x32x16_bf16(PAF(1),VFR(1),o[0],0,0,0), C0,8); \
    KRD(GL,1); GAPB(o[1]=__builtin_amdgcn_mfma_f32_32x32x16_bf16(PAF(1),VFR(5),o[1],0,0,0), C0,12); \
    KRD(GL,2); GAPB(o[0]=__builtin_amdgcn_mfma_f32_32x32x16_bf16(PAF(2),VFR(2),o[0],0,0,0), C1,0); \
    KRD(GL,3); GAPB(o[1]=__builtin_amdgcn_mfma_f32_32x32x16_bf16(PAF(2),VFR(6),o[1],0,0,0), C1,4); \
    GAPB(o[0]=__builtin_amdgcn_mfma_f32_32x32x16_bf16(PAF(3),VFR(3),o[0],0,0,0), C1,8); \
    GAPB(o[1]=__builtin_amdgcn_mfma_f32_32x32x16_bf16(PAF(3),VFR(7),o[1],0,0,0), C1,12); \
    }while(0)
  int t=1;
  #undef CMASK
  #define CMASK(P0,P1,t) do{ if(MODE==1){int jb_=(t)-(NT-4); if(jb_>=0)cmask(P0,P1,jb_,qrel,hi);} }while(0)
  for(;t+5<NT;t+=2){
    STEP(pB0,pB1,pA0,pA1,t,true,true,true);     WAIT_BAR(2); RESC(); ROT();
    STEP(pA0,pA1,pB0,pB1,t+1,true,true,true);   WAIT_BAR(2); RESC(); ROT();
  }
  #undef CMASK
  #define CMASK(P0,P1,t) do{ if(MODE==1){int jb_=(t)-(NT-4); if(jb_>=0)cmask(P0,P1,jb_,qrel,hi);} }while(0)
  #define ENDW(tt) do{ if((tt)+3<NT){WAIT_BAR(2);} else if((tt)+2<NT){WAIT_BAR(1);} else {WAIT_BAR(0);} }while(0)
  for(;t+1<NT;t+=2){
    STEP(pB0,pB1,pA0,pA1,t,(t+3<NT),(t+1<NT),(t+1<NT));       ENDW(t);   RESC(); ROT();
    STEP(pA0,pA1,pB0,pB1,t+1,(t+4<NT),(t+2<NT),(t+2<NT));     ENDW(t+1); RESC(); ROT();
  }
  STEP(pB0,pB1,pA0,pA1,NT-1,false,false,false); RESC();
  { float sacc=pB0[0]+pB0[1]; _Pragma("unroll") for(int r=2;r<16;++r)sacc+=pB0[r]; _Pragma("unroll") for(int r=0;r<16;++r)sacc+=pB1[r]; l_reg+=sacc;
    pw0=(u32x4){PKW(pB0,0),PKW(pB0,2),PKW(pB0,4),PKW(pB0,6)};pw1=(u32x4){PKW(pB0,8),PKW(pB0,10),PKW(pB0,12),PKW(pB0,14)};pw2=(u32x4){PKW(pB1,0),PKW(pB1,2),PKW(pB1,4),PKW(pB1,6)};pw3=(u32x4){PKW(pB1,8),PKW(pB1,10),PKW(pB1,12),PKW(pB1,14)};
    SBAR(); pv(o,vb0+sl_cur,PAF(0),PAF(1),PAF(2),PAF(3)); }
  #undef PKW
  #undef PAF
  #undef VFR
  #undef PIN
  #undef MX3
  #undef GAPA
  #undef GAPB
  #undef EX
  #undef VRD
  #undef KRD
  #undef STEP
  #undef ENDW
  bf16*Zw=Zu+(long)(wid*QBLK)*zp;
  u32x4 zq[4];
  #pragma unroll
  for(int i=0;i<4;++i)zq[i]=*(const u32x4*)(Zw+(long)(i*8+(lane>>3))*zp+(lane&7)*8);
  {auto rr=__builtin_amdgcn_permlane32_swap(__float_as_uint(l_reg),__float_as_uint(l_reg),false,false);l_reg=__uint_as_float(rr[0])+__uint_as_float(rr[1]);}
  if(hi==0)wsf[32+r32]=l_reg;asm volatile("s_waitcnt lgkmcnt(0)":::"memory");
  float rli[16];
  #pragma unroll
  for(int r=0;r<16;++r)rli[r]=__builtin_amdgcn_rcpf(wsf[32+crow(r,hi)]);
  { bf16*stg=(bf16*)(shm+LDS_OST)+wid*2048;
    #pragma unroll
    for(int r=0;r<16;++r){const int orow=crow(r,hi);
      #pragma unroll
      for(int d0=0;d0<2;++d0)stg[orow*64+d0*32+r32]=__float2bfloat16(o[d0][r]*rli[r]);}
    asm volatile("s_waitcnt lgkmcnt(0)":::"memory");
    #pragma unroll
    for(int i=0;i<4;++i){const int row=i*8+(lane>>3),ch=lane&7; const u32x4 v=*(const u32x4*)(stg+row*64+ch*8); u32x4*zpz=(u32x4*)(Zw+(long)row*zp+ch*8); const u32x4 zz=zq[i]; u32x4 yy;
      _Pragma("unroll") for(int e=0;e<4;++e){ const float o0=__uint_as_float(v[e]<<16),o1=__uint_as_float(v[e]&0xffff0000u),z0=__uint_as_float(zz[e]<<16),z1=__uint_as_float(zz[e]&0xffff0000u);
        yy[e]=cvtpk_s(o0*z0*__builtin_amdgcn_rcpf(1.f+__expf(-z0)),o1*z1*__builtin_amdgcn_rcpf(1.f+__expf(-z1))); }
      if(!dry)*zpz=yy;} }
  asm volatile("s_waitcnt lgkmcnt(0)\n\ts_barrier":::"memory");
  #undef DMA_K
  #undef DMA_V
  #undef CMASK
  #undef START
  #undef RESC
  #undef ROT
}
constexpr int ATTN_LDS_BYTES=LDS_BYTES;
#undef SBAR
#undef WAIT_BAR
}
namespace cg = cooperative_groups;
constexpr int BATCH = 8, SEQ = 4096, DM = 1024, M = BATCH * SEQ;
constexpr int NMEM = 256, MROWS = BATCH * NMEM;
constexpr int N_IN0 = 3608, N_IN0P = 3840, N_IN1 = 3584;
constexpr int NUNIT_D = BATCH * 12 * 64;
constexpr float C2 = 0.125f * 1.4426950408889634f;
constexpr float EPS = 1e-6f;
constexpr int NTHREADS = 512;
constexpr int LDS_BYTES = 161792 + 512;
constexpr size_t MiB = 1u << 20;
constexpr size_t WS_KSUM = 0;
constexpr size_t WS_GL = 512 * 1024;
constexpr size_t WS_WCAT0 = 2 * MiB;
constexpr size_t WS_WOUT0 = 12 * MiB, WS_WIN1 = 14 * MiB, WS_WOUT1 = 21 * MiB;
constexpr size_t WS_ROPE = 24 * MiB;
constexpr size_t WS_ACAT = 32 * MiB;
constexpr size_t WS_MKV = 104 * MiB;
constexpr size_t WS_QKV = 108 * MiB;
constexpr size_t WS_Z = 252 * MiB;
constexpr size_t WS_MQ = 316 * MiB;
constexpr size_t WS_BA = 332 * MiB;
constexpr size_t WS_DW = WS_ACAT;
constexpr size_t WS_DU = 336 * MiB, WS_DA = 384 * MiB;
constexpr size_t WS_PS = 432 * MiB;
constexpr size_t WS_END = 434 * MiB;

#define LAS __attribute__((address_space(3)))
typedef unsigned short bf16;
typedef unsigned v4u __attribute__((ext_vector_type(4)));
typedef unsigned v2u __attribute__((ext_vector_type(2)));
typedef float f32x4 __attribute__((ext_vector_type(4)));
typedef float f32x2v __attribute__((ext_vector_type(2)));
typedef __bf16 bf16x2v __attribute__((ext_vector_type(2)));
typedef short bf16x8 __attribute__((ext_vector_type(8)));
#define LDS_WAIT() asm volatile("s_waitcnt lgkmcnt(0)" ::: "memory")
__device__ __forceinline__ unsigned pk2(float lo, float hi) { f32x2v v = {lo, hi}; bf16x2v b = __builtin_convertvector(v, bf16x2v); return __builtin_bit_cast(unsigned, b); }
__device__ __forceinline__ float bflo(unsigned u) { return __uint_as_float(u << 16); }
__device__ __forceinline__ float bfhi(unsigned u) { return __uint_as_float(u & 0xffff0000u); }
__device__ __forceinline__ float bf1(bf16 u) { return __uint_as_float(((unsigned)u) << 16); }
__device__ __forceinline__ float dppf(float v, const int ctrl_dummy);
#define DPP_ADD(v, ctrl) ((v) + __builtin_bit_cast(float, __builtin_amdgcn_update_dpp(0, __builtin_bit_cast(int, (v)), (ctrl), 0xf, 0xf, true)))
__device__ __forceinline__ float row8_sum(float v) { v = DPP_ADD(v, 0xB1); v = DPP_ADD(v, 0x4E); v = DPP_ADD(v, 0x141); return v; }
__device__ __forceinline__ float row16_sum(float v) { v = row8_sum(v); v = DPP_ADD(v, 0x140); return v; }
__device__ __forceinline__ float wave_sum(float v) {
    v = row16_sum(v); const int vi = __builtin_bit_cast(int, v);
    return (__builtin_bit_cast(float, __builtin_amdgcn_readlane(vi, 0)) + __builtin_bit_cast(float, __builtin_amdgcn_readlane(vi, 16))) + (__builtin_bit_cast(float, __builtin_amdgcn_readlane(vi, 32)) + __builtin_bit_cast(float, __builtin_amdgcn_readlane(vi, 48)));
}
__device__ __forceinline__ float silu_f(float x) { return x * __builtin_amdgcn_rcpf(1.f + __expf(-x)); }
__device__ const float ROPE_INVF[32] = {1.000000000e+00f, 7.498942614e-01f, 5.623413324e-01f, 4.216965139e-01f, 3.162277639e-01f, 2.371373773e-01f, 1.778279394e-01f, 1.333521307e-01f, 1.000000015e-01f, 7.498941571e-02f, 5.623413250e-02f, 4.216965288e-02f, 3.162277490e-02f, 2.371373773e-02f, 1.778279431e-02f, 1.333521493e-02f, 9.999999776e-03f, 7.498941850e-03f, 5.623413250e-03f, 4.216964822e-03f, 3.162277630e-03f, 2.371373586e-03f, 1.778279431e-03f, 1.333521446e-03f, 1.000000047e-03f, 7.498942432e-04f, 5.623413017e-04f, 4.216965172e-04f, 3.162277571e-04f, 2.371373703e-04f, 1.778279402e-04f, 1.333521504e-04f};

struct OrderX {
    int nM, nN, nwg, G, c, nextra;
    __device__ void init(int nM_, int nN_, int G_, int c_, int nextra_) { nM = nM_; nN = nN_; nwg = nM * nN; G = G_; c = c_; nextra = nextra_; }
    __device__ bool next(int i, pg8::Unit& u) const {
        const long L = (long)i * G + c; if (L >= nwg + nextra) return false;
        if (L >= nwg) { const int e = (int)L - nwg, layer = e >> 4; u.pm = 128 + 8 * layer + ((e & 15) >> 1); u.pn = 15 + 2 * layer + (e & 1); return true; }
        int wgid = (int)L; { const int q = nwg / pg8::NXCD, r = nwg % pg8::NXCD, xcd = wgid % pg8::NXCD, off = wgid / pg8::NXCD; wgid = (xcd < r ? xcd * (q + 1) : r * (q + 1) + (xcd - r) * q) + off; }
        const int nig = pg8::WGM * nN, gid = wgid / nig, fm = gid * pg8::WGM, gsz = (nM - fm) < pg8::WGM ? (nM - fm) : pg8::WGM;
        u.pm = fm + ((wgid % nig) % gsz); u.pn = (wgid % nig) / gsz; return true;
    }
    __device__ __forceinline__ void a_ready(const pg8::Unit&) const {}
    __device__ __forceinline__ void done(const pg8::Unit&) const {}
};
struct EpiIn0 {
    static constexpr bool PERM = true, AFTER_DRAIN = false;
    bf16 *QKV, *Z, *MQ, *MKV; float* BA;
    __device__ __forceinline__ void operator()(const f32x4 (&acc)[2][2][4][2], const pg8::Unit& u, int wr, int wc, int fr_in, int fq_in) const {
        int fr = fr_in, fq = fq_in; asm volatile("" : "+v"(fr), "+v"(fq));
        const int pm = u.pm, pn = u.pn; bf16* base = QKV; int ld = 2304, colt = pn * 256, rowt = pm * 256; float sc = 1.f; bool isba = false;
        if (pm < 128) {
            if (pn < 9) {}
            else if (pn < 13) { base = Z; ld = 1024; colt = (pn - 9) * 256; }
            else if (pn == 13) { base = MQ; ld = 256; colt = 0; sc = C2; }
            else isba = true;
        } else { const int layer = (pm - 128) >> 3; base = MKV + (size_t)layer * (MROWS * 512); ld = 512; colt = (pn - 15 - 2 * layer) * 256; rowt = (pm - 128 - 8 * layer) * 256; }
        const int row0 = rowt + wr * 64 + fr, col0 = colt + wc * 32 + 8 * fq;
        if (!isba) {
#pragma unroll
            for (int ai = 0; ai < 2; ++ai)
#pragma unroll
                for (int m = 0; m < 4; ++m) { bf16* rowp = base + (unsigned)((row0 + ai * 128 + m * 16) * ld + col0);
#pragma unroll
                    for (int bj = 0; bj < 2; ++bj) { const f32x4 v0 = acc[ai][bj][m][0] * sc, v1 = acc[ai][bj][m][1] * sc; v4u w; w.x = pk2(v0[0], v0[1]); w.y = pk2(v0[2], v0[3]); w.z = pk2(v1[0], v1[1]); w.w = pk2(v1[2], v1[3]);
                        *(v4u*)(rowp + bj * 128) = w; } }
        } else if (wc == 0) {
#pragma unroll
            for (int ai = 0; ai < 2; ++ai)
#pragma unroll
                for (int m = 0; m < 4; ++m) { float* p = BA + (unsigned)((row0 + ai * 128 + m * 16) * 32 + 8 * fq); *(f32x4*)p = acc[ai][0][m][0]; *(f32x4*)(p + 4) = acc[ai][0][m][1]; }
        }
    }
};
__device__ __forceinline__ float row_rstd(const float* PS, int row) {
    const f32x4 p = *(const f32x4*)(PS + (unsigned)(row * 4));
    return rsqrtf(((p[0] + p[1]) + (p[2] + p[3])) * (1.f / DM) + EPS);
}
struct EpiIn1 {
    static constexpr bool PERM = true, AFTER_DRAIN = false;
    bf16 *QKV, *Z, *MQ; const float* RT; float* KSUM; const float* PS;
    __device__ __forceinline__ void operator()(const f32x4 (&acc)[2][2][4][2], const pg8::Unit& u, int wr, int wc, int fr_in, int fq_in) const {
        int fr = fr_in, fq = fq_in, pm = u.pm, pn = u.pn; asm volatile("" : "+v"(fr), "+v"(fq), "+s"(pm), "+s"(pn));
        float rsr[2][4];
#pragma unroll
        for (int ai = 0; ai < 2; ++ai)
#pragma unroll
            for (int m = 0; m < 4; ++m) rsr[ai][m] = row_rstd(PS, pm * 256 + wr * 64 + fr + ai * 128 + m * 16);
        if (pn >= 3 && pn < 6) {
            bf16* base = QKV + (size_t)M * 768; const int colt = (pn - 3) * 256;
            const int row0 = pm * 256 + wr * 64 + fr, col0 = colt + wc * 32 + 8 * fq, i0 = (wc & 1) * 16 + 4 * fq;
#pragma unroll
            for (int bj = 0; bj < 2; ++bj) { float cs[8];
#pragma unroll
                for (int e = 0; e < 8; ++e) cs[e] = 0.f;
#pragma unroll
                for (int ai = 0; ai < 2; ++ai)
#pragma unroll
                    for (int m = 0; m < 4; ++m) { const int row = row0 + ai * 128 + m * 16;
                        const f32x4 t0 = *(const f32x4*)(RT + (unsigned)(row * 64 + 2 * i0)), t1 = *(const f32x4*)(RT + (unsigned)(row * 64 + 2 * i0 + 4));
                        const float rs = rsr[ai][m];
                        const f32x4 v0 = acc[ai][bj][m][0] * rs, v1 = acc[ai][bj][m][1] * rs; float o[8];
                        o[0] = v0[0] * t0[0] - v0[1] * t0[1]; o[1] = v0[1] * t0[0] + v0[0] * t0[1]; o[2] = v0[2] * t0[2] - v0[3] * t0[3]; o[3] = v0[3] * t0[2] + v0[2] * t0[3];
                        o[4] = v1[0] * t1[0] - v1[1] * t1[1]; o[5] = v1[1] * t1[0] + v1[0] * t1[1]; o[6] = v1[2] * t1[2] - v1[3] * t1[3]; o[7] = v1[3] * t1[2] + v1[2] * t1[3];
#pragma unroll
                        for (int e = 0; e < 8; ++e) cs[e] += o[e];
                        v4u w; w.x = pk2(o[0], o[1]); w.y = pk2(o[2], o[3]); w.z = pk2(o[4], o[5]); w.w = pk2(o[6], o[7]);
                        *(v4u*)(base + (unsigned)(row * 768 + col0 + bj * 128)) = w;
                        asm volatile("" ::: "memory"); }
#pragma unroll
                for (int e = 0; e < 8; ++e) { const float sm = row16_sum(cs[e]); if (fr == 0) atomicAdd(KSUM + (unsigned)(pm * 768 + colt + bj * 128 + wc * 32 + 8 * fq + e), sm); }
            }
        } else {
            bf16* base; int ld = 768, colt; float sc = 1.f;
            if (pn < 9) { const int t = pn / 3; base = QKV + (size_t)t * M * 768; colt = (pn - 3 * t) * 256; }
            else if (pn < 13) { base = Z; ld = 1024; colt = (pn - 9) * 256; }
            else { base = MQ; ld = 256; colt = 0; sc = C2; }
            const int row0 = pm * 256 + wr * 64 + fr, col0 = colt + wc * 32 + 8 * fq;
#pragma unroll
            for (int ai = 0; ai < 2; ++ai)
#pragma unroll
                for (int m = 0; m < 4; ++m) { const int row = row0 + ai * 128 + m * 16; bf16* rowp = base + (unsigned)(row * ld + col0); const float rs = rsr[ai][m] * sc;
#pragma unroll
                    for (int bj = 0; bj < 2; ++bj) { const f32x4 v0 = acc[ai][bj][m][0] * rs, v1 = acc[ai][bj][m][1] * rs; v4u w; w.x = pk2(v0[0], v0[1]); w.y = pk2(v0[2], v0[3]); w.z = pk2(v1[0], v1[1]); w.w = pk2(v1[2], v1[3]);
                        *(v4u*)(rowp + bj * 128) = w; }
                    if (m & 1) asm volatile("" ::: "memory"); }
        }
    }
};
__device__ __forceinline__ void p6b_rope(LAS unsigned char* lds, int G, bf16* K, const float* __restrict__ RT, float* KSUM, const int wave_s) {
    int lane_ = __builtin_amdgcn_mbcnt_hi(~0u, __builtin_amdgcn_mbcnt_lo(~0u, 0u)); asm volatile("" : "+v"(lane_)); const int tid = wave_s * 64 + lane_;
    LAS float* red = (LAS float*)lds;
    for (int u = blockIdx.x; u < 256; u += G) {
        const int pm = u >> 1, ch = u & 1;
        float cs[8];
#pragma unroll
        for (int e = 0; e < 8; ++e) cs[e] = 0.f;
        const int cc = tid % 48, rg = tid / 48, col = 384 * ch + 8 * cc, i0 = ((col & 63) >> 1);
        if (tid < 384) {
#pragma unroll 4
            for (int rr = 0; rr < 32; ++rr) { const int row = pm * 256 + rg * 32 + rr; v4u* p = (v4u*)(K + (unsigned)(row * 768 + col)); const v4u w = *p;
                const f32x4 t0 = *(const f32x4*)(RT + (unsigned)(row * 64 + 2 * i0)), t1 = *(const f32x4*)(RT + (unsigned)(row * 64 + 2 * i0 + 4)); float o[8];
                { const float a = bflo(w.x), b = bfhi(w.x); o[0] = a * t0[0] - b * t0[1]; o[1] = b * t0[0] + a * t0[1]; }
                { const float a = bflo(w.y), b = bfhi(w.y); o[2] = a * t0[2] - b * t0[3]; o[3] = b * t0[2] + a * t0[3]; }
                { const float a = bflo(w.z), b = bfhi(w.z); o[4] = a * t1[0] - b * t1[1]; o[5] = b * t1[0] + a * t1[1]; }
                { const float a = bflo(w.w), b = bfhi(w.w); o[6] = a * t1[2] - b * t1[3]; o[7] = b * t1[2] + a * t1[3]; }
#pragma unroll
                for (int e = 0; e < 8; ++e) cs[e] += o[e];
                v4u y; y.x = pk2(o[0], o[1]); y.y = pk2(o[2], o[3]); y.z = pk2(o[4], o[5]); y.w = pk2(o[6], o[7]); *p = y; }
#pragma unroll
            for (int e = 0; e < 8; ++e) red[rg * 384 + cc * 8 + e] = cs[e];
        }
        __syncthreads();
        if (tid < 384) { float s = 0.f;
#pragma unroll
            for (int g8 = 0; g8 < 8; ++g8) s += red[g8 * 384 + tid];
            KSUM[(unsigned)(pm * 768 + 384 * ch + tid)] = s; }
        __syncthreads();
    }
}
struct EpiOutG {
    static constexpr bool PERM = true, AFTER_DRAIN = false;
    const float* resid; const float* gain; bf16* XN; float* PS; LAS float* xl;
    __device__ __forceinline__ void operator()(const f32x4 (&acc)[2][2][4][2], const pg8::Unit& u, int wr, int wc_in, int fr_in, int fq_in) const {
        int fr = fr_in, fq = fq_in, wc = wc_in, pm = u.pm, pn = u.pn; asm volatile("" : "+v"(fr), "+v"(fq), "+s"(pm), "+s"(pn), "+s"(wc));
        const int row0 = pm * 256 + wr * 64 + fr, col0 = pn * 256 + wc * 32 + 8 * fq;
        f32x4 gv[2][2];
#pragma unroll
        for (int bj = 0; bj < 2; ++bj) { gv[bj][0] = *(const f32x4*)(gain + col0 + bj * 128); gv[bj][1] = *(const f32x4*)(gain + col0 + bj * 128 + 4); }
#pragma unroll
        for (int ai = 0; ai < 2; ++ai)
#pragma unroll
            for (int m = 0; m < 4; ++m) { const int row = row0 + ai * 128 + m * 16; const unsigned off = (unsigned)(row * DM + col0); float ss = 0.f;
#pragma unroll
                for (int bj = 0; bj < 2; ++bj) { const f32x4 r0 = *(const f32x4*)(resid + off + bj * 128), r1 = *(const f32x4*)(resid + off + bj * 128 + 4);
                    const f32x4 h0 = r0 + acc[ai][bj][m][0], h1 = r1 + acc[ai][bj][m][1];
                    ss += ((h0[0] * h0[0] + h0[1] * h0[1]) + (h0[2] * h0[2] + h0[3] * h0[3])) + ((h1[0] * h1[0] + h1[1] * h1[1]) + (h1[2] * h1[2] + h1[3] * h1[3]));
                    const f32x4 y0 = h0 * gv[bj][0], y1 = h1 * gv[bj][1]; v4u w; w.x = pk2(y0[0], y0[1]); w.y = pk2(y0[2], y0[3]); w.z = pk2(y1[0], y1[1]); w.w = pk2(y1[2], y1[3]);
                    *(v4u*)(XN + off + bj * 128) = w; }
                ss += __shfl_xor(ss, 16); ss += __shfl_xor(ss, 32);
                if (fq == 0) xl[(wr * 4 + wc) * 128 + ai * 64 + m * 16 + fr] = ss;
                if (m & 1) asm volatile("" ::: "memory"); }
        asm volatile("s_waitcnt lgkmcnt(0)\n\ts_barrier" ::: "memory");
        { const int ln = fq * 16 + fr; if (ln < 32) { const int rsl = wc * 32 + ln;
              const float tot = (xl[(wr * 4 + 0) * 128 + rsl] + xl[(wr * 4 + 1) * 128 + rsl]) + (xl[(wr * 4 + 2) * 128 + rsl] + xl[(wr * 4 + 3) * 128 + rsl]);
              const int row = pm * 256 + (rsl >> 6) * 128 + wr * 64 + (rsl & 63); PS[(unsigned)(row * 4 + pn)] = tot; } }
        asm volatile("s_waitcnt lgkmcnt(0)\n\ts_barrier" ::: "memory");
    }
};
struct EpiOutR {
    static constexpr bool PERM = true, AFTER_DRAIN = false;
    const bf16* XN; const float* gain; bf16* hb;
    __device__ __forceinline__ void operator()(const f32x4 (&acc)[2][2][4][2], const pg8::Unit& u, int wr, int wc, int fr_in, int fq_in) const {
        int fr = fr_in, fq = fq_in, pm = u.pm, pn = u.pn; asm volatile("" : "+v"(fr), "+v"(fq), "+s"(pm), "+s"(pn));
        const int row0 = pm * 256 + wr * 64 + fr, col0 = pn * 256 + wc * 32 + 8 * fq;
        f32x4 gi[2][2];
#pragma unroll
        for (int bj = 0; bj < 2; ++bj)
#pragma unroll
            for (int t = 0; t < 2; ++t) { const f32x4 g = *(const f32x4*)(gain + col0 + bj * 128 + 4 * t); gi[bj][t] = (f32x4){__builtin_amdgcn_rcpf(g[0]), __builtin_amdgcn_rcpf(g[1]), __builtin_amdgcn_rcpf(g[2]), __builtin_amdgcn_rcpf(g[3])}; }
#pragma unroll
        for (int ai = 0; ai < 2; ++ai)
#pragma unroll
            for (int m = 0; m < 4; ++m) { const unsigned off = (unsigned)((row0 + ai * 128 + m * 16) * DM + col0);
#pragma unroll
                for (int bj = 0; bj < 2; ++bj) { const v4u rb = *(const v4u*)(XN + off + bj * 128);
                    const f32x4 r0 = (f32x4){bflo(rb.x), bfhi(rb.x), bflo(rb.y), bfhi(rb.y)} * gi[bj][0], r1 = (f32x4){bflo(rb.z), bfhi(rb.z), bflo(rb.w), bfhi(rb.w)} * gi[bj][1];
                    const f32x4 h0 = r0 + acc[ai][bj][m][0], h1 = r1 + acc[ai][bj][m][1]; v4u w; w.x = pk2(h0[0], h0[1]); w.y = pk2(h0[2], h0[3]); w.z = pk2(h1[0], h1[1]); w.w = pk2(h1[2], h1[3]);
                    *(v4u*)(hb + off + bj * 128) = w; } }
    }
};
template <bool RESID_BF16> struct EpiOutB {
    static constexpr bool PERM = true, AFTER_DRAIN = false;
    const void* resid; bf16* hb;
    __device__ __forceinline__ void operator()(const f32x4 (&acc)[2][2][4][2], const pg8::Unit& u, int wr, int wc, int fr_in, int fq_in) const {
        int fr = fr_in, fq = fq_in, pm = u.pm, pn = u.pn; asm volatile("" : "+v"(fr), "+v"(fq), "+s"(pm), "+s"(pn));
        const int row0 = pm * 256 + wr * 64 + fr, col0 = pn * 256 + wc * 32 + 8 * fq;
#pragma unroll
        for (int ai = 0; ai < 2; ++ai)
#pragma unroll
            for (int m = 0; m < 4; ++m) { const unsigned off = (unsigned)((row0 + ai * 128 + m * 16) * DM + col0);
#pragma unroll
                for (int bj = 0; bj < 2; ++bj) { f32x4 r0, r1;
                    if (RESID_BF16) { const v4u rb = *(const v4u*)((const bf16*)resid + off + bj * 128); r0 = (f32x4){bflo(rb.x), bfhi(rb.x), bflo(rb.y), bfhi(rb.y)}; r1 = (f32x4){bflo(rb.z), bfhi(rb.z), bflo(rb.w), bfhi(rb.w)}; }
                    else { r0 = *(const f32x4*)((const float*)resid + off + bj * 128); r1 = *(const f32x4*)((const float*)resid + off + bj * 128 + 4); }
                    const f32x4 h0 = r0 + acc[ai][bj][m][0], h1 = r1 + acc[ai][bj][m][1]; v4u w; w.x = pk2(h0[0], h0[1]); w.y = pk2(h0[2], h0[3]); w.z = pk2(h1[0], h1[1]); w.w = pk2(h1[2], h1[3]);
                    *(v4u*)(hb + off + bj * 128) = w; } }
    }
};
struct EpiOut {
    static constexpr bool PERM = true, AFTER_DRAIN = false;
    const float* resid; float* out;
    __device__ __forceinline__ void operator()(const f32x4 (&acc)[2][2][4][2], const pg8::Unit& u, int wr, int wc, int fr_in, int fq_in) const {
        int fr = fr_in, fq = fq_in; asm volatile("" : "+v"(fr), "+v"(fq));
        const int row0 = u.pm * 256 + wr * 64 + fr, col0 = u.pn * 256 + wc * 32 + 8 * fq;
#pragma unroll
        for (int ai = 0; ai < 2; ++ai)
#pragma unroll
            for (int m = 0; m < 4; ++m) { const unsigned off = (unsigned)((row0 + ai * 128 + m * 16) * DM + col0);
#pragma unroll
                for (int bj = 0; bj < 2; ++bj) { const f32x4 r0 = *(const f32x4*)(resid + off + bj * 128), r1 = *(const f32x4*)(resid + off + bj * 128 + 4);
                    *(f32x4*)(out + off + bj * 128) = r0 + acc[ai][bj][m][0]; *(f32x4*)(out + off + bj * 128 + 4) = r1 + acc[ai][bj][m][1]; } }
    }
};
struct EpiOutN {
    static constexpr bool PERM = true, AFTER_DRAIN = false;
    const float* resid; float* out; const float* gain; bf16* XN; float* PS;
    __device__ __forceinline__ void operator()(const f32x4 (&acc)[2][2][4][2], const pg8::Unit& u, int wr, int wc, int fr_in, int fq_in) const {
        int fr = fr_in, fq = fq_in; asm volatile("" : "+v"(fr), "+v"(fq));
        const int row0 = u.pm * 256 + wr * 64 + fr, col0 = u.pn * 256 + wc * 32 + 8 * fq;
        f32x4 gv[2][2];
#pragma unroll
        for (int bj = 0; bj < 2; ++bj) { gv[bj][0] = *(const f32x4*)(gain + col0 + bj * 128); gv[bj][1] = *(const f32x4*)(gain + col0 + bj * 128 + 4); }
#pragma unroll
        for (int ai = 0; ai < 2; ++ai)
#pragma unroll
            for (int m = 0; m < 4; ++m) { const int row = row0 + ai * 128 + m * 16; const unsigned off = (unsigned)(row * DM + col0); float ss = 0.f;
#pragma unroll
                for (int bj = 0; bj < 2; ++bj) { const f32x4 r0 = *(const f32x4*)(resid + off + bj * 128), r1 = *(const f32x4*)(resid + off + bj * 128 + 4);
                    const f32x4 h0 = r0 + acc[ai][bj][m][0], h1 = r1 + acc[ai][bj][m][1];
                    *(f32x4*)(out + off + bj * 128) = h0; *(f32x4*)(out + off + bj * 128 + 4) = h1;
                    ss += (h0[0] * h0[0] + h0[1] * h0[1]) + (h0[2] * h0[2] + h0[3] * h0[3]) + (h1[0] * h1[0] + h1[1] * h1[1]) + (h1[2] * h1[2] + h1[3] * h1[3]);
                    const f32x4 y0 = h0 * gv[bj][0], y1 = h1 * gv[bj][1]; v4u w; w.x = pk2(y0[0], y0[1]); w.y = pk2(y0[2], y0[3]); w.z = pk2(y1[0], y1[1]); w.w = pk2(y1[2], y1[3]);
                    *(v4u*)(XN + off + bj * 128) = w; }
                ss += __shfl_xor(ss, 16); ss += __shfl_xor(ss, 32);
                if (fq == 0) PS[(unsigned)(row * 16 + u.pn * 4 + wc)] = ss;
                if (m & 1) asm volatile("" ::: "memory"); }
    }
};

__device__ __forceinline__ int rope_row(int n) { const int d = n & 63; return (n - d) + ((d < 32) ? 2 * d : 2 * (d - 32) + 1); }
__device__ __forceinline__ void p0_transpose_item(const float* W, int K, int N, int nblk, bf16* WT, int row_off, bool ropeperm, LAS float* scr, int item, int lane) {
    const int kb = item / nblk, nb = item % nblk, k0 = 64 * kb, n0 = 32 * nb;
    const int nn = n0 + (lane & 31);
#pragma unroll 8
    for (int i = 0; i < 32; ++i) { const int kk = 2 * i + (lane >> 5); scr[kk * 33 + (lane & 31)] = (nn < N) ? W[(size_t)(k0 + kk) * N + nn] : 0.f; }
    LDS_WAIT(); asm volatile("" ::: "memory");
    const int c = lane & 7;
#pragma unroll
    for (int j = 0; j < 4; ++j) { const int nl = (lane >> 3) + 8 * j; const LAS float* s = scr + (8 * c) * 33 + nl; int n = n0 + nl; if (ropeperm && n < 1536) n = rope_row(n);
        v4u o; o.x = pk2(s[0 * 33], s[1 * 33]); o.y = pk2(s[2 * 33], s[3 * 33]); o.z = pk2(s[4 * 33], s[5 * 33]); o.w = pk2(s[6 * 33], s[7 * 33]);
        *(v4u*)(WT + (size_t)(row_off + n) * K + k0 + 8 * c) = o; }
    LDS_WAIT(); asm volatile("" ::: "memory");
}
__device__ __forceinline__ void rms_row_to_bf16(const float* xrow, const float* g0, bf16* o0, const float* g1, bf16* o1, int lane) {
    const f32x4* xr = (const f32x4*)xrow + lane; f32x4 v[4]; float s = 0.f;
#pragma unroll
    for (int j = 0; j < 4; ++j) { v[j] = xr[64 * j]; s += (v[j].x * v[j].x + v[j].y * v[j].y) + (v[j].z * v[j].z + v[j].w * v[j].w); }
    const float rstd = rsqrtf(wave_sum(s) * (1.f / DM) + EPS);
#pragma unroll
    for (int j = 0; j < 4; ++j) { const f32x4 g = ((const f32x4*)g0)[lane + 64 * j]; const f32x4 y = v[j] * rstd * g; v2u w; w.x = pk2(y.x, y.y); w.y = pk2(y.z, y.w); ((v2u*)o0)[lane + 64 * j] = w; }
    if (g1) {
#pragma unroll
        for (int j = 0; j < 4; ++j) { const f32x4 g = ((const f32x4*)g1)[lane + 64 * j]; const f32x4 y = v[j] * rstd * g; v2u w; w.x = pk2(y.x, y.y); w.y = pk2(y.z, y.w); ((v2u*)o1)[lane + 64 * j] = w; }
    }
}

__device__ __forceinline__ void rms_row2_to_bf16(const float* xa, const float* xb, const float* g0, bf16* oa, bf16* ob, int lane) {
    const f32x4* ra = (const f32x4*)xa + lane; const f32x4* rb = (const f32x4*)xb + lane; f32x4 va[4], vb[4]; float sa = 0.f, sb = 0.f;
#pragma unroll
    for (int j = 0; j < 4; ++j) { va[j] = ra[64 * j]; vb[j] = rb[64 * j]; }
#pragma unroll
    for (int j = 0; j < 4; ++j) { sa += (va[j].x * va[j].x + va[j].y * va[j].y) + (va[j].z * va[j].z + va[j].w * va[j].w); sb += (vb[j].x * vb[j].x + vb[j].y * vb[j].y) + (vb[j].z * vb[j].z + vb[j].w * vb[j].w); }
    const float rsa = rsqrtf(wave_sum(sa) * (1.f / DM) + EPS), rsb = rsqrtf(wave_sum(sb) * (1.f / DM) + EPS);
#pragma unroll
    for (int j = 0; j < 4; ++j) { const f32x4 g = ((const f32x4*)g0)[lane + 64 * j]; const f32x4 ya = va[j] * rsa * g, yb = vb[j] * rsb * g; v2u wa, wb; wa.x = pk2(ya.x, ya.y); wa.y = pk2(ya.z, ya.w); wb.x = pk2(yb.x, yb.y); wb.y = pk2(yb.z, yb.w);
        ((v2u*)oa)[lane + 64 * j] = wa; ((v2u*)ob)[lane + 64 * j] = wb; }
}
template <bool BF16OUT> __device__ __forceinline__ void rms_row2_bf16in(const bf16* xa, const bf16* xb, const float* g0, void* oa, void* ob, int lane) {
    v2u ra[4], rb[4]; f32x4 va[4], vb[4]; float sa = 0.f, sb = 0.f;
#pragma unroll
    for (int j = 0; j < 4; ++j) { ra[j] = ((const v2u*)xa)[lane + 64 * j]; rb[j] = ((const v2u*)xb)[lane + 64 * j]; }
#pragma unroll
    for (int j = 0; j < 4; ++j) { va[j] = (f32x4){bflo(ra[j].x), bfhi(ra[j].x), bflo(ra[j].y), bfhi(ra[j].y)}; vb[j] = (f32x4){bflo(rb[j].x), bfhi(rb[j].x), bflo(rb[j].y), bfhi(rb[j].y)};
        sa += (va[j].x * va[j].x + va[j].y * va[j].y) + (va[j].z * va[j].z + va[j].w * va[j].w); sb += (vb[j].x * vb[j].x + vb[j].y * vb[j].y) + (vb[j].z * vb[j].z + vb[j].w * vb[j].w); }
    const float rsa = rsqrtf(wave_sum(sa) * (1.f / DM) + EPS), rsb = rsqrtf(wave_sum(sb) * (1.f / DM) + EPS);
#pragma unroll
    for (int j = 0; j < 4; ++j) { const f32x4 g = ((const f32x4*)g0)[lane + 64 * j]; const f32x4 ya = va[j] * rsa * g, yb = vb[j] * rsb * g;
        if (BF16OUT) { v2u wa, wb; wa.x = pk2(ya.x, ya.y); wa.y = pk2(ya.z, ya.w); wb.x = pk2(yb.x, yb.y); wb.y = pk2(yb.z, yb.w); ((v2u*)oa)[lane + 64 * j] = wa; ((v2u*)ob)[lane + 64 * j] = wb; }
        else { __builtin_nontemporal_store(ya, (f32x4*)oa + lane + 64 * j); __builtin_nontemporal_store(yb, (f32x4*)ob + lane + 64 * j); } }
}
__device__ __forceinline__ int dstperm(int k) { return (k & ~31) + 8 * ((k >> 2) & 3) + 4 * ((k >> 4) & 1) + (k & 3); }
constexpr int P2_TEAM_BYTES = 80896;
typedef short bf16x4 __attribute__((ext_vector_type(4)));
__device__ __forceinline__ bf16x4 cvt4(f32x4 v) { v2u w; w.x = pk2(v[0], v[1]); w.y = pk2(v[2], v[3]); return __builtin_bit_cast(bf16x4, w); }
#define LBAR() do { asm volatile("s_waitcnt lgkmcnt(0)" ::: "memory"); __builtin_amdgcn_s_barrier(); asm volatile("" ::: "memory"); } while (0)
__device__ __forceinline__ void p2_delta_prep(LAS unsigned char* lds, int G, const bf16* __restrict__ QKV, const float* __restrict__ BA, const float* __restrict__ conv_w, const float* __restrict__ a_log,
                                              const float* __restrict__ dt_bias, bf16* __restrict__ DQG, bf16* __restrict__ DKDT, bf16* __restrict__ DW, bf16* __restrict__ DU, bf16* __restrict__ DA, float* __restrict__ GL, const int wave_s, const int lim = 4) {
    const int team = wave_s >> 2, wt = wave_s & 3;
    LAS unsigned char* tb = lds + team * P2_TEAM_BYTES;
    LAS bf16* Qs = (LAS bf16*)tb; LAS bf16* Ks = (LAS bf16*)(tb + 9216); LAS bf16* As = (LAS bf16*)(tb + 18432);
    LAS float* RHS = (LAS float*)(tb + 27648); LAS float* Lm = (LAS float*)(tb + 60416); LAS float* gc = (LAS float*)(tb + 76800); LAS float* bt = (LAS float*)(tb + 77056); LAS float* eq = (LAS float*)(tb + 77312); LAS float* ek = (LAS float*)(tb + 77568); LAS float* CW = (LAS float*)(tb + 77824);
    const int nteams = G * 2, per = (NUNIT_D + nteams - 1) / nteams, ubase = ((int)blockIdx.x * 2 + team) * per;
    v4u raw[3][5]; float ba_b = 0.f, ba_a = 0.f;
#define P2_FETCH(uid_) do { const int bh_ = (uid_) >> 6, c_ = (uid_) & 63, b_ = bh_ / 12, h_ = bh_ - 12 * b_; const size_t r0_ = (size_t)b_ * SEQ + (size_t)c_ * 64; \
        _Pragma("unroll") for (int mtx = 0; mtx < 3; ++mtx) _Pragma("unroll") for (int r = 0; r < 5; ++r) { const int s = c_ * 64 + t0 - 3 + r; \
            raw[mtx][r] = *(const v4u*)(QKV + (r0_ + (s >= 0 ? t0 - 3 + r : 0)) * 2304 + mtx * 768 + h_ * 64 + 8 * dg); }     \
        ba_b = BA[(r0_ + lane) * 32 + h_]; ba_a = BA[(r0_ + lane) * 32 + 12 + h_]; } while (0)
    int h_prev = -1; float h_nal = 0.f, h_dtb = 0.f;
    { int lane = __builtin_amdgcn_mbcnt_hi(~0u, __builtin_amdgcn_mbcnt_lo(~0u, 0u)); asm volatile("" : "+v"(lane)); const int tt = wt * 64 + lane, dg = tt & 7, t0 = (tt >> 3) * 2; if (ubase < NUNIT_D) P2_FETCH(ubase); }
    for (int it = 0; it < per; ++it) {
        int lane = __builtin_amdgcn_mbcnt_hi(~0u, __builtin_amdgcn_mbcnt_lo(~0u, 0u)); asm volatile("" : "+v"(lane));
        const int tt = wt * 64 + lane, dg = tt & 7, t0 = (tt >> 3) * 2;
        const int rt_ = tt ^ (team << 7);
        const int uid = ubase + it; const bool act = uid < NUNIT_D;
        const int bh = uid >> 6, b = bh / 12, h = bh - 12 * b;
        if (act && h != h_prev) {
            h_nal = -__expf(a_log[h]); h_dtb = dt_bias[h];
            for (int i = tt; i < 768; i += 256) { const int mtx = i >> 8, tap = (i >> 6) & 3, dd = i & 63; CW[i] = conv_w[tap * 2304 + mtx * 768 + h * 64 + dd]; }
        }
        h_prev = h;
        LBAR();
        if (act) {
            { const float beta = __builtin_amdgcn_rcpf(1.f + __expf(-ba_b)); const float xx = ba_a + h_dtb; const float sp = xx > 20.f ? xx : log1pf(__expf(xx));
              const float g0 = h_nal * sp;
#define DPPF(src, ctrl, rm, bm) __builtin_bit_cast(float, __builtin_amdgcn_update_dpp(0, __builtin_bit_cast(int, (src)), (ctrl), (rm), (bm), false))
              float g = g0 + DPPF(g0, 0x111, 0xf, 0xf); g += DPPF(g0, 0x112, 0xf, 0xf); g += DPPF(g0, 0x113, 0xf, 0xf);
              g += DPPF(g, 0x114, 0xf, 0xe); g += DPPF(g, 0x118, 0xf, 0xc); g += DPPF(g, 0x142, 0xa, 0xf); g += DPPF(g, 0x143, 0xc, 0xf);
#undef DPPF
              const float gl_ = __builtin_bit_cast(float, __builtin_amdgcn_readlane(__builtin_bit_cast(int, g), 63));
              gc[lane] = g; bt[lane] = beta; eq[lane] = __expf(g); ek[lane] = __expf(gl_ - g); }
            { const int c_now = uid & 63;
#pragma unroll
              for (int r = 0; r < 5; ++r) if (c_now * 64 + t0 - 3 + r < 0) {
#pragma unroll
                  for (int mtx = 0; mtx < 3; ++mtx) raw[mtx][r] = (v4u){0u, 0u, 0u, 0u}; } }
            float q[2][8], k[2][8], v[2][8];
#pragma unroll
            for (int mtx = 0; mtx < 3; ++mtx) {
                f32x4 cw[4][2];
#pragma unroll
                for (int tap = 0; tap < 4; ++tap) { cw[tap][0] = *(const LAS f32x4*)(CW + mtx * 256 + tap * 64 + 8 * dg); cw[tap][1] = *(const LAS f32x4*)(CW + mtx * 256 + tap * 64 + 8 * dg + 4); }
#pragma unroll
                for (int tk = 0; tk < 2; ++tk) { float o[8];
#pragma unroll
                    for (int e = 0; e < 8; ++e) o[e] = 0.f;
#pragma unroll
                    for (int tap = 0; tap < 4; ++tap) { const v4u rw = raw[mtx][tk + tap];
                        o[0] += cw[tap][0][0] * bflo(rw.x); o[1] += cw[tap][0][1] * bfhi(rw.x); o[2] += cw[tap][0][2] * bflo(rw.y); o[3] += cw[tap][0][3] * bfhi(rw.y);
                        o[4] += cw[tap][1][0] * bflo(rw.z); o[5] += cw[tap][1][1] * bfhi(rw.z); o[6] += cw[tap][1][2] * bflo(rw.w); o[7] += cw[tap][1][3] * bfhi(rw.w); }
#pragma unroll
                    for (int e = 0; e < 8; ++e) { const float y = silu_f(o[e]); if (mtx == 0) q[tk][e] = y; else if (mtx == 1) k[tk][e] = y; else v[tk][e] = y; } }
            }
#pragma unroll
            for (int tk = 0; tk < 2; ++tk) { float sq = 0.f, sk = 0.f;
#pragma unroll
                for (int e = 0; e < 8; ++e) { sq += q[tk][e] * q[tk][e]; sk += k[tk][e] * k[tk][e]; }
                sq = row8_sum(sq); sk = row8_sum(sk); const float rq = rsqrtf(sq + EPS) * 0.125f, rk = rsqrtf(sk + EPS);
#pragma unroll
                for (int e = 0; e < 8; ++e) { q[tk][e] *= rq; k[tk][e] *= rk; } }
            LDS_WAIT();
#pragma unroll
            for (int tk = 0; tk < 2; ++tk) { const int t = t0 + tk; const float beta = bt[t], eg = eq[t] * beta;
                v4u w; w.x = pk2(q[tk][0], q[tk][1]); w.y = pk2(q[tk][2], q[tk][3]); w.z = pk2(q[tk][4], q[tk][5]); w.w = pk2(q[tk][6], q[tk][7]); *(LAS v4u*)(Qs + t * 72 + 8 * dg) = w;
                w.x = pk2(k[tk][0], k[tk][1]); w.y = pk2(k[tk][2], k[tk][3]); w.z = pk2(k[tk][4], k[tk][5]); w.w = pk2(k[tk][6], k[tk][7]); *(LAS v4u*)(Ks + t * 72 + 8 * dg) = w;
                *(LAS f32x4*)(RHS + t * 128 + 8 * dg) = (f32x4){v[tk][0] * beta, v[tk][1] * beta, v[tk][2] * beta, v[tk][3] * beta};
                *(LAS f32x4*)(RHS + t * 128 + 8 * dg + 4) = (f32x4){v[tk][4] * beta, v[tk][5] * beta, v[tk][6] * beta, v[tk][7] * beta};
                *(LAS f32x4*)(RHS + t * 128 + 64 + 8 * dg) = (f32x4){k[tk][0] * eg, k[tk][1] * eg, k[tk][2] * eg, k[tk][3] * eg};
                *(LAS f32x4*)(RHS + t * 128 + 64 + 8 * dg + 4) = (f32x4){k[tk][4] * eg, k[tk][5] * eg, k[tk][6] * eg, k[tk][7] * eg}; }
        }
        LBAR();
        if (it + 1 < per && uid + 1 < NUNIT_D) P2_FETCH(uid + 1);
        const int l15 = lane & 15, lq = lane >> 4;
        if (act && lim >= 2) {
            bf16x8 ka[2], qa[2];
#pragma unroll
            for (int ks = 0; ks < 2; ++ks) { ka[ks] = *(const LAS bf16x8*)(Ks + (16 * wt + l15) * 72 + 32 * ks + 8 * lq); qa[ks] = *(const LAS bf16x8*)(Qs + (16 * wt + l15) * 72 + 32 * ks + 8 * lq); }
            float gi[4], bi[4];
#pragma unroll
            for (int r = 0; r < 4; ++r) { gi[r] = gc[16 * wt + 4 * lq + r]; bi[r] = bt[16 * wt + 4 * lq + r]; }
#pragma unroll
            for (int ct = 0; ct < 4; ++ct) {
                const bf16x8 kb0 = *(const LAS bf16x8*)(Ks + (16 * ct + l15) * 72 + 8 * lq), kb1 = *(const LAS bf16x8*)(Ks + (16 * ct + l15) * 72 + 32 + 8 * lq);
                f32x4 kk = {0.f, 0.f, 0.f, 0.f}, qk = {0.f, 0.f, 0.f, 0.f};
                kk = __builtin_amdgcn_mfma_f32_16x16x32_bf16(ka[0], kb0, kk, 0, 0, 0); kk = __builtin_amdgcn_mfma_f32_16x16x32_bf16(ka[1], kb1, kk, 0, 0, 0);
                qk = __builtin_amdgcn_mfma_f32_16x16x32_bf16(qa[0], kb0, qk, 0, 0, 0); qk = __builtin_amdgcn_mfma_f32_16x16x32_bf16(qa[1], kb1, qk, 0, 0, 0);
                const int j = 16 * ct + l15; const float gj = gc[j];
#pragma unroll
                for (int r = 0; r < 4; ++r) { const int i = 16 * wt + 4 * lq + r; const float dec = (j <= i) ? __expf(gi[r] - gj) : 0.f;
                    Lm[i * 64 + j] = (j < i) ? bi[r] * kk[r] * dec : 0.f;
                    As[i * 72 + j] = (bf16)(pk2(qk[r] * dec, 0.f) & 0xffffu); }
            }
        }
        LBAR();
        if (act && lim >= 3) {
            if (rt_ < 64) {
                const int bb = rt_ >> 4, cc = rt_ & 15; const LAS float* Lb = Lm + (16 * bb) * 64 + 16 * bb; float t[16]; f32x4 lv[15][4];
#pragma unroll
                for (int r = 1; r < 16; ++r)
#pragma unroll
                    for (int j4 = 0; j4 < (r + 3) / 4; ++j4) lv[r - 1][j4] = *(const LAS f32x4*)(Lb + r * 64 + 4 * j4);
                __builtin_amdgcn_sched_barrier(0);
#pragma unroll
                for (int r = 0; r < 16; ++r) { float a = (r == cc) ? 1.f : 0.f;
#pragma unroll
                    for (int j4 = 0; j4 < (r + 3) / 4; ++j4) { const f32x4 l = lv[r > 0 ? r - 1 : 0][j4];
#pragma unroll
                        for (int e = 0; e < 4; ++e) if (4 * j4 + e < r) a -= l[e] * t[4 * j4 + e]; }
                    t[r] = a; }
                LDS_WAIT(); asm volatile("" ::: "memory");
#pragma unroll
                for (int r = 0; r < 16; ++r) ((LAS float*)Lb)[r * 64 + cc] = t[r];
            } else if (rt_ >= 128) {
                const int t2 = rt_ - 128, rrow = t2 >> 1, half = t2 & 1;
                { const float eg = eq[rrow]; v4u in[4], ou[4];
#pragma unroll
                  for (int i = 0; i < 4; ++i) in[i] = *(const LAS v4u*)(Qs + rrow * 72 + 32 * half + 8 * i);
                  unsigned g4[16];
#pragma unroll
                  for (int kk4 = 0; kk4 < 8; ++kk4) { const unsigned a0 = in[kk4 >> 1][(kk4 & 1) * 2], a1 = in[kk4 >> 1][(kk4 & 1) * 2 + 1]; const int p4 = 2 * (kk4 & 3) + (kk4 >> 2);
                      g4[2 * p4] = pk2(bflo(a0) * eg, bfhi(a0) * eg); g4[2 * p4 + 1] = pk2(bflo(a1) * eg, bfhi(a1) * eg); }
#pragma unroll
                  for (int i = 0; i < 4; ++i) { ou[i] = (v4u){g4[4 * i], g4[4 * i + 1], g4[4 * i + 2], g4[4 * i + 3]}; *(v4u*)(DQG + (size_t)uid * 4096 + rrow * 64 + 32 * half + 8 * i) = ou[i]; } }
                { v4u in[4], ou[4];
#pragma unroll
                  for (int i = 0; i < 4; ++i) in[i] = *(const LAS v4u*)(As + rrow * 72 + 32 * half + 8 * i);
                  unsigned g4[16];
#pragma unroll
                  for (int kk4 = 0; kk4 < 8; ++kk4) { const int p4 = 2 * (kk4 & 3) + (kk4 >> 2); g4[2 * p4] = in[kk4 >> 1][(kk4 & 1) * 2]; g4[2 * p4 + 1] = in[kk4 >> 1][(kk4 & 1) * 2 + 1]; }
#pragma unroll
                  for (int i = 0; i < 4; ++i) { ou[i] = (v4u){g4[4 * i], g4[4 * i + 1], g4[4 * i + 2], g4[4 * i + 3]}; *(v4u*)(DA + (size_t)uid * 4096 + rrow * 64 + 32 * half + 8 * i) = ou[i]; } }
                {
                  unsigned g4[16]; bf16 kv_[32]; f32x4 ev_[8];
#pragma unroll
                  for (int i = 0; i < 32; ++i) kv_[i] = Ks[(32 * half + i) * 72 + rrow];
#pragma unroll
                  for (int i = 0; i < 8; ++i) ev_[i] = *(const LAS f32x4*)(ek + 32 * half + 4 * i);
                  __builtin_amdgcn_sched_barrier(0);
#pragma unroll
                  for (int kk4 = 0; kk4 < 8; ++kk4) { const int p4 = 2 * (kk4 & 3) + (kk4 >> 2); float f[4];
#pragma unroll
                      for (int e = 0; e < 4; ++e) f[e] = bf1(kv_[4 * kk4 + e]) * ev_[kk4][e];
                      g4[2 * p4] = pk2(f[0], f[1]); g4[2 * p4 + 1] = pk2(f[2], f[3]); }
#pragma unroll
                  for (int i = 0; i < 4; ++i) *(v4u*)(DKDT + (size_t)uid * 4096 + rrow * 64 + 32 * half + 8 * i) = (v4u){g4[4 * i], g4[4 * i + 1], g4[4 * i + 2], g4[4 * i + 3]}; }
                if (t2 == 0) GL[uid] = eq[63];
            }
        }
        LBAR();
        if (act && lim >= 4) {
            f32x4 X[2][4]; bf16x4 xb[2][4]; f32x4 racc[4][2], lfr[4][4];
#pragma unroll
            for (int bb = 0; bb < 4; ++bb) {
#pragma unroll
                for (int c2 = 0; c2 < 2; ++c2)
#pragma unroll
                    for (int r = 0; r < 4; ++r) racc[bb][c2][r] = RHS[(16 * bb + 4 * lq + r) * 128 + 32 * wt + 16 * c2 + l15];
#pragma unroll
                for (int j = 0; j < 4; ++j) if (j <= bb) lfr[bb][j] = *(const LAS f32x4*)(Lm + (16 * bb + l15) * 64 + 16 * j + 4 * lq); }
            __builtin_amdgcn_sched_barrier(0);
#pragma unroll
            for (int bb = 0; bb < 4; ++bb) {
                f32x4 acc[2]; acc[0] = racc[bb][0]; acc[1] = racc[bb][1];
#pragma unroll
                for (int j = 0; j < 4; ++j) if (j < bb) { const f32x4 lv = lfr[bb][j]; const bf16x4 la = cvt4(-lv);
#pragma unroll
                    for (int c2 = 0; c2 < 2; ++c2) acc[c2] = __builtin_amdgcn_mfma_f32_16x16x16bf16_1k(la, xb[c2][j], acc[c2], 0, 0, 0); }
                const f32x4 tv = lfr[bb][bb]; const bf16x4 ta = cvt4(tv);
#pragma unroll
                for (int c2 = 0; c2 < 2; ++c2) { const bf16x4 yb = cvt4(acc[c2]); X[c2][bb] = __builtin_amdgcn_mfma_f32_16x16x16bf16_1k(ta, yb, (f32x4){0.f, 0.f, 0.f, 0.f}, 0, 0, 0); xb[c2][bb] = cvt4(X[c2][bb]); }
            }
            if (wt < 2) {
#pragma unroll
                for (int c2 = 0; c2 < 2; ++c2) { bf16* up = DU + (size_t)uid * 4096 + ((2 * wt + c2) * 64 + lane) * 16; v4u w0, w1;
                    w0.x = pk2(X[c2][0][0], X[c2][0][1]); w0.y = pk2(X[c2][0][2], X[c2][0][3]); w0.z = pk2(X[c2][1][0], X[c2][1][1]); w0.w = pk2(X[c2][1][2], X[c2][1][3]);
                    w1.x = pk2(X[c2][2][0], X[c2][2][1]); w1.y = pk2(X[c2][2][2], X[c2][2][3]); w1.z = pk2(X[c2][3][0], X[c2][3][1]); w1.w = pk2(X[c2][3][2], X[c2][3][3]);
                    *(v4u*)up = w0; *(v4u*)(up + 8) = w1; }
            } else {
#pragma unroll
                for (int c2 = 0; c2 < 2; ++c2) { bf16* wp = DW + (size_t)uid * 4096 + dstperm(32 * (wt - 2) + 16 * c2 + l15);
#pragma unroll
                    for (int bb = 0; bb < 4; ++bb)
#pragma unroll
                        for (int r = 0; r < 4; ++r) wp[(16 * bb + 4 * lq + r) * 64] = (bf16)(pk2(X[c2][bb][r], 0.f) & 0xffffu); }
            }
        }
    }
    LBAR();
#undef P2_FETCH
}

constexpr int SC_W = 0, SC_QG = 9216, SC_A = 18432, SC_KDT = 27648, SC_U = 36864, SC_STAGE = 45056, SC_O = 2 * SC_STAGE, SC_OSTRIDE = 68, SC_OBYTES = 64 * SC_OSTRIDE * 4;
__device__ __forceinline__ void p3_scan(LAS unsigned char* lds, int sq, const bf16* __restrict__ DQG, const bf16* __restrict__ DKDT, const bf16* __restrict__ DW, const bf16* __restrict__ DU, const bf16* __restrict__ DA,
                                        const float* __restrict__ GL, bf16* Z, const float* __restrict__ o_norm, const int wave_s, const bool dostore = true) {
    int lane_ = __builtin_amdgcn_mbcnt_hi(~0u, __builtin_amdgcn_mbcnt_lo(~0u, 0u)); asm volatile("" : "+v"(lane_)); const int tid = wave_s * 64 + lane_; const int wid = wave_s, lane = lane_, l15 = lane & 15, lq = lane >> 4;
    const int b = sq / 12, h = sq - 12 * b; const size_t uid0 = (size_t)sq * 64; const size_t row0 = (size_t)b * SEQ;
    const int ht = tid - 256;
#define SC_LOAD(n) do { const size_t ub = (uid0 + (n)) * 8192; \
        _Pragma("unroll") for (int i = 0; i < 2; ++i) { const int p = ht + 256 * i; \
            st[0][i] = *(const v4u*)((const char*)DW + ub + p * 16); st[1][i] = *(const v4u*)((const char*)DQG + ub + p * 16); st[2][i] = *(const v4u*)((const char*)DA + ub + p * 16); \
            st[3][i] = *(const v4u*)((const char*)DKDT + ub + p * 16); st[4][i] = *(const v4u*)((const char*)DU + ub + p * 16); } } while (0)
#define SC_STORE(s) do { LAS unsigned char* sb_ = lds + (s) * SC_STAGE; \
        _Pragma("unroll") for (int i = 0; i < 2; ++i) { const int p = ht + 256 * i; const int ro = (p >> 3) * 144 + (p & 7) * 16; \
            *(LAS v4u*)(sb_ + SC_W + ro) = st[0][i]; *(LAS v4u*)(sb_ + SC_QG + ro) = st[1][i]; *(LAS v4u*)(sb_ + SC_A + ro) = st[2][i]; *(LAS v4u*)(sb_ + SC_KDT + ro) = st[3][i]; \
            *(LAS v4u*)(sb_ + SC_U + p * 16) = st[4][i]; } } while (0)
#define SC_EPI(n) do { const int row_ = ht >> 2, sg_ = ht & 3; bf16* zp_ = Z + (row0 + (size_t)(n) * 64 + row_) * 1024 + h * 64 + sg_ * 16; \
        const v4u z0_ = *(const v4u*)zp_, z1_ = *(const v4u*)(zp_ + 8); const LAS float* op_ = (const LAS float*)(lds + SC_O + ((n) & 1) * SC_OBYTES) + row_ * SC_OSTRIDE + sg_ * 16; \
        f32x4 o_[4]; float ss_ = 0.f; \
        _Pragma("unroll") for (int i = 0; i < 4; ++i) { o_[i] = *(const LAS f32x4*)(op_ + 4 * i); ss_ += (o_[i][0] * o_[i][0] + o_[i][1] * o_[i][1]) + (o_[i][2] * o_[i][2] + o_[i][3] * o_[i][3]); } \
        ss_ = DPP_ADD(ss_, 0xB1); ss_ = DPP_ADD(ss_, 0x4E); const float rstd_ = rsqrtf(ss_ * (1.f / 64.f) + EPS); \
        v4u y0_, y1_; \
        _Pragma("unroll") for (int i = 0; i < 4; ++i) { const unsigned zz_ = (i < 2) ? z0_[2 * i] : z1_[2 * (i - 2)], zw_ = (i < 2) ? z0_[2 * i + 1] : z1_[2 * (i - 2) + 1]; \
            const unsigned a_ = pk2(o_[i][0] * rstd_ * onv[4 * i] * silu_f(bflo(zz_)), o_[i][1] * rstd_ * onv[4 * i + 1] * silu_f(bfhi(zz_))); \
            const unsigned b_ = pk2(o_[i][2] * rstd_ * onv[4 * i + 2] * silu_f(bflo(zw_)), o_[i][3] * rstd_ * onv[4 * i + 3] * silu_f(bfhi(zw_))); \
            if (i < 2) { y0_[2 * i] = a_; y0_[2 * i + 1] = b_; } else { y1_[2 * (i - 2)] = a_; y1_[2 * (i - 2) + 1] = b_; } } \
        if (dostore) { *(v4u*)zp_ = y0_; *(v4u*)(zp_ + 8) = y1_; } } while (0)
    v4u st[5][2]; float onv[16];
    if (wid >= 4) { SC_LOAD(0); SC_STORE(0); SC_LOAD(1);
#pragma unroll
        for (int i = 0; i < 16; ++i) onv[i] = o_norm[(ht & 3) * 16 + i]; }
    LBAR();
    f32x4 S[4];
#pragma unroll
    for (int i = 0; i < 4; ++i) S[i] = (f32x4){0.f, 0.f, 0.f, 0.f};
    float gl_next = GL[uid0];
    for (int n = 0; n < 64; ++n) {
        if (wid >= 4) {
            if (n + 1 < 64) { SC_STORE((n + 1) & 1); if (n + 2 < 64) SC_LOAD(n + 2); }
            if (n > 0) SC_EPI(n - 1);
        } else {
            const LAS unsigned char* sb = lds + (n & 1) * SC_STAGE; const int fo = l15 * 144 + lq * 16;
            const float gl = gl_next; gl_next = GL[uid0 + (n + 1 < 64 ? n + 1 : n)];
            bf16x8 sbv[2], vb[2];
#pragma unroll
            for (int ks = 0; ks < 2; ++ks) { v4u w; w.x = pk2(S[2 * ks][0], S[2 * ks][1]); w.y = pk2(S[2 * ks][2], S[2 * ks][3]); w.z = pk2(S[2 * ks + 1][0], S[2 * ks + 1][1]); w.w = pk2(S[2 * ks + 1][2], S[2 * ks + 1][3]); sbv[ks] = __builtin_bit_cast(bf16x8, w); }
            f32x4 vn[4];
#pragma unroll
            for (int rt = 0; rt < 4; ++rt) { f32x4 a = {0.f, 0.f, 0.f, 0.f};
#pragma unroll
                for (int ks = 0; ks < 2; ++ks) a = __builtin_amdgcn_mfma_f32_16x16x32_bf16(*(const LAS bf16x8*)(sb + SC_W + rt * 2304 + ks * 64 + fo), sbv[ks], a, 0, 0, 0);
                const v2u uu = *(const LAS v2u*)(sb + SC_U + ((wid * 64 + lane) * 16 + rt * 4) * 2);
                vn[rt] = (f32x4){bflo(uu.x), bfhi(uu.x), bflo(uu.y), bfhi(uu.y)} - a; }
#pragma unroll
            for (int ks = 0; ks < 2; ++ks) { v4u w; w.x = pk2(vn[2 * ks][0], vn[2 * ks][1]); w.y = pk2(vn[2 * ks][2], vn[2 * ks][3]); w.z = pk2(vn[2 * ks + 1][0], vn[2 * ks + 1][1]); w.w = pk2(vn[2 * ks + 1][2], vn[2 * ks + 1][3]); vb[ks] = __builtin_bit_cast(bf16x8, w); }
            LAS float* ob = (LAS float*)(lds + SC_O + (n & 1) * SC_OBYTES) + 16 * wid + l15;
#pragma unroll
            for (int rt = 0; rt < 4; ++rt) { f32x4 a = {0.f, 0.f, 0.f, 0.f};
#pragma unroll
                for (int ks = 0; ks < 2; ++ks) { a = __builtin_amdgcn_mfma_f32_16x16x32_bf16(*(const LAS bf16x8*)(sb + SC_QG + rt * 2304 + ks * 64 + fo), sbv[ks], a, 0, 0, 0);
                    a = __builtin_amdgcn_mfma_f32_16x16x32_bf16(*(const LAS bf16x8*)(sb + SC_A + rt * 2304 + ks * 64 + fo), vb[ks], a, 0, 0, 0); }
#pragma unroll
                for (int r = 0; r < 4; ++r) ob[(16 * rt + 4 * lq + r) * SC_OSTRIDE] = a[r]; }
#pragma unroll
            for (int dt = 0; dt < 4; ++dt) { f32x4 a = S[dt] * gl;
#pragma unroll
                for (int ks = 0; ks < 2; ++ks) a = __builtin_amdgcn_mfma_f32_16x16x32_bf16(*(const LAS bf16x8*)(sb + SC_KDT + dt * 2304 + ks * 64 + fo), vb[ks], a, 0, 0, 0);
                S[dt] = a; }
        }
        LBAR();
    }
    if (wid >= 4) SC_EPI(63);
    LBAR();
#undef SC_LOAD
#undef SC_STORE
#undef SC_EPI
}
constexpr int PTR_OFF = 161792;
#define GAS __attribute__((address_space(1)))
__device__ __forceinline__ GAS void* ldp(LAS unsigned char* lds, int k) {
    asm volatile("" ::: "memory");
    const LAS unsigned* t = (const LAS unsigned*)(lds + PTR_OFF) + 2 * k; unsigned lo = t[0], hi = t[1];
    lo = __builtin_amdgcn_readfirstlane(lo); hi = __builtin_amdgcn_readfirstlane(hi);
    return (GAS void*)(((unsigned long long)hi << 32) | lo);
}
#define x_ ((const float*)(GAS const float*)ldp(lds, 0))
#define mem_ ((const float*)(GAS const float*)ldp(lds, 1))
#define positions_ ((const int*)(GAS const int*)ldp(lds, 2))
#define norm_0_ ((const float*)(GAS const float*)ldp(lds, 3))
#define w_in_0_ ((const float*)(GAS const float*)ldp(lds, 4))
#define conv_w_ ((const float*)(GAS const float*)ldp(lds, 5))
#define a_log_ ((const float*)(GAS const float*)ldp(lds, 6))
#define dt_bias_ ((const float*)(GAS const float*)ldp(lds, 7))
#define o_norm_ ((const float*)(GAS const float*)ldp(lds, 8))
#define mem_norm_0_ ((const float*)(GAS const float*)ldp(lds, 9))
#define w_mkv_0_ ((const float*)(GAS const float*)ldp(lds, 10))
#define w_out_0_ ((const float*)(GAS const float*)ldp(lds, 11))
#define norm_1_ ((const float*)(GAS const float*)ldp(lds, 12))
#define w_in_1_ ((const float*)(GAS const float*)ldp(lds, 13))
#define mem_norm_1_ ((const float*)(GAS const float*)ldp(lds, 14))
#define w_mkv_1_ ((const float*)(GAS const float*)ldp(lds, 15))
#define w_out_1_ ((const float*)(GAS const float*)ldp(lds, 16))
#define final_norm_ ((const float*)(GAS const float*)ldp(lds, 17))
#define out_ ((float*)(GAS float*)ldp(lds, 18))
#define KSUM_ ((float*)(GAS float*)((GAS unsigned char*)ldp(lds, 19) + WS_KSUM))
#define GL_ ((float*)(GAS float*)((GAS unsigned char*)ldp(lds, 19) + WS_GL))
#define WCAT0_ ((bf16*)(GAS bf16*)((GAS unsigned char*)ldp(lds, 19) + WS_WCAT0))
#define WOUT0_ ((bf16*)(GAS bf16*)((GAS unsigned char*)ldp(lds, 19) + WS_WOUT0))
#define WIN1_ ((bf16*)(GAS bf16*)((GAS unsigned char*)ldp(lds, 19) + WS_WIN1))
#define WOUT1_ ((bf16*)(GAS bf16*)((GAS unsigned char*)ldp(lds, 19) + WS_WOUT1))
#define RT_ ((float*)(GAS float*)((GAS unsigned char*)ldp(lds, 19) + WS_ROPE))
#define ACAT_ ((bf16*)(GAS bf16*)((GAS unsigned char*)ldp(lds, 19) + WS_ACAT))
#define MKV_ ((bf16*)(GAS bf16*)((GAS unsigned char*)ldp(lds, 19) + WS_MKV))
#define QKV_ ((bf16*)(GAS bf16*)((GAS unsigned char*)ldp(lds, 19) + WS_QKV))
#define Zb_ ((bf16*)(GAS bf16*)((GAS unsigned char*)ldp(lds, 19) + WS_Z))
#define MQ_ ((bf16*)(GAS bf16*)((GAS unsigned char*)ldp(lds, 19) + WS_MQ))
#define BA_ ((float*)(GAS float*)((GAS unsigned char*)ldp(lds, 19) + WS_BA))
#define PS_ ((float*)(GAS float*)((GAS unsigned char*)ldp(lds, 19) + WS_PS))
#define H1B_ ((bf16*)(GAS bf16*)((GAS unsigned char*)ldp(lds, 19) + WS_DU))
#define H2B_ ((bf16*)(GAS bf16*)((GAS unsigned char*)ldp(lds, 19) + WS_DU))
#define DW_ ((bf16*)(GAS bf16*)((GAS unsigned char*)ldp(lds, 19) + WS_DW))
#define DU_ ((bf16*)(GAS bf16*)((GAS unsigned char*)ldp(lds, 19) + WS_DU))
#define DA_ ((bf16*)(GAS bf16*)((GAS unsigned char*)ldp(lds, 19) + WS_DA))
#define DQG_ ((bf16*)(GAS bf16*)ldp(lds, 18))
#define DKDT_ ((bf16*)((GAS bf16*)ldp(lds, 18) + (size_t)NUNIT_D * 4096))
#define Q1_ (QKV_)
#define K1_ (QKV_ + (size_t)M * 768)
#define V1_ (QKV_ + (size_t)2 * M * 768)
__device__ __forceinline__ void mem_attn_unit(int u, int layer, LAS unsigned char* lds, char* shm, const int wave_s) {
    const int qb = u & 15, hm = (u >> 4) & 3, b = u >> 6; const size_t r0 = (size_t)b * SEQ + (size_t)qb * 256;
    GAS unsigned char* ws_ = (GAS unsigned char*)ldp(lds, 19);
    const attn_body::bf16* Kh = (const attn_body::bf16*)(GAS attn_body::bf16*)(ws_ + WS_MKV) + (size_t)layer * MROWS * 512 + (size_t)b * NMEM * 512 + hm * 64;
    attn_body::attn_unit<8, 0, 256, 512, 1024>(4, (const attn_body::bf16*)(GAS attn_body::bf16*)(ws_ + WS_MQ) + r0 * 256 + hm * 64, Kh, Kh + 256,
                               (attn_body::bf16*)(GAS attn_body::bf16*)(ws_ + WS_Z) + r0 * 1024 + 768 + hm * 64, nullptr, 0, shm, wave_s);
}
__device__ __forceinline__ void moba_attn_unit(int bh, int qb, LAS unsigned char* lds, char* shm, const int wave_s, const bool dry = false) {
    const int b = bh / 12, h = bh - 12 * b; const size_t r0 = (size_t)b * SEQ + (size_t)qb * 256;
    GAS unsigned char* ws_ = (GAS unsigned char*)ldp(lds, 19);
    const attn_body::bf16* qkv_ = (const attn_body::bf16*)(GAS attn_body::bf16*)(ws_ + WS_QKV);
    attn_body::attn_unit<8, 1, 768, 768, 1024>(4 * (qb + 1), qkv_ + r0 * 768 + h * 64, qkv_ + (size_t)M * 768 + (size_t)b * SEQ * 768 + h * 64, qkv_ + (size_t)2 * M * 768 + (size_t)b * SEQ * 768 + h * 64,
                               (attn_body::bf16*)(GAS attn_body::bf16*)(ws_ + WS_Z) + r0 * 1024 + h * 64, (const float*)(GAS float*)(ws_ + WS_KSUM) + (size_t)b * 16 * 768 + h * 64, qb, shm, wave_s, dry,
                               (const float*)(GAS float*)(ws_ + WS_ROPE) + r0 * 64);
}
#define XB_TMO      128
#define XB_XCNT(j)  (256  + 64 * (j))
#define XB_XSUB(j)  (1280 + 64 * (j))
#define XB_XGEN(j)  (2304 + 64 * (j))
#define XB_TOP      3328
#define XB_TOPGEN   3392
#define XCD_BAR_WORDS 3456
#define XB_SPIN_CAP (1u << 18)

__device__ __forceinline__ unsigned xb_ld(unsigned* p)              { return __hip_atomic_load(p, __ATOMIC_RELAXED, __HIP_MEMORY_SCOPE_AGENT); }
__device__ __forceinline__ unsigned xb_add(unsigned* p, unsigned v) { return __hip_atomic_fetch_add(p, v, __ATOMIC_RELAXED, __HIP_MEMORY_SCOPE_AGENT); }
__device__ __forceinline__ unsigned xb_xcc_id() { return (unsigned)__builtin_amdgcn_s_getreg((3 << 11) | 20) & 0xFu; }
#define XB_SPIN(cond, bar) do { unsigned _sp = 0; while (cond) { __builtin_amdgcn_s_sleep(1); \
    if ((++_sp & 255u) == 0u) { if (xb_ld(&(bar)[XB_TMO])) break; if (_sp > XB_SPIN_CAP) { atomicAdd(&(bar)[XB_TMO], 1u); break; } } } } while (0)

struct XcdBarrier {
    unsigned* bar; unsigned x;
    volatile LAS unsigned* st;
};

__device__ __forceinline__ XcdBarrier xcd_barrier_post(unsigned* bar, volatile LAS unsigned* st) {
    XcdBarrier b; b.bar = bar; b.x = xb_xcc_id(); b.st = st;
    if (threadIdx.x == 0) (void)xb_add(&bar[XB_XCNT(b.x)], 1u);
    return b;
}
__device__ __forceinline__ void xcd_barrier_complete(unsigned* bar, unsigned x, unsigned& nloc, unsigned& nx) {
    const unsigned G = gridDim.x * gridDim.y * gridDim.z;
    unsigned sum, cnt, mine, sp = 0u;
    for (;;) {
        sum = 0u; cnt = 0u; mine = 0u;
#pragma unroll
        for (unsigned j = 0; j < 16; ++j) { const unsigned c = xb_ld(&bar[XB_XCNT(j)]); sum += c; cnt += (c > 0u) ? 1u : 0u; mine = (j == x) ? c : mine; }
        if (sum == G) break;
        __builtin_amdgcn_s_sleep(1);
        if ((++sp & 255u) == 0u) { if (xb_ld(&bar[XB_TMO])) break; if (sp > XB_SPIN_CAP) { atomicAdd(&bar[XB_TMO], 1u); break; } }
    }
    nloc = mine > 0u ? mine : 1u; nx = cnt > 0u ? cnt : 1u;
}

__device__ __forceinline__ void xcd_barrier(const XcdBarrier& b) {
    asm volatile("s_waitcnt vmcnt(0)" ::: "memory");
    __syncthreads();
    if (threadIdx.x == 0) {
        unsigned* bar = b.bar;
        __builtin_amdgcn_s_waitcnt(0);
        unsigned nloc = b.st[0], nx = b.st[1];
        if (nloc == 0u) { xcd_barrier_complete(bar, b.x, nloc, nx); b.st[0] = nloc; b.st[1] = nx; }
        const unsigned old = xb_add(&bar[XB_XSUB(b.x)], 1u);
        const unsigned gen = old / nloc;
        if (old + 1u == (gen + 1u) * nloc) {
            __builtin_amdgcn_fence(__ATOMIC_RELEASE, "agent");
            asm volatile("s_waitcnt vmcnt(0)" ::: "memory");
            const unsigned og = xb_add(&bar[XB_TOP], 1u);
            const unsigned tg = og / nx;
            if (og + 1u == (tg + 1u) * nx) xb_add(&bar[XB_TOPGEN], 1u);
            else XB_SPIN(xb_ld(&bar[XB_TOPGEN]) == tg, bar);
            __builtin_amdgcn_fence(__ATOMIC_ACQUIRE, "agent");
            xb_add(&bar[XB_XGEN(b.x)], 1u);
            asm volatile("s_waitcnt vmcnt(0)" ::: "memory");
        } else {
            XB_SPIN(xb_ld(&bar[XB_XGEN(b.x)]) == gen, bar);
            __builtin_amdgcn_fence(__ATOMIC_ACQUIRE, "agent");
            asm volatile("s_waitcnt vmcnt(0)" ::: "memory");
        }
    }
    __syncthreads();
}

constexpr size_t WS_BAR = 1 * MiB;
struct Args { const float* in[18]; float* out; unsigned char* ws; };
__global__ void __launch_bounds__(NTHREADS, 2) hybrid_fwd(Args args) {
    extern __shared__ __attribute__((aligned(16))) unsigned char lds_raw[];
    cg::grid_group grid = cg::this_grid();
    LAS unsigned char* lds = (LAS unsigned char*)lds_raw;
    const int G = gridDim.x, bid = blockIdx.x;
    const int wave_s = __builtin_amdgcn_readfirstlane((int)threadIdx.x >> 6);
    if (threadIdx.x < 20) { const unsigned long long pv = threadIdx.x < 18 ? (unsigned long long)args.in[threadIdx.x < 18 ? threadIdx.x : 0] : (threadIdx.x == 18 ? (unsigned long long)args.out : (unsigned long long)args.ws);
        ((LAS unsigned long long*)(lds + PTR_OFF))[threadIdx.x] = pv; }
    if (threadIdx.x == 32) { ((LAS unsigned*)(lds + PTR_OFF + 192))[0] = 0u; ((LAS unsigned*)(lds + PTR_OFF + 192))[1] = 0u; }
    __syncthreads();
    const XcdBarrier xbar = xcd_barrier_post((unsigned*)(args.ws + WS_BAR), (volatile LAS unsigned*)(lds + PTR_OFF + 192));
    const int vcu = (G % 8 == 0) ? (bid % 8) * (G / 8) + bid / 8 : bid;
    const int NGW = G * 8;
#define FRESH_IDS() int lane = __builtin_amdgcn_mbcnt_hi(~0u, __builtin_amdgcn_mbcnt_lo(~0u, 0u)); asm volatile("" : "+v"(lane)); const int wave = wave_s, tid = wave_s * 64 + lane; (void)tid; const int gw = vcu * 8 + wave; (void)lane; (void)gw

#ifndef SKIP_P0
    {
        FRESH_IDS();
        LAS float* scr = (LAS float*)(lds + wave * 16384);
        constexpr int I_IN0 = 16 * 113, I_MKV = 16 * 16, I_OUT = 16 * 32, I_IN1 = 16 * 112;
        constexpr int NITEMS = I_IN0 + 2 * I_MKV + 2 * I_OUT + I_IN1;
        for (int it = gw; it < NITEMS; it += NGW) {
            int r = it;
            if (r < I_IN0) { p0_transpose_item(w_in_0_, DM, N_IN0, 113, WCAT0_, 0, false, scr, r, lane); continue; } r -= I_IN0;
            if (r < I_MKV) { p0_transpose_item(w_mkv_0_, DM, 512, 16, WCAT0_, N_IN0P, false, scr, r, lane); continue; } r -= I_MKV;
            if (r < I_MKV) { p0_transpose_item(w_mkv_1_, DM, 512, 16, WCAT0_, N_IN0P + 512, false, scr, r, lane); continue; } r -= I_MKV;
            if (r < I_OUT) { p0_transpose_item(w_out_0_, DM, DM, 32, WOUT0_, 0, false, scr, r, lane); continue; } r -= I_OUT;
            if (r < I_OUT) { p0_transpose_item(w_out_1_, DM, DM, 32, WOUT1_, 0, false, scr, r, lane); continue; } r -= I_OUT;
            p0_transpose_item(w_in_1_, DM, N_IN1, 112, WIN1_, 0, true, scr, r, lane);
        }
        { const size_t z0 = (size_t)3616 * DM * 2, z1 = (size_t)N_IN0P * DM * 2;
          for (size_t p = z0 + ((size_t)bid * NTHREADS + tid) * 16; p < z1; p += (size_t)G * NTHREADS * 16) *(v4u*)((unsigned char*)WCAT0_ + p) = (v4u){0u, 0u, 0u, 0u}; }
        for (int i = bid * NTHREADS + tid; i < BATCH * 16 * 768; i += G * NTHREADS) KSUM_[i] = 0.f;
        { int m = gw; for (; m + NGW < M; m += 2 * NGW) rms_row2_to_bf16(x_ + (size_t)m * DM, x_ + (size_t)(m + NGW) * DM, norm_0_, ACAT_ + (size_t)m * DM, ACAT_ + (size_t)(m + NGW) * DM, lane);
          if (m < M) rms_row_to_bf16(x_ + (size_t)m * DM, norm_0_, ACAT_ + (size_t)m * DM, nullptr, nullptr, lane); }
        for (int m = gw; m < MROWS; m += NGW) rms_row_to_bf16(mem_ + (size_t)m * DM, mem_norm_0_, ACAT_ + (size_t)(M + m) * DM, mem_norm_1_, ACAT_ + (size_t)(M + MROWS + m) * DM, lane);
        for (int i = bid * NTHREADS + tid; i < M * 32; i += G * NTHREADS) { const int row = i >> 5, f = i & 31;
            const double ang = (double)positions_[row] * (double)ROPE_INVF[f]; double rv = ang * 0.15915494309189535; rv -= __builtin_rint(rv); const float rf = (float)rv;
            RT_[2 * (size_t)i] = __builtin_amdgcn_cosf(rf); RT_[2 * (size_t)i + 1] = __builtin_amdgcn_sinf(rf); }
    }
#ifdef DUP_P0
    grid.sync();
    {
        FRESH_IDS();
        LAS float* scr = (LAS float*)(lds + wave * 16384);
        constexpr int I_IN0 = 16 * 113, I_MKV = 16 * 16, I_OUT = 16 * 32, I_IN1 = 16 * 112;
        constexpr int NITEMS = I_IN0 + 2 * I_MKV + 2 * I_OUT + I_IN1;
        for (int it = gw; it < NITEMS; it += NGW) {
            int r = it;
            if (r < I_IN0) { p0_transpose_item(w_in_0_, DM, N_IN0, 113, WCAT0_, 0, false, scr, r, lane); continue; } r -= I_IN0;
            if (r < I_MKV) { p0_transpose_item(w_mkv_0_, DM, 512, 16, WCAT0_, N_IN0P, false, scr, r, lane); continue; } r -= I_MKV;
            if (r < I_MKV) { p0_transpose_item(w_mkv_1_, DM, 512, 16, WCAT0_, N_IN0P + 512, false, scr, r, lane); continue; } r -= I_MKV;
            if (r < I_OUT) { p0_transpose_item(w_out_0_, DM, DM, 32, WOUT0_, 0, false, scr, r, lane); continue; } r -= I_OUT;
            if (r < I_OUT) { p0_transpose_item(w_out_1_, DM, DM, 32, WOUT1_, 0, false, scr, r, lane); continue; } r -= I_OUT;
            p0_transpose_item(w_in_1_, DM, N_IN1, 112, WIN1_, 0, true, scr, r, lane);
        }
        { const size_t z0 = (size_t)3616 * DM * 2, z1 = (size_t)N_IN0P * DM * 2;
          for (size_t p = z0 + ((size_t)bid * NTHREADS + tid) * 16; p < z1; p += (size_t)G * NTHREADS * 16) *(v4u*)((unsigned char*)WCAT0_ + p) = (v4u){0u, 0u, 0u, 0u}; }
        for (int i = bid * NTHREADS + tid; i < BATCH * 16 * 768; i += G * NTHREADS) KSUM_[i] = 0.f;
        { int m = gw; for (; m + NGW < M; m += 2 * NGW) rms_row2_to_bf16(x_ + (size_t)m * DM, x_ + (size_t)(m + NGW) * DM, norm_0_, ACAT_ + (size_t)m * DM, ACAT_ + (size_t)(m + NGW) * DM, lane);
          if (m < M) rms_row_to_bf16(x_ + (size_t)m * DM, norm_0_, ACAT_ + (size_t)m * DM, nullptr, nullptr, lane); }
        for (int m = gw; m < MROWS; m += NGW) rms_row_to_bf16(mem_ + (size_t)m * DM, mem_norm_0_, ACAT_ + (size_t)(M + m) * DM, mem_norm_1_, ACAT_ + (size_t)(M + MROWS + m) * DM, lane);
        for (int i = bid * NTHREADS + tid; i < M * 32; i += G * NTHREADS) { const int row = i >> 5, f = i & 31;
            const double ang = (double)positions_[row] * (double)ROPE_INVF[f]; double rv = ang * 0.15915494309189535; rv -= __builtin_rint(rv); const float rf = (float)rv;
            RT_[2 * (size_t)i] = __builtin_amdgcn_cosf(rf); RT_[2 * (size_t)i + 1] = __builtin_amdgcn_sinf(rf); }
    }
#endif
#endif
    xcd_barrier(xbar);
    if (G > (1 << 24)) grid.sync();

#ifndef SKIP_P1
    {
        pg8::Gemm g{ACAT_, WCAT0_, M + 2 * MROWS, N_IN0P + 1024, DM}; OrderX S; S.init(128, 15, G, bid, 32);
        EpiIn0 E{QKV_, Zb_, MQ_, MKV_, BA_};
        pg8::gemm_phase<EpiIn0, OrderX, true, true>(lds, g, S, E, wave_s);
    }
#ifdef DUP_GEMMS
    xcd_barrier(xbar);
    {
        pg8::Gemm g{ACAT_, WCAT0_, M + 2 * MROWS, N_IN0P + 1024, DM}; OrderX S; S.init(128, 15, G, bid, 32);
        EpiIn0 E{QKV_, Zb_, MQ_, MKV_, BA_};
        pg8::gemm_phase<EpiIn0, OrderX, true, true>(lds, g, S, E, wave_s);
    }
#endif
#endif
    xcd_barrier(xbar);

#ifndef SKIP_P2
#ifdef DUP_P2
    p2_delta_prep(lds, G, QKV_, BA_, conv_w_, a_log_, dt_bias_, DQG_, DKDT_, DW_, DU_, DA_, GL_, wave_s, DUP_P2);
    xcd_barrier(xbar);
#endif
    p2_delta_prep(lds, G, QKV_, BA_, conv_w_, a_log_, dt_bias_, DQG_, DKDT_, DW_, DU_, DA_, GL_, wave_s);
#endif
    xcd_barrier(xbar);

#ifndef SKIP_P3
    {
        const int nscan = G < 96 ? G : 96;
#ifdef DUP_P3
        if (bid < nscan) { for (int sq = bid; sq < 96; sq += nscan) p3_scan(lds, sq, DQG_, DKDT_, DW_, DU_, DA_, GL_, Zb_, o_norm_, wave_s, false); }
        xcd_barrier(xbar);
#endif
        if (bid < nscan) { for (int sq = bid; sq < 96; sq += nscan) p3_scan(lds, sq, DQG_, DKDT_, DW_, DU_, DA_, GL_, Zb_, o_norm_, wave_s); }
        const int u0 = (G > 96) ? (bid >= 96 ? bid - 96 : 512) : bid, ustep = (G > 96) ? G - 96 : G;
        for (int u = u0; u < 512; u += ustep) mem_attn_unit(u, 0, lds, (char*)lds_raw, wave_s);
    }
#endif
    xcd_barrier(xbar);

#ifndef SKIP_P4
    {
        pg8::Gemm g{Zb_, WOUT0_, M, DM, DM}; OrderX S; S.init(128, 4, G, bid, 0);
        EpiOutG E{x_, norm_1_, ACAT_, PS_, (LAS float*)(lds + 131072)};
        pg8::gemm_phase<EpiOutG, OrderX, true, true>(lds, g, S, E, wave_s);
    }
#ifdef DUP_GEMMS
    xcd_barrier(xbar);
    {
        pg8::Gemm g{Zb_, WOUT0_, M, DM, DM}; OrderX S; S.init(128, 4, G, bid, 0);
        EpiOutG E{x_, norm_1_, ACAT_, PS_, (LAS float*)(lds + 131072)};
        pg8::gemm_phase<EpiOutG, OrderX, true, true>(lds, g, S, E, wave_s);
    }
#endif
#endif
    xcd_barrier(xbar);


#ifndef SKIP_P6
    {
        pg8::Gemm g{ACAT_, WIN1_, M, N_IN1, DM}; OrderX S; S.init(128, 14, G, bid, 0);
        EpiIn1 E{QKV_, Zb_, MQ_, RT_, KSUM_, PS_};
        pg8::gemm_phase<EpiIn1, OrderX, true, true>(lds, g, S, E, wave_s);
    }
#ifdef DUP_GEMMS
    xcd_barrier(xbar);
    {
        pg8::Gemm g{ACAT_, WIN1_, M, N_IN1, DM}; OrderX S; S.init(128, 14, G, bid, 0);
        EpiIn1 E{QKV_, Zb_, MQ_, RT_, KSUM_, PS_};
        pg8::gemm_phase<EpiIn1, OrderX, true, true>(lds, g, S, E, wave_s);
    }
#endif
#endif
    xcd_barrier(xbar);


#ifndef SKIP_P7
    {
        const int npair = (768 - vcu + G - 1) / G;
#ifdef DUP_P7
        for (int i = 0; i < 2 * npair; ++i) { const int p = vcu + (i >> 1) * G, bh = p >> 3, s = p & 7;
            moba_attn_unit(bh, (i & 1) ? s : 15 - s, lds, (char*)lds_raw, wave_s, true); }
        xcd_barrier(xbar);
#endif
        for (int i = 0; i < 2 * npair; ++i) { const int p = vcu + (i >> 1) * G, bh = p >> 3, s = p & 7;
            moba_attn_unit(bh, (i & 1) ? s : 15 - s, lds, (char*)lds_raw, wave_s); }
        for (int u = vcu; u < 512; u += G) mem_attn_unit(u, 1, lds, (char*)lds_raw, wave_s);
    }
#endif
    xcd_barrier(xbar);

#ifndef SKIP_P8
    {
        pg8::Gemm g{Zb_, WOUT1_, M, DM, DM}; OrderX S; S.init(128, 4, G, bid, 0);
        EpiOutR E{ACAT_, norm_1_, H2B_};
        pg8::gemm_phase<EpiOutR, OrderX, true, true>(lds, g, S, E, wave_s);
    }
#endif
    xcd_barrier(xbar);

#ifdef DUP_SYNC
    for (int i_ = 0; i_ < 20; ++i_) xcd_barrier(xbar);
#endif
#ifndef SKIP_P9
    { FRESH_IDS(); int m = gw; for (; m + NGW < M; m += 2 * NGW) rms_row2_bf16in<false>(H2B_ + (size_t)m * DM, H2B_ + (size_t)(m + NGW) * DM, final_norm_, out_ + (size_t)m * DM, out_ + (size_t)(m + NGW) * DM, lane);
      if (m < M) rms_row2_bf16in<false>(H2B_ + (size_t)m * DM, H2B_ + (size_t)m * DM, final_norm_, out_ + (size_t)m * DM, out_ + (size_t)m * DM, lane); }
#endif
}

extern "C" void kernel_launch(void* const* d_in, const int* in_sizes, int n_in, void* d_out, int out_size, void* d_ws, size_t ws_size, hipStream_t stream) {
    static int grid = 0;
    if (grid == 0) {
        if (n_in != 18 || out_size != M * DM || ws_size < WS_END) { fprintf(stderr, "kernel_launch: unexpected shapes (n_in %d, out %d, ws %zu)\n", n_in, out_size, ws_size); grid = -1; return; }
        int dev = 0, cus = 0, per_cu = 0;
        hipGetDevice(&dev); hipDeviceGetAttribute(&cus, hipDeviceAttributeMultiprocessorCount, dev);
        if (hipFuncSetAttribute((const void*)hybrid_fwd, hipFuncAttributeMaxDynamicSharedMemorySize, LDS_BYTES) != hipSuccess) { fprintf(stderr, "kernel_launch: hipFuncSetAttribute failed\n"); grid = -1; return; }
        if (hipOccupancyMaxActiveBlocksPerMultiprocessor(&per_cu, (const void*)hybrid_fwd, NTHREADS, LDS_BYTES) != hipSuccess || per_cu < 1) { fprintf(stderr, "kernel_launch: occupancy query says %d\n", per_cu); per_cu = 1; }
        (void)hipGetLastError();
        grid = cus * 1;
    }
    if (grid < 0) return;
    if (hipMemsetAsync((char*)d_ws + WS_BAR, 0, 16384, stream) != hipSuccess) { fprintf(stderr, "kernel_launch: memset failed\n"); return; }
    Args a{};
    for (int i = 0; i < 18; ++i) a.in[i] = (const float*)d_in[i];
    a.out = (float*)d_out; a.ws = (unsigned char*)d_ws;
    void* kargs[] = {&a};
    hipError_t e = hipLaunchCooperativeKernel((const void*)hybrid_fwd, dim3(grid), dim3(NTHREADS), kargs, LDS_BYTES, stream);
    if (e != hipSuccess) fprintf(stderr, "kernel_launch: cooperative launch failed: %s (grid %d)\n", hipGetErrorString(e), grid);
}
```
